# Optimizing an MI355X kernel written in HIP

```python
import jax, jax.numpy as jnp
from jax import lax
import numpy as np

D_MODEL = 1024
BATCH = 8
SEQ = 2048
DEPTH = 2

HEAD_DIM = 64
RET_HEADS = 4
RET_W = RET_HEADS * HEAD_DIM
RET_CHUNK = 128
ROPE_BASE = 10000.0
MOBA_HEADS = 6
MOBA_W = MOBA_HEADS * HEAD_DIM
MOBA_BLOCK = 256
MOBA_TOPK = 3
MOBA_QCHUNK = 32
LRU_BLOCKS = 6
LRU_BLOCK_W = 64
LRU_W = LRU_BLOCKS * LRU_BLOCK_W
CONV_WIDTH = 4
LRU_C = 8.0
MIX_W = RET_W + MOBA_W + LRU_W
IN_SIZES = [RET_W] * 4 + [MOBA_W] * 3 + [LRU_W] * 2
IN_W = sum(IN_SIZES)
IN_OFFSETS = np.cumsum(IN_SIZES)[:-1].tolist()
N_EXPERTS = 32
TOPK_EXPERTS = 4
D_FF = D_MODEL
SWIGLU_LIMIT = 7.0
SWIGLU_ALPHA = 1.702
EXPERT_BLOCK = 256
NORM_EPS = 1e-6

kernel_name = "hybrid_retention_moba_rglru_moe_adaln"


def rms_norm(x, w):
    xf = x.astype(jnp.float32)
    y = xf * lax.rsqrt(jnp.mean(xf * xf, axis=-1, keepdims=True) + NORM_EPS)
    return (y * w.astype(jnp.float32)).astype(x.dtype)


def rotary(x, pos):
    half = x.shape[-1] // 2
    inv = 1.0 / (ROPE_BASE ** (jnp.arange(half, dtype=jnp.float32) / half))
    ang = pos.astype(jnp.float32)[:, None] * inv[None, :]
    cos = jnp.cos(ang)[None, :, None, :]
    sin = jnp.sin(ang)[None, :, None, :]
    xf = x.astype(jnp.float32)
    x1, x2 = xf[..., :half], xf[..., half:]
    return jnp.concatenate([x1 * cos - x2 * sin, x2 * cos + x1 * sin], axis=-1)


def retention(q, k, v, g, norm_w):
    B, S, _ = q.shape
    H, dh, C = RET_HEADS, HEAD_DIM, RET_CHUNK
    N = S // C
    pos = jnp.arange(S)
    qh = rotary(q.reshape(B, S, H, dh), pos)
    kh = rotary(k.reshape(B, S, H, dh), pos) * (dh ** -0.5)
    vh = v.reshape(B, S, H, dh).astype(jnp.float32)
    to_chunks = lambda t: t.reshape(B, N, C, H, dh).transpose(0, 3, 1, 2, 4)
    qc, kc, vc = to_chunks(qh), to_chunks(kh), to_chunks(vh)
    log_g = jnp.log1p(-jnp.exp2(-5.0 - jnp.arange(H, dtype=jnp.float32)))
    idx = jnp.arange(C, dtype=jnp.float32)
    diff = idx[:, None] - idx[None, :]
    dmat = jnp.where(diff >= 0, jnp.exp(log_g[:, None, None] * jnp.maximum(diff, 0.0)), 0.0)
    scores = jnp.einsum('bhnid,bhnjd->bhnij', qc, kc) * dmat[None, :, None]
    intra = jnp.einsum('bhnij,bhnje->bhnie', scores, vc)
    zeta = jnp.exp(log_g[:, None] * (C - 1 - idx)[None, :])
    xi = jnp.exp(log_g[:, None] * (idx + 1)[None, :])
    kv = jnp.einsum('bhnjd,bhnje->nbhde', kc * zeta[None, :, None, :, None], vc)
    chunk_decay = jnp.exp(log_g * C)[None, :, None, None]

    def step(state, kv_n):
        return state * chunk_decay + kv_n, state

    _, prev = lax.scan(step, jnp.zeros((B, H, dh, dh), jnp.float32), kv)
    cross = jnp.einsum('bhnid,nbhde->bhnie', qc, prev) * xi[None, :, None, :, None]
    y = (intra + cross).transpose(0, 2, 3, 1, 4).reshape(B, S, H, dh)
    mu = jnp.mean(y, axis=-1, keepdims=True)
    var = jnp.mean(jnp.square(y - mu), axis=-1, keepdims=True)
    y = ((y - mu) * lax.rsqrt(var + NORM_EPS)).reshape(B, S, RET_W) * norm_w.astype(jnp.float32)
    return (jax.nn.silu(g.astype(jnp.float32)) * y).astype(q.dtype)


def moba_attention(q, k, v):
    B, S, _ = q.shape
    H, dh, Bk, Qc = MOBA_HEADS, HEAD_DIM, MOBA_BLOCK, MOBA_QCHUNK
    NBk = -(-S // Bk)
    Sp = NBk * Bk
    topk = min(MOBA_TOPK, NBk)
    to_heads = lambda t: t.reshape(B, S, H, dh).transpose(0, 2, 1, 3).astype(jnp.float32)
    qh, kh, vh = to_heads(q), to_heads(k), to_heads(v)
    pad = ((0, 0), (0, 0), (0, Sp - S), (0, 0))
    kb = jnp.pad(kh, pad).reshape(B, H, NBk, Bk, dh)
    vb = jnp.pad(vh, pad).reshape(B, H, NBk, Bk, dh)
    kmean = jnp.mean(kb, axis=3)
    NQ = S // Qc
    qch = qh.reshape(B, H, NQ, Qc, dh).transpose(2, 0, 1, 3, 4)
    bi = jnp.arange(B)[:, None, None, None]
    hi = jnp.arange(H)[None, :, None, None]
    scale = dh ** -0.5
    blk_ids = jnp.arange(NBk)

    def chunk(args):
        qq, ci = args
        qpos = ci * Qc + jnp.arange(Qc)
        own = (ci * Qc) // Bk
        gs = jnp.einsum('bhqd,bhnd->bhqn', qq, kmean)
        gs = jnp.where(blk_ids < own, gs, -jnp.inf)
        _, sel = lax.top_k(gs, topk)
        valid = sel < own
        kg = kb[bi, hi, sel]
        vg = vb[bi, hi, sel]
        s_sel = jnp.einsum('bhqd,bhqnkd->bhqnk', qq, kg) * scale
        s_sel = jnp.where(valid[..., None], s_sel, -jnp.inf).reshape(B, H, Qc, topk * Bk)
        ko = lax.dynamic_index_in_dim(kb, own, axis=2, keepdims=False)
        vo = lax.dynamic_index_in_dim(vb, own, axis=2, keepdims=False)
        kpos = own * Bk + jnp.arange(Bk)
        s_own = jnp.einsum('bhqd,bhkd->bhqk', qq, ko) * scale
        s_own = jnp.where(kpos[None, :] <= qpos[:, None], s_own, -jnp.inf)
        p = jax.nn.softmax(jnp.concatenate([s_sel, s_own], axis=-1), axis=-1)
        p_sel = p[..., :topk * Bk].reshape(B, H, Qc, topk, Bk)
        p_own = p[..., topk * Bk:]
        return (jnp.einsum('bhqnk,bhqnkd->bhqd', p_sel, vg)
                + jnp.einsum('bhqk,bhkd->bhqd', p_own, vo))

    out = lax.map(chunk, (qch, jnp.arange(NQ)))
    return out.transpose(1, 0, 3, 2, 4).reshape(B, S, MOBA_W).astype(q.dtype)


def rg_lru_branch(xb, gb, conv_w, conv_b, wa, ba, wx, bx, lam):
    B, S, _ = xb.shape
    u = lax.conv_general_dilated(xb, conv_w[:, None, :], window_strides=(1,),
                                 padding=[(CONV_WIDTH - 1, 0)],
                                 dimension_numbers=('NWC', 'WIO', 'NWC'),
                                 feature_group_count=LRU_W) + conv_b
    uf = u.astype(jnp.float32)
    ub = uf.reshape(B, S, LRU_BLOCKS, LRU_BLOCK_W)
    r = jax.nn.sigmoid(jnp.einsum('bsgi,gij->bsgj', ub, wa.astype(jnp.float32)).reshape(B, S, LRU_W) + ba)
    i = jax.nn.sigmoid(jnp.einsum('bsgi,gij->bsgj', ub, wx.astype(jnp.float32)).reshape(B, S, LRU_W) + bx)
    log_a = -LRU_C * r * jax.nn.softplus(-lam.astype(jnp.float32))
    a = jnp.exp(log_a)
    b = jnp.sqrt(-jnp.expm1(2.0 * log_a)) * (i * uf)

    def combine(left, right):
        a1, b1 = left
        a2, b2 = right
        return a1 * a2, a2 * b1 + b2

    _, h = lax.associative_scan(combine, (a, b), axis=1)
    return (jax.nn.gelu(gb.astype(jnp.float32)) * h).astype(xb.dtype)


def moe_ffn(h, router_w, router_b, w_gu, b_gu, w_dn, b_dn):
    B, S, D = h.shape
    T = B * S
    ht = h.reshape(T, D)
    logits = (ht @ router_w + router_b).astype(jnp.float32)
    top_v, top_i = lax.top_k(logits, TOPK_EXPERTS)
    gates = jax.nn.softmax(top_v, axis=-1)
    A = T * TOPK_EXPERTS
    e_flat = top_i.reshape(A)
    tok_flat = jnp.repeat(jnp.arange(T), TOPK_EXPERTS)
    g_flat = gates.reshape(A)
    order = jnp.argsort(e_flat, stable=True)
    e_sorted, tok_sorted, g_sorted = e_flat[order], tok_flat[order], g_flat[order]
    counts = jnp.bincount(e_flat, length=N_EXPERTS)
    padded = ((counts + EXPERT_BLOCK - 1) // EXPERT_BLOCK) * EXPERT_BLOCK
    pend = jnp.cumsum(padded)
    pstart = pend - padded
    ustart = jnp.cumsum(counts) - counts
    ppos = pstart[e_sorted] + (jnp.arange(A) - ustart[e_sorted])
    NB = -(-A // EXPERT_BLOCK) + N_EXPERTS
    P = NB * EXPERT_BLOCK
    row_tok = jnp.zeros((P,), jnp.int32).at[ppos].set(tok_sorted.astype(jnp.int32))
    row_g = jnp.zeros((P,), jnp.float32).at[ppos].set(g_sorted)
    blk_e = jnp.minimum(jnp.searchsorted(pend, jnp.arange(NB) * EXPERT_BLOCK, side='right'), N_EXPERTS - 1)
    xr = ht[row_tok].reshape(NB, EXPERT_BLOCK, D)

    def expert_block(args):
        xb, e = args
        gu = (xb @ w_gu[e] + b_gu[e]).astype(jnp.float32)
        gate, up = gu[:, :D_FF], gu[:, D_FF:]
        gate = jnp.minimum(gate, SWIGLU_LIMIT)
        up = jnp.clip(up, -SWIGLU_LIMIT, SWIGLU_LIMIT)
        act = ((up + 1.0) * gate * jax.nn.sigmoid(SWIGLU_ALPHA * gate)).astype(xb.dtype)
        return act @ w_dn[e] + b_dn[e]

    yr = lax.map(expert_block, (xr, blk_e)).reshape(P, D)
    y = jnp.zeros((T, D), jnp.float32).at[row_tok].add(yr.astype(jnp.float32) * row_g[:, None])
    return y.reshape(B, S, D).astype(h.dtype)


def setup_inputs(seed: int = 0) -> dict:
    key = jax.random.key(seed)
    ks = jax.random.split(key, 24)
    f32 = jnp.float32
    nrm = lambda k, shape, s: jax.random.normal(k, shape, f32) * s
    u = jax.random.uniform(ks[12], (DEPTH, LRU_W), f32, 0.9, 0.999)
    a_base = u ** (1.0 / LRU_C)
    return {
        "x": nrm(ks[0], (BATCH, SEQ, D_MODEL), 1.0),
        "c": nrm(ks[1], (BATCH, D_MODEL), 1.0),
        "ada_w": nrm(ks[2], (DEPTH, D_MODEL, 6 * D_MODEL), 0.5 * D_MODEL ** -0.5),
        "ada_b": nrm(ks[3], (DEPTH, 6 * D_MODEL), 0.02),
        "norm_mix_w": 1.0 + nrm(ks[4], (DEPTH, D_MODEL), 0.02),
        "w_in": nrm(ks[5], (DEPTH, D_MODEL, IN_W), D_MODEL ** -0.5),
        "ret_norm_w": 1.0 + nrm(ks[6], (DEPTH, RET_W), 0.02),
        "lru_conv_w": nrm(ks[7], (DEPTH, CONV_WIDTH, LRU_W), CONV_WIDTH ** -0.5),
        "lru_conv_b": nrm(ks[8], (DEPTH, LRU_W), 0.02),
        "lru_gate_a_w": nrm(ks[9], (DEPTH, LRU_BLOCKS, LRU_BLOCK_W, LRU_BLOCK_W), LRU_BLOCK_W ** -0.5),
        "lru_gate_a_b": nrm(ks[10], (DEPTH, LRU_W), 0.02),
        "lru_gate_x_w": nrm(ks[11], (DEPTH, LRU_BLOCKS, LRU_BLOCK_W, LRU_BLOCK_W), LRU_BLOCK_W ** -0.5),
        "lru_gate_x_b": nrm(ks[13], (DEPTH, LRU_W), 0.02),
        "lru_lambda": jnp.log(a_base) - jnp.log1p(-a_base),
        "w_out": nrm(ks[14], (DEPTH, MIX_W, D_MODEL), MIX_W ** -0.5),
        "norm_ffn_w": 1.0 + nrm(ks[15], (DEPTH, D_MODEL), 0.02),
        "router_w": nrm(ks[16], (DEPTH, D_MODEL, N_EXPERTS), D_MODEL ** -0.5),
        "router_b": nrm(ks[17], (DEPTH, N_EXPERTS), 0.01),
        "moe_w_gu": nrm(ks[18], (DEPTH, N_EXPERTS, D_MODEL, 2 * D_FF), D_MODEL ** -0.5),
        "moe_b_gu": nrm(ks[19], (DEPTH, N_EXPERTS, 2 * D_FF), 0.02),
        "moe_w_down": nrm(ks[20], (DEPTH, N_EXPERTS, D_FF, D_MODEL), D_FF ** -0.5),
        "moe_b_down": nrm(ks[21], (DEPTH, N_EXPERTS, D_MODEL), 0.02),
        "final_norm_w": 1.0 + nrm(ks[22], (D_MODEL,), 0.02),
    }


def reference(x, c, ada_w, ada_b, norm_mix_w, w_in, ret_norm_w, lru_conv_w, lru_conv_b,
              lru_gate_a_w, lru_gate_a_b, lru_gate_x_w, lru_gate_x_b, lru_lambda, w_out,
              norm_ffn_w, router_w, router_b, moe_w_gu, moe_b_gu, moe_w_down, moe_b_down,
              final_norm_w):
    c_act = jax.nn.silu(c)
    for l in range(DEPTH):
        mod = c_act @ ada_w[l] + ada_b[l]
        shift1, scale1, gate1, shift2, scale2, gate2 = [m[:, None, :] for m in jnp.split(mod, 6, axis=-1)]
        h = rms_norm(x, norm_mix_w[l]) * (1.0 + scale1) + shift1
        proj = h @ w_in[l]
        rq, rk, rv, rg, mq, mk, mv, lx, lg = jnp.split(proj, IN_OFFSETS, axis=-1)
        y_ret = retention(rq, rk, rv, rg, ret_norm_w[l])
        y_moba = moba_attention(mq, mk, mv)
        y_lru = rg_lru_branch(lx, lg, lru_conv_w[l], lru_conv_b[l], lru_gate_a_w[l], lru_gate_a_b[l],
                              lru_gate_x_w[l], lru_gate_x_b[l], lru_lambda[l])
        mixed = jnp.concatenate([y_ret, y_moba, y_lru], axis=-1) @ w_out[l]
        x = x + gate1 * mixed
        h2 = rms_norm(x, norm_ffn_w[l]) * (1.0 + scale2) + shift2
        x = x + gate2 * moe_ffn(h2, router_w[l], router_b[l], moe_w_gu[l], moe_b_gu[l],
                                moe_w_down[l], moe_b_down[l])
    return rms_norm(x, final_norm_w)
```

```cpp
#include <hip/hip_runtime.h>
#include <cstdio>
#include <cstdint>
#include <cmath>
#include <type_traits>

#ifndef MK_N_LAUNCHES
#define MK_N_LAUNCHES 1
#endif

#ifndef DBG_REP_PHASE
#define DBG_REP_PHASE -1
#endif
#ifndef DBG_REP_N
#define DBG_REP_N 2
#endif
#define NREP(j) ((DBG_REP_PHASE) == (j) ? (DBG_REP_N) : 1)
#ifndef DBG_MIX0
#define DBG_MIX0 1.0f
#endif
#ifndef DBG_MIX1
#define DBG_MIX1 1.0f
#endif
#ifndef DBG_MOE0
#define DBG_MOE0 1.0f
#endif
#ifndef DBG_MOE1
#define DBG_MOE1 1.0f
#endif
#define GAS __attribute__((address_space(1)))
#define LAS __attribute__((address_space(3)))
typedef unsigned short bf16_t;
typedef short bf16x8 __attribute__((ext_vector_type(8)));
typedef short s16x4 __attribute__((ext_vector_type(4)));
typedef short v4i16_t __attribute__((ext_vector_type(4)));
typedef float f32x4 __attribute__((ext_vector_type(4)));
typedef float f32x2 __attribute__((ext_vector_type(2)));
typedef unsigned u32x4 __attribute__((ext_vector_type(4)));
typedef unsigned u32x2 __attribute__((ext_vector_type(2)));
typedef int i32x2 __attribute__((ext_vector_type(2)));
typedef int i32x8 __attribute__((ext_vector_type(8)));
typedef GAS unsigned gu32;

constexpr int D = 1024, BATCH = 8, SEQ = 2048, T = BATCH * SEQ, DEPTH = 2;
constexpr int INW = 2944, PP = 3072;
constexpr int C_RQ = 0, C_RK = 256, C_RV = 512, C_RG = 768, C_MQ = 1024, C_MK = 1408, C_MV = 1792, C_LX = 2176, C_LG = 2560;
constexpr int Y_RET = 0, Y_MOBA = 256, Y_LRU = 640;
constexpr int NE = 32, FF = 1024, CAP = 16384;
constexpr int LCH = 128, NLCH = SEQ / LCH;
constexpr float NORM_EPS = 1e-6f;

constexpr size_t MiB = 1u << 20;
constexpr size_t WS_CTL = 0, CTL_ZERO_BYTES = 1 * MiB;
constexpr size_t WS_MOD = 1 * MiB;
constexpr size_t WS_ROT = 2 * MiB;
constexpr size_t WS_LRUSUM = 3 * MiB;
constexpr size_t WS_KMEAN = 4 * MiB;
constexpr size_t WS_SLOT = 5 * MiB;
constexpr size_t WS_GATE = 9 * MiB;
constexpr size_t WS_WIN = 10 * MiB;
constexpr size_t WS_WOUT = 22 * MiB;
constexpr size_t WS_RWT = 26 * MiB;
constexpr size_t WS_WGU = 32 * MiB;
constexpr size_t WS_WDN = 288 * MiB;
constexpr size_t WS_H = 416 * MiB;
constexpr size_t WS_PROJ = 448 * MiB;
constexpr size_t WS_YMIX = 544 * MiB;
constexpr size_t WS_X1 = 576 * MiB;
constexpr size_t WS_X2 = 640 * MiB;
constexpr size_t WS_ACT = 704 * MiB;
constexpr size_t WS_YBUF = 848 * MiB;
constexpr size_t WS_LRUH = 976 * MiB;
constexpr size_t WS_LRUA = 992 * MiB;
constexpr size_t WS_H8 = 1008 * MiB;
constexpr size_t WS_END = 1024 * MiB;
constexpr int CW_TMO = 0, CW_CODE = 1;
constexpr int CW_BAR = 4096;
constexpr int CW_CNT = 8192;
constexpr int CW_Q = 8192 + 256;

constexpr int RING_BYTES = 131072;
constexpr int MISC_OFF = RING_BYTES;
constexpr int LDS_BYTES = 147456;
constexpr int NWAVES = 8;

#define RLX_AGENT __ATOMIC_RELAXED, __HIP_MEMORY_SCOPE_AGENT
#define LDS_WAIT() asm volatile("s_waitcnt lgkmcnt(0)" ::: "memory")
#define VM_WAIT() asm volatile("s_waitcnt vmcnt(0)" ::: "memory")

__device__ __forceinline__ unsigned f2bf(float f) { unsigned u = __builtin_bit_cast(unsigned, f); return (u + 0x7fffu + ((u >> 16) & 1u)) >> 16; }
__device__ __forceinline__ unsigned pk2(float lo, float hi) { return f2bf(lo) | (f2bf(hi) << 16); }
__device__ __forceinline__ unsigned cvtpk(float lo, float hi) { typedef __bf16 bf2_t __attribute__((ext_vector_type(2))); f32x2 v = {lo, hi}; bf2_t b = __builtin_convertvector(v, bf2_t); return __builtin_bit_cast(unsigned, b); }
__device__ __forceinline__ unsigned cvt4_fp8(float a, float b, float c, float d) { int w = 0; w = __builtin_amdgcn_cvt_pk_fp8_f32(a, b, w, false); w = __builtin_amdgcn_cvt_pk_fp8_f32(c, d, w, true); return (unsigned)w; }
__device__ __forceinline__ float sat448(float x) { return __builtin_amdgcn_fmed3f(x, -448.0f, 448.0f); }
__device__ __forceinline__ unsigned cvt4_fp8_sat(float a, float b, float c, float d) { return cvt4_fp8(sat448(a), sat448(b), sat448(c), sat448(d)); }
__device__ __forceinline__ float ex2(float x) { return __builtin_amdgcn_exp2f(x); }
__device__ __forceinline__ float fexp(float x) { return __builtin_amdgcn_exp2f(x * 1.4426950408889634f); }
__device__ __forceinline__ float frcp(float x) { return __builtin_amdgcn_rcpf(x); }
__device__ __forceinline__ float bf2f(unsigned short b) { return __builtin_bit_cast(float, ((unsigned)b) << 16); }
__device__ __forceinline__ float bflo(unsigned w) { return __builtin_bit_cast(float, w << 16); }
__device__ __forceinline__ float bfhi(unsigned w) { return __builtin_bit_cast(float, w & 0xffff0000u); }
__device__ __forceinline__ int lane_id() { int l; asm volatile("v_mbcnt_lo_u32_b32 %0, -1, 0\n\tv_mbcnt_hi_u32_b32 %0, -1, %0" : "=v"(l)); return l; }
__device__ __forceinline__ float wave_sum(float v) {
#pragma unroll
    for (int o = 1; o < 64; o <<= 1) v += __shfl_xor(v, o);
    return v;
}

namespace pg8 {
constexpr int BM = 256, BK = 64, HALF = 128, HTB = HALF * BK * 2, STAGE_BYTES = 8 * HTB, NXCD = 8, WGM = 8;
__host__ __device__ __forceinline__ int lds_byte(int r, int c) { const int st = (r >> 4) * 2 + (c >> 5), rr = r & 15, cc = c & 31, ob = rr * 64 + cc * 2; return st * 1024 + (ob ^ (((ob >> 9) & 1) << 5)); }
__host__ __device__ __forceinline__ void stage_rc(int b, int& R, int& C) { const int st = b / 1024, sb = b % 1024, swz = sb ^ (((sb >> 9) & 1) << 5); R = (st >> 1) * 16 + swz / 64; C = (st & 1) * 32 + (swz % 64) / 2; }
__host__ __device__ __forceinline__ int perm32(int rho) { const int n = rho >> 4, i = rho & 15; return 8 * (i >> 2) + 4 * n + (i & 3); }

struct Unit { int pm, pn, e, srow, nv; };

__device__ __forceinline__ unsigned cvt_pk_bf16(float lo, float hi) { unsigned r; asm volatile("v_cvt_pk_bf16_f32 %0, %1, %2" : "=v"(r) : "v"(lo), "v"(hi)); return r; }

struct DenseSched {
    const char* A; const char* Bt; int K; int nM, nN, nwg, G, c;
    __device__ __forceinline__ void init(const void* A_, const void* Bt_, int M, int N, int K_, int G_, int c_) { A = (const char*)A_; Bt = (const char*)Bt_; K = K_; nM = M / BM; nN = N / BM; nwg = nM * nN; G = G_; c = c_; }
    __device__ __forceinline__ bool next(int i, Unit& u) const {
        const long L = (long)i * G + c; if (L >= nwg) return false;
        int wgid = (int)L; { const int q = nwg / NXCD, r = nwg % NXCD, xcd = wgid % NXCD, off = wgid / NXCD; wgid = (xcd < r ? xcd * (q + 1) : r * (q + 1) + (xcd - r) * q) + off; }
        const int nig = WGM * nN, gid = wgid / nig, fm = gid * WGM, gsz = (nM - fm) < WGM ? (nM - fm) : WGM;
        u.pm = fm + ((wgid % nig) % gsz); u.pn = (wgid % nig) / gsz; u.e = 0; u.srow = 0; u.nv = BM; return true;
    }
    __device__ __forceinline__ const char* a_base(const Unit& u) const { return A + (size_t)u.pm * (size_t)BM * K * 2; }
    __device__ __forceinline__ const char* b_base(const Unit& u) const { return Bt + (size_t)u.pn * (size_t)BM * K * 2; }
    __device__ __forceinline__ void a_offs(const Unit&, unsigned (&)[4], const int (&)[2], const int (&)[2]) const {}
};
template <bool GATHER> struct MoeSched {
    const char* A; const char* Bt; int K  , nN, G, c, total, lj_in  ; const LAS int* tab; const i32x2* slot;
    __device__ __forceinline__ bool next(int i, Unit& u) const {
        int blk;
        if ((G % (8 * nN)) == 0) {
            const int BR = G / nN, bpx = BR >> 3, xcd = c & 7, slot = c >> 3;
            blk = i * BR + xcd * bpx + slot / nN; u.pn = slot % nN; if (blk * nN >= total) return false;
        } else { const int L = i * G + c; if (L >= total) return false; blk = L / nN; u.pn = L - blk * nN; }
        u.pm = blk;
        const int lj = lane_id() & 31;
        const unsigned long long bal = __ballot(lj >= 1 && tab[lj] <= blk);
        const int e = __builtin_popcount((unsigned)(bal & 0xffffffffull));
        const int rb = blk - __builtin_amdgcn_readfirstlane(tab[e]); const int cn = __builtin_amdgcn_readfirstlane(tab[33 + e]);
        u.e = e; u.srow = e * CAP + rb * BM; const int rem = cn - rb * BM; u.nv = rem < BM ? rem : BM; return true;
    }
    __device__ __forceinline__ const char* a_base(const Unit& u) const { return GATHER ? A : A + (size_t)u.pm * (size_t)BM * K; }
    __device__ __forceinline__ const char* b_base(const Unit& u) const { return Bt + ((size_t)u.e * nN + u.pn) * (size_t)BM * K; }
    __device__ __forceinline__ void a_offs(const Unit& u, unsigned (&vo)[4], const int (&R)[2], const int (&C)[2]) const {
#pragma unroll
        for (int h = 0; h < 2; ++h)
#pragma unroll
            for (int i = 0; i < 2; ++i) { const int r = h * HALF + R[i]; int ent = 0; if (r < u.nv) ent = slot[u.srow + r].x; vo[h * 2 + i] = (unsigned)(ent >> 2) * (unsigned)K + (unsigned)(C[i] * 2); }
    }
};

struct EpiProj { static constexpr bool PREFETCH = false; static constexpr bool BIAS_LDS = false;
    static constexpr bool PERM = true;
    bf16_t* O; int ldc;
    __device__ __forceinline__ void operator()(const f32x4 (&acc)[2][2][4][2], const Unit& u, int wr, int wc, int fr, int fq) const {
        const int row0 = u.pm * BM + wr * 64 + fr, col0 = u.pn * BM + wc * 32 + 8 * fq;
#pragma unroll
        for (int ai = 0; ai < 2; ++ai)
#pragma unroll
            for (int m = 0; m < 4; ++m) { bf16_t* rowp = O + (size_t)(row0 + ai * HALF + m * 16) * ldc + col0;
#pragma unroll
                for (int bj = 0; bj < 2; ++bj) { const f32x4 v0 = acc[ai][bj][m][0], v1 = acc[ai][bj][m][1];
                    u32x4 w; w.x = cvt_pk_bf16(v0[0], v0[1]); w.y = cvt_pk_bf16(v0[2], v0[3]); w.z = cvt_pk_bf16(v1[0], v1[1]); w.w = cvt_pk_bf16(v1[2], v1[3]);
                    *(u32x4*)(rowp + bj * HALF) = w; } }
    }
};
template <bool IN16> struct EpiResGateT { static constexpr bool PREFETCH = false; static constexpr bool BIAS_LDS = false;
    static constexpr bool PERM = true;
    const float* xin32; const bf16_t* xin16; bf16_t* out; const float* gate; float dbg;
    __device__ __forceinline__ void operator()(const f32x4 (&acc)[2][2][4][2], const Unit& u, int wr, int wc, int fr, int fq) const {
        const int row0 = u.pm * BM + wr * 64 + fr, col0 = u.pn * BM + wc * 32 + 8 * fq; const int b = (u.pm * BM) / SEQ;
        f32x4 gv[2][2];
#pragma unroll
        for (int bj = 0; bj < 2; ++bj)
#pragma unroll
            for (int n = 0; n < 2; ++n) gv[bj][n] = *(const f32x4*)(gate + (size_t)b * 6144 + col0 + bj * HALF + n * 4) * dbg;
        constexpr int MB = IN16 ? 4 : 2;
#pragma unroll
        for (int ai = 0; ai < 2; ++ai)
#pragma unroll
          for (int m0 = 0; m0 < 4; m0 += MB) {
            u32x4 xw[MB][2]; f32x4 xf[MB][2][2];
#pragma unroll
            for (int mm = 0; mm < MB; ++mm) { const size_t off = (size_t)(row0 + ai * HALF + (m0 + mm) * 16) * D + col0;
#pragma unroll
                for (int bj = 0; bj < 2; ++bj) {
                    if constexpr (!IN16) { xf[mm][bj][0] = *(const f32x4*)(xin32 + off + bj * HALF); xf[mm][bj][1] = *(const f32x4*)(xin32 + off + bj * HALF + 4); }
                    else xw[mm][bj] = *(const u32x4*)(xin16 + off + bj * HALF); } }
#pragma unroll
            for (int mm = 0; mm < MB; ++mm) { const int m = m0 + mm; const size_t off = (size_t)(row0 + ai * HALF + m * 16) * D + col0;
#pragma unroll
                for (int bj = 0; bj < 2; ++bj) { f32x4 x0, x1;
                    if constexpr (!IN16) { x0 = xf[mm][bj][0]; x1 = xf[mm][bj][1]; }
                    else { const u32x4 w = xw[mm][bj]; x0 = (f32x4){bflo(w.x), bfhi(w.x), bflo(w.y), bfhi(w.y)}; x1 = (f32x4){bflo(w.z), bfhi(w.z), bflo(w.w), bfhi(w.w)}; }
                    const f32x4 o0 = x0 + gv[bj][0] * acc[ai][bj][m][0], o1 = x1 + gv[bj][1] * acc[ai][bj][m][1];
                    u32x4 ow; ow.x = cvt_pk_bf16(o0[0], o0[1]); ow.y = cvt_pk_bf16(o0[2], o0[3]); ow.z = cvt_pk_bf16(o1[0], o1[1]); ow.w = cvt_pk_bf16(o1[2], o1[3]);
                    *(u32x4*)(out + off + bj * HALF) = ow; } }
            asm volatile("" ::: "memory"); }
    }
};
struct EpiSwiGLU { static constexpr bool PREFETCH = false; static constexpr bool BIAS_LDS = true;
    static constexpr bool PERM = true;
    unsigned char* O; const float* bgu;
    __device__ __forceinline__ const float* bias_src(const Unit& u, int lane) const { return bgu + (size_t)u.e * 2048 + u.pn * HALF + (lane < 32 ? lane * 4 : 1024 + (lane - 32) * 4); }
    __device__ __forceinline__ void operator()(const f32x4 (&acc)[2][2][4][2], const Unit& u, int wr, int wc, int fr, int fq, const LAS float* bl) const {
        const int row0 = u.pm * BM + wr * 64 + fr, jc0 = u.pn * HALF + wc * 32 + 8 * fq;
        f32x4 bg[2], bu[2];
#pragma unroll
        for (int n = 0; n < 2; ++n) { bg[n] = *(const LAS f32x4*)(bl + wc * 32 + 8 * fq + 4 * n); bu[n] = *(const LAS f32x4*)(bl + 128 + wc * 32 + 8 * fq + 4 * n); }
#pragma unroll
        for (int ai = 0; ai < 2; ++ai)
#pragma unroll
            for (int m = 0; m < 4; ++m) { float a[8];
#pragma unroll
                for (int n = 0; n < 2; ++n)
#pragma unroll
                    for (int jp = 0; jp < 2; ++jp) {
                        const f32x2 ag = {acc[ai][0][m][n][2 * jp], acc[ai][0][m][n][2 * jp + 1]}, au = {acc[ai][1][m][n][2 * jp], acc[ai][1][m][n][2 * jp + 1]};
                        const f32x2 bgp = {bg[n][2 * jp], bg[n][2 * jp + 1]}, bup = {bu[n][2 * jp], bu[n][2 * jp + 1]};
                        f32x2 g = ag * 0.03125f + bgp, up = au * 0.03125f + bup;
                        g.x = fminf(g.x, 7.0f); g.y = fminf(g.y, 7.0f); up.x = __builtin_amdgcn_fmed3f(up.x, -7.0f, 7.0f); up.y = __builtin_amdgcn_fmed3f(up.y, -7.0f, 7.0f);
                        const f32x2 z = g * (-1.702f * 1.4426950408889634f);
                        f32x2 d; d.x = __builtin_amdgcn_exp2f(z.x); d.y = __builtin_amdgcn_exp2f(z.y); d = d + 1.0f;
                        f32x2 sg; sg.x = __builtin_amdgcn_rcpf(d.x); sg.y = __builtin_amdgcn_rcpf(d.y);
                        const f32x2 r = (up + 1.0f) * g * sg; a[n * 4 + 2 * jp] = r.x; a[n * 4 + 2 * jp + 1] = r.y; }
                u32x2 w; w.x = cvt4_fp8(a[0], a[1], a[2], a[3]); w.y = cvt4_fp8(a[4], a[5], a[6], a[7]);
                *(u32x2*)(O + (size_t)(row0 + ai * HALF + m * 16) * FF + jc0) = w; }
    }
};
struct EpiDown { static constexpr bool PREFETCH = true; static constexpr bool BIAS_LDS = true;
    static constexpr bool PERM = true;
    unsigned char* Y; const float* bdn; const i32x2* slot;
    __device__ __forceinline__ void pre1(const Unit& u, int wr, int fr, unsigned (&pk)[8]) const {
#pragma unroll
        for (int i = 0; i < 8; ++i) { const int r = (i >> 2) * HALF + wr * 64 + (i & 3) * 16 + fr; i32x2 ent = {0, 0}; if (r < u.nv) ent = slot[u.srow + r];
            const int ex = ent.x, ey = ent.y;
            pk[i] = (cvtpk(0.f, __builtin_bit_cast(float, ey)) & 0xffff0000u) | ((unsigned)ex & 0xffffu); }
    }
    __device__ __forceinline__ const float* bias_src(const Unit& u, int lane) const { return bdn + (size_t)u.e * 1024 + u.pn * BM + lane * 4; }
    __device__ __forceinline__ void operator()(const f32x4 (&acc)[2][2][4][2], const Unit& u, int wr, int wc, int fr, int fq, const unsigned (&pk)[8], const LAS float* bl) const {
        const int col0 = u.pn * BM + wc * 32 + 8 * fq;
        f32x4 bv[2][2];
#pragma unroll
        for (int bj = 0; bj < 2; ++bj)
#pragma unroll
            for (int n = 0; n < 2; ++n) bv[bj][n] = *(const LAS f32x4*)(bl + wc * 32 + 8 * fq + bj * HALF + 4 * n);
#pragma unroll
        for (int ai = 0; ai < 2; ++ai)
#pragma unroll
            for (int m = 0; m < 4; ++m) { const unsigned e = pk[ai * 4 + m];
                if ((e >> 16) != 0u) { const float g = __builtin_bit_cast(float, e & 0xffff0000u) * 16.0f; unsigned char* rowp = Y + (size_t)(e & 0xffffu) * D + col0;
#pragma unroll
                    for (int bj = 0; bj < 2; ++bj) { const f32x4 v0 = (acc[ai][bj][m][0] * 0.03125f + bv[bj][0]) * g, v1 = (acc[ai][bj][m][1] * 0.03125f + bv[bj][1]) * g;
                        u32x2 w; w.x = cvt4_fp8_sat(v0[0], v0[1], v0[2], v0[3]); w.y = cvt4_fp8_sat(v1[0], v1[1], v1[2], v1[3]);
                        *(u32x2*)(rowp + bj * HALF) = w; } } }
    }
};

template <class Epi, class Sched, bool GATHER, bool F8 = false>
__device__ __forceinline__ void gemm_phase(LAS unsigned char* lds, const int K, const Sched& S, const Epi& E, const int tid_in) {
    int tz = tid_in; asm volatile("" : "+v"(tz));
    const int tid = tz, wid = __builtin_amdgcn_readfirstlane(tid >> 6), lane = tid & 63, wr = wid >> 2, wc = wid & 3, fr = lane & 15, fq = lane >> 4;
    const int RB = F8 ? K : 2 * K;
    int nt = RB / 128; asm volatile("" : "+s"(nt));
    int Rr[2], Cc[2]; unsigned voffB[2], voffC[4], voffN[4];
#pragma unroll
    for (int i = 0; i < 2; ++i) { int R, C; stage_rc(tid * 16 + i * 8192, R, C); Rr[i] = R; Cc[i] = C; const int Rb = Epi::PERM ? ((R & ~31) + perm32(R & 31)) : R;
        voffB[i] = (unsigned)(Rb * RB + C * 2); voffC[i] = (unsigned)(R * RB + C * 2); voffC[2 + i] = (unsigned)((R + HALF) * RB + C * 2); }
#pragma unroll
    for (int i = 0; i < 4; ++i) voffN[i] = voffC[i];
    const size_t kstep = (size_t)(BK * 2);
    const size_t hstep = (size_t)HALF * RB;
    const unsigned ldsw = (unsigned)wid * 1024u;
    unsigned aoff = (unsigned)lds_byte(wr * 64 + fr, fq * (F8 ? 16 : 8)), boff = 65536u + (unsigned)lds_byte(wc * 32 + fr, fq * (F8 ? 16 : 8));
    asm volatile("" : "+v"(aoff), "+v"(boff));
    unsigned aoff1 = aoff, boff1 = boff;
    if constexpr (F8) { aoff += 16u * (unsigned)(fq & 1); boff += 16u * (unsigned)(fq & 1); aoff1 = aoff ^ 16u; boff1 = boff ^ 16u; asm volatile("" : "+v"(aoff), "+v"(boff), "+v"(aoff1), "+v"(boff1)); }
#define PG8_SA(b, h) (((b) * 2 + (h)) * HTB)
#define PG8_SB(b, h) ((4 + (b) * 2 + (h)) * HTB)
#define PG8_SBR(b, h) (((b) * 2 + (h)) * HTB)
#define PG8_STAGE_B(bufoff, gbase) do { _Pragma("unroll") for (int _i = 0; _i < 2; ++_i) \
        __builtin_amdgcn_global_load_lds((const unsigned*)((const char*)(gbase) + voffB[_i]), (LAS unsigned*)(lds + (bufoff) + ldsw + _i * 8192), 16, 0, 0); } while (0)
#define PG8_STAGE_A(bufoff, gbase, o0, o1) do { \
        __builtin_amdgcn_global_load_lds((const unsigned*)((const char*)(gbase) + (o0)), (LAS unsigned*)(lds + (bufoff) + ldsw), 16, 0, 0); \
        __builtin_amdgcn_global_load_lds((const unsigned*)((const char*)(gbase) + (o1)), (LAS unsigned*)(lds + (bufoff) + ldsw + 8192), 16, 0, 0); } while (0)
#define PG8_RD16(off) (*(const LAS u32x4*)(lds + (off)))
#define PG8_MK8(x0, x1) ((i32x8){(int)(x0).x, (int)(x0).y, (int)(x0).z, (int)(x0).w, (int)(x1).x, (int)(x1).y, (int)(x1).z, (int)(x1).w})
#define PG8_LDA(dst, b, h) do { _Pragma("unroll") for (int m = 0; m < 4; ++m) { \
        if constexpr (F8) { const u32x4 _x0 = PG8_RD16(aoff + (PG8_SA(b, h) + m * 2048)), _x1 = PG8_RD16(aoff1 + (PG8_SA(b, h) + m * 2048)); dst##8[m] = PG8_MK8(_x0, _x1); } \
        else { _Pragma("unroll") for (int k = 0; k < 2; ++k) dst[m][k] = *(const LAS bf16x8*)(lds + aoff + (PG8_SA(b, h) + m * 2048 + k * 1024)); } } } while (0)
#define PG8_LDB(dst, b, h) do { _Pragma("unroll") for (int n = 0; n < 2; ++n) { \
        if constexpr (F8) { const u32x4 _x0 = PG8_RD16(boff + (PG8_SBR(b, h) + n * 2048)), _x1 = PG8_RD16(boff1 + (PG8_SBR(b, h) + n * 2048)); dst##8[n] = PG8_MK8(_x0, _x1); } \
        else { _Pragma("unroll") for (int k = 0; k < 2; ++k) dst[n][k] = *(const LAS bf16x8*)(lds + boff + (PG8_SBR(b, h) + n * 2048 + k * 1024)); } } } while (0)
#define PG8_MMA(ai, bj, At, Bt) do { __builtin_amdgcn_s_setprio(1); _Pragma("unroll") for (int m = 0; m < 4; ++m) _Pragma("unroll") for (int n = 0; n < 2; ++n) { \
        if constexpr (F8) asm volatile("v_mfma_scale_f32_16x16x128_f8f6f4 %0, %1, %2, %0, %3, %3 op_sel_hi:[0,0,0]" : "+v"(acc[ai][bj][m][n]) : "v"(Bt##8[n]), "v"(At##8[m]), "v"(f8scale));   \
        else { _Pragma("unroll") for (int k = 0; k < 2; ++k) acc[ai][bj][m][n] = __builtin_amdgcn_mfma_f32_16x16x32_bf16(Bt[n][k], At[m][k], acc[ai][bj][m][n], 0, 0, 0); } } \
        __builtin_amdgcn_s_setprio(0); } while (0)
#define PG8_WAIT_V(n) asm volatile("s_waitcnt vmcnt(" #n ")" ::: "memory")
#define PG8_WAIT_L(n) asm volatile("s_waitcnt lgkmcnt(" #n ")" ::: "memory")
#define PG8_BAR __builtin_amdgcn_s_barrier()
#define PG8_SCHED __builtin_amdgcn_sched_barrier(0)
    Unit cur, nxt; int ui = 0;
    if (!S.next(0, cur)) return;
    f32x4 acc[2][2][4][2];
#pragma unroll
    for (int a = 0; a < 2; ++a)
#pragma unroll
        for (int b = 0; b < 2; ++b)
#pragma unroll
            for (int m = 0; m < 4; ++m)
#pragma unroll
                for (int n = 0; n < 2; ++n) acc[a][b][m][n] = (f32x4){0.f, 0.f, 0.f, 0.f};
    int f8scale = 0x7f7f7f7f; asm volatile("" : "+v"(f8scale));
    bf16x8 At[4][2], B0[2][2], B1[2][2]; i32x8 At8[4], B08[2], B18[2];
    const char* cA = S.a_base(cur); const char* cB = S.b_base(cur);
    if constexpr (GATHER) S.a_offs(cur, voffC, Rr, Cc);
    unsigned epk[8];
    if constexpr (Epi::PREFETCH) E.pre1(cur, wr, fr, epk);
    LAS unsigned char* const bias_lds = lds + MISC_OFF + 8192;
    if constexpr (Epi::BIAS_LDS) { if (wid == 0) __builtin_amdgcn_global_load_lds((const unsigned*)E.bias_src(cur, lane_id()), (LAS unsigned*)bias_lds, 16, 0, 0); }
    PG8_STAGE_B(PG8_SB(0, 0), cB); PG8_STAGE_B(PG8_SB(0, 1), cB + hstep); PG8_STAGE_A(PG8_SA(0, 0), cA, voffC[0], voffC[1]); PG8_STAGE_A(PG8_SA(0, 1), cA, voffC[2], voffC[3]);
    if (wr == 1) PG8_BAR;
    PG8_WAIT_V(2); PG8_BAR;
    PG8_STAGE_B(PG8_SB(1, 0), cB + kstep); PG8_STAGE_A(PG8_SA(1, 0), cA + kstep, voffC[0], voffC[1]); PG8_STAGE_B(PG8_SB(1, 1), cB + hstep + kstep);
    PG8_WAIT_V(6); PG8_BAR;
    for (;;) {
        const bool has_next = S.next(ui + 1, nxt);
        const char* nA = has_next ? S.a_base(nxt) : cA; const char* nB = has_next ? S.b_base(nxt) : cB;
        if constexpr (GATHER) { if (has_next) S.a_offs(nxt, voffN, Rr, Cc); else {
#pragma unroll
            for (int i = 0; i < 4; ++i) voffN[i] = voffC[i]; } }
#pragma unroll 1
        for (int t = 0; t < nt; t += 2) {
            const bool last = (t == nt - 2);
            const char* a1 = cA + (size_t)(t + 1) * kstep;
            const char* a2 = last ? nA : cA + (size_t)(t + 2) * kstep; const char* b2 = last ? nB : cB + (size_t)(t + 2) * kstep;
            const char* a3 = a2 + kstep; const char* b3 = b2 + kstep;
            unsigned o2[4];
#pragma unroll
            for (int i = 0; i < 4; ++i) o2[i] = GATHER ? (last ? voffN[i] : voffC[i]) : voffC[i];
            PG8_LDB(B0, 0, 0); PG8_LDB(B1, 0, 1); PG8_SCHED; PG8_LDA(At, 0, 0); PG8_STAGE_A(PG8_SA(1, 1), a1, voffC[2], voffC[3]);
            PG8_WAIT_V(8); PG8_WAIT_L(0); PG8_BAR; PG8_MMA(0, 0, At, B0); PG8_MMA(0, 1, At, B1); PG8_BAR; PG8_SCHED;
            PG8_LDA(At, 0, 1); PG8_STAGE_B(PG8_SB(0, 0), b2); PG8_STAGE_B(PG8_SB(0, 1), b2 + hstep); PG8_STAGE_A(PG8_SA(0, 0), a2, o2[0], o2[1]);
            PG8_WAIT_V(8); PG8_WAIT_L(0); PG8_BAR; PG8_MMA(1, 0, At, B0); PG8_MMA(1, 1, At, B1); PG8_BAR; PG8_SCHED;
            PG8_LDB(B0, 1, 0); PG8_LDB(B1, 1, 1); PG8_SCHED; PG8_LDA(At, 1, 0); PG8_STAGE_A(PG8_SA(0, 1), a2, o2[2], o2[3]);
            PG8_WAIT_V(8); PG8_WAIT_L(0); PG8_BAR; PG8_MMA(0, 0, At, B0); PG8_MMA(0, 1, At, B1); PG8_BAR; PG8_SCHED;
            PG8_LDA(At, 1, 1); PG8_STAGE_B(PG8_SB(1, 0), b3); PG8_STAGE_B(PG8_SB(1, 1), b3 + hstep); PG8_STAGE_A(PG8_SA(1, 0), a3, o2[0], o2[1]);
            PG8_WAIT_V(8); PG8_WAIT_L(0); PG8_BAR; PG8_MMA(1, 0, At, B0); PG8_MMA(1, 1, At, B1); PG8_BAR; PG8_SCHED;
        }
        if (wr == 0) PG8_BAR;
        if constexpr (F8) asm volatile("s_nop 15\n\ts_nop 15" ::: "memory");
        { const LAS float* bl = (const LAS float*)(bias_lds + (ui & 1) * 1024);
          if constexpr (Epi::PREFETCH && Epi::BIAS_LDS) E(acc, cur, wr, wc, fr, fq, epk, bl); else if constexpr (Epi::BIAS_LDS) E(acc, cur, wr, wc, fr, fq, bl); else if constexpr (Epi::PREFETCH) E(acc, cur, wr, wc, fr, fq, epk); else E(acc, cur, wr, wc, fr, fq); }
        if (!has_next) break;
#pragma unroll
        for (int a = 0; a < 2; ++a)
#pragma unroll
            for (int b = 0; b < 2; ++b)
#pragma unroll
                for (int m = 0; m < 4; ++m)
#pragma unroll
                    for (int n = 0; n < 2; ++n) acc[a][b][m][n] = (f32x4){0.f, 0.f, 0.f, 0.f};
        cur = nxt; cA = nA; cB = nB; ++ui;
        if constexpr (Epi::PREFETCH) E.pre1(cur, wr, fr, epk);
        if constexpr (Epi::BIAS_LDS) { if (wid == 0) __builtin_amdgcn_global_load_lds((const unsigned*)E.bias_src(cur, lane_id()), (LAS unsigned*)(bias_lds + (ui & 1) * 1024), 16, 0, 0); }
#pragma unroll
        for (int i = 0; i < 4; ++i) voffC[i] = voffN[i];
        if (wr == 1) PG8_BAR;
    }
    PG8_WAIT_V(0);
    PG8_BAR;
#undef PG8_SA
#undef PG8_SB
#undef PG8_SBR
#undef PG8_STAGE_A
#undef PG8_STAGE_B
#undef PG8_LDA
#undef PG8_RD16
#undef PG8_MK8
#undef PG8_LDB
#undef PG8_MMA
#undef PG8_WAIT_V
#undef PG8_WAIT_L
#undef PG8_BAR
#undef PG8_SCHED
}
}

#define XB_TMO      128
#define XB_XCNT(j)  (256  + 64 * (j))
#define XB_XSUB(j)  (1280 + 64 * (j))
#define XB_XGEN(j)  (2304 + 64 * (j))
#define XB_TOP      3328
#define XB_TOPGEN   3392
#define XCD_BAR_WORDS 3456
#define XB_SPIN_CAP (1u << 18)
__device__ __forceinline__ unsigned xb_ld(unsigned* p)              { return __hip_atomic_load(p, __ATOMIC_RELAXED, __HIP_MEMORY_SCOPE_AGENT); }
__device__ __forceinline__ unsigned xb_add(unsigned* p, unsigned v) { return __hip_atomic_fetch_add(p, v, __ATOMIC_RELAXED, __HIP_MEMORY_SCOPE_AGENT); }
__device__ __forceinline__ unsigned xb_xcc_id() { return (unsigned)__builtin_amdgcn_s_getreg((3 << 11) | 20) & 0xFu; }
#define XB_SPIN(cond, bar) do { unsigned _sp = 0; while (cond) { __builtin_amdgcn_s_sleep(1); \
    if ((++_sp & 255u) == 0u) { if (xb_ld(&(bar)[XB_TMO])) break; if (_sp > XB_SPIN_CAP) { atomicAdd(&(bar)[XB_TMO], 1u); break; } } } } while (0)
struct XcdBarrier { unsigned* bar; unsigned x; volatile LAS unsigned* st; };
__device__ __forceinline__ XcdBarrier xcd_barrier_post(unsigned* bar, volatile LAS unsigned* st, int tid) {
    XcdBarrier b; b.bar = bar; b.x = xb_xcc_id(); b.st = st;
    if (tid == 0) (void)xb_add(&bar[XB_XCNT(b.x)], 1u);
    return b;
}
__device__ __forceinline__ void xcd_barrier_complete(unsigned* bar, unsigned x, unsigned& nloc, unsigned& nx) {
    const unsigned G = gridDim.x * gridDim.y * gridDim.z;
    unsigned sum, cnt, mine, sp = 0u;
    for (;;) {
        sum = 0u; cnt = 0u; mine = 0u;
#pragma unroll
        for (unsigned j = 0; j < 16; ++j) { const unsigned c = xb_ld(&bar[XB_XCNT(j)]); sum += c; cnt += (c > 0u) ? 1u : 0u; mine = (j == x) ? c : mine; }
        if (sum == G) break;
        __builtin_amdgcn_s_sleep(1);
        if ((++sp & 255u) == 0u) { if (xb_ld(&bar[XB_TMO])) break; if (sp > XB_SPIN_CAP) { atomicAdd(&bar[XB_TMO], 1u); break; } }
    }
    nloc = mine > 0u ? mine : 1u; nx = cnt > 0u ? cnt : 1u;
}
__device__ __forceinline__ void xcd_barrier(const XcdBarrier& b, int tid) {
    asm volatile("s_waitcnt vmcnt(0)" ::: "memory");
    __syncthreads();
    if (tid == 0) {
        unsigned* bar = b.bar;
        __builtin_amdgcn_s_waitcnt(0);
        unsigned nloc = b.st[0], nx = b.st[1];
        if (nloc == 0u) { xcd_barrier_complete(bar, b.x, nloc, nx); b.st[0] = nloc; b.st[1] = nx; }
        const unsigned old = xb_add(&bar[XB_XSUB(b.x)], 1u);
        const unsigned gen = old / nloc;
        if (old + 1u == (gen + 1u) * nloc) {
            __builtin_amdgcn_fence(__ATOMIC_RELEASE, "agent");
            asm volatile("s_waitcnt vmcnt(0)" ::: "memory");
            const unsigned og = xb_add(&bar[XB_TOP], 1u);
            const unsigned tg = og / nx;
            if (og + 1u == (tg + 1u) * nx) xb_add(&bar[XB_TOPGEN], 1u);
            else XB_SPIN(xb_ld(&bar[XB_TOPGEN]) == tg, bar);
            __builtin_amdgcn_fence(__ATOMIC_ACQUIRE, "agent");
            xb_add(&bar[XB_XGEN(b.x)], 1u);
            asm volatile("s_waitcnt vmcnt(0)" ::: "memory");
        } else {
            XB_SPIN(xb_ld(&bar[XB_XGEN(b.x)]) == gen, bar);
            __builtin_amdgcn_fence(__ATOMIC_ACQUIRE, "agent");
            asm volatile("s_waitcnt vmcnt(0)" ::: "memory");
        }
    }
    __syncthreads();
}

#define CAS __attribute__((address_space(4)))
typedef const float* PFC;
struct Frame {
    LAS unsigned char* lds;
    gu32* ctl;
    int tid, lane, wave, vcu, G, bx;
    const CAS PFC* in;
    float* out; unsigned char* ws;
};
#define GIN(i) ((const float*)(const GAS float*)F.in[i])
enum { I_X = 0, I_C, I_ADAW, I_ADAB, I_NMIX, I_WIN, I_RETNW, I_CONVW, I_CONVB, I_WA, I_BA, I_WX, I_BX, I_LAM, I_WOUT, I_NFFN, I_RW, I_RB, I_WGU, I_BGU, I_WDN, I_BDN, I_FNW };

__device__ __forceinline__ void p0_transpose_item(const float* W, int N, int k0, int n0, bf16_t* WTrow0  , int Kd, LAS float* scr, int lane) {
#pragma unroll 8
    for (int i = 0; i < 32; ++i) { const int kk = 2 * i + (lane >> 5); scr[kk * 33 + (lane & 31)] = W[(size_t)(k0 + kk) * N + n0 + (lane & 31)]; }
    LDS_WAIT(); asm volatile("" ::: "memory");
    const int c = lane & 7;
#pragma unroll
    for (int j = 0; j < 4; ++j) { const int n = (lane >> 3) + 8 * j; const LAS float* s = scr + (8 * c) * 33 + n;
        u32x4 o; o.x = pk2(s[0 * 33], s[1 * 33]); o.y = pk2(s[2 * 33], s[3 * 33]); o.z = pk2(s[4 * 33], s[5 * 33]); o.w = pk2(s[6 * 33], s[7 * 33]);
        *(u32x4*)(WTrow0 + (size_t)n * Kd + k0 + 8 * c) = o; }
    LDS_WAIT(); asm volatile("" ::: "memory");
}
__device__ __forceinline__ void p0_transpose_item8(const float* W, int N, int k0, int n0, unsigned char* WTrow0, int Kd, LAS float* scr, int lane) {
#pragma unroll 8
    for (int i = 0; i < 32; ++i) { const int kk = 2 * i + (lane >> 5); scr[kk * 33 + (lane & 31)] = W[(size_t)(k0 + kk) * N + n0 + (lane & 31)] * 32.0f; }
    LDS_WAIT(); asm volatile("" ::: "memory");
    const int c = lane & 7;
#pragma unroll
    for (int j = 0; j < 4; ++j) { const int n = (lane >> 3) + 8 * j; const LAS float* sp = scr + (8 * c) * 33 + n;
        u32x2 o; o.x = cvt4_fp8(sp[0 * 33], sp[1 * 33], sp[2 * 33], sp[3 * 33]); o.y = cvt4_fp8(sp[4 * 33], sp[5 * 33], sp[6 * 33], sp[7 * 33]);
        *(u32x2*)(WTrow0 + (size_t)n * Kd + k0 + 8 * c) = o; }
    LDS_WAIT(); asm volatile("" ::: "memory");
}
__device__ __forceinline__ float silu_f(float x) { return x * frcp(1.0f + fexp(-x)); }

__device__ __forceinline__ void p0_prologue(Frame& F) {
    const int gw = F.vcu * NWAVES + F.wave, NGW = F.G * NWAVES;
    {
        LAS float* cact = (LAS float*)(F.lds);
        LAS float* red = (LAS float*)(F.lds + 32768);
        for (int i = F.tid; i < BATCH * D; i += 512) cact[i] = silu_f(GIN(I_C)[i]);
        __syncthreads();
        float* mod = (float*)(F.ws + WS_MOD);
        for (int u = F.bx; u < DEPTH * 96; u += F.G) {
            const int l = u / 96, n0 = (u % 96) * 64, col = F.tid & 63, kg = F.tid >> 6;
            const float* w = GIN(I_ADAW) + (size_t)l * D * 6144 + n0 + col;
            float a[8];
#pragma unroll
            for (int b = 0; b < 8; ++b) a[b] = 0.f;
#pragma unroll 32
            for (int k = kg * 128; k < kg * 128 + 128; ++k) { const float wv = w[(size_t)k * 6144];
#pragma unroll
                for (int b = 0; b < 8; ++b) a[b] += cact[b * D + k] * wv; }
#pragma unroll
            for (int b = 0; b < 8; ++b) red[(kg * 8 + b) * 64 + col] = a[b];
            __syncthreads();
            { const int b = F.tid >> 6; float s = 0.f;
#pragma unroll
              for (int g = 0; g < 8; ++g) s += red[(g * 8 + b) * 64 + col];
              mod[((size_t)l * BATCH + b) * 6144 + n0 + col] = s + GIN(I_ADAB)[l * 6144 + n0 + col]; }
            __syncthreads();
        }
    }
    {
        float* rc = (float*)(F.ws + WS_ROT); float* rs = rc + SEQ * 32;
        for (int i = gw * 64 + F.lane; i < SEQ * 32; i += NGW * 64) { const int pos = i >> 5, j = i & 31;
            const double inv = pow(10000.0, -(double)j / 32.0), ang = (double)pos * inv; rc[i] = (float)cos(ang); rs[i] = (float)sin(ang); }
    }
    {
        bf16_t* rwt = (bf16_t*)(F.ws + WS_RWT);
        for (int i = gw * 64 + F.lane; i < DEPTH * NE * D; i += NGW * 64) { const int l = i / (NE * D), r = i % (NE * D), e = r / D, k = r % D;
            const float w = GIN(I_RW)[(size_t)l * D * NE + (size_t)k * NE + e]; const unsigned hi = f2bf(w); const float lo = w - __builtin_bit_cast(float, hi << 16);
            rwt[((size_t)l * 2 + 0) * NE * D + r] = (bf16_t)hi; rwt[((size_t)l * 2 + 1) * NE * D + r] = (bf16_t)f2bf(lo); }
    }
}
namespace cv {
constexpr int I_IN = 16 * (INW / 64), I_OUT = 16 * 16, I_GU = 16 * 32, I_DN = 16 * 16;
constexpr int N_IN = DEPTH * I_IN, N_OUT = DEPTH * I_OUT, N_GU = DEPTH * NE * I_GU, N_DN = DEPTH * NE * I_DN, N_PROJ = N_IN + N_OUT;
struct Item { const float* src; unsigned char* dst; int N, f8; };
__device__ __forceinline__ Item decode(Frame& F, int it) { Item t; int r = it;
    bf16_t* win_t = (bf16_t*)(F.ws + WS_WIN); bf16_t* wout_t = (bf16_t*)(F.ws + WS_WOUT); unsigned char* wgu_t = (unsigned char*)(F.ws + WS_WGU); unsigned char* wdn_t = (unsigned char*)(F.ws + WS_WDN);
    if (r < N_IN) { const int l = r / I_IN, q = r % I_IN, kb = q / (INW / 64), nb = q % (INW / 64);
        t.src = GIN(I_WIN) + (size_t)l * D * INW + (size_t)kb * 64 * INW + nb * 64; t.dst = (unsigned char*)(win_t + ((size_t)l * PP + nb * 64) * D + kb * 64); t.N = INW; t.f8 = 0; return t; }
    r -= N_IN;
    if (r < N_OUT) { const int l = r / I_OUT, q = r % I_OUT, kb = q / 16, nb = q % 16;
        t.src = GIN(I_WOUT) + (size_t)l * D * D + (size_t)kb * 64 * D + nb * 64; t.dst = (unsigned char*)(wout_t + ((size_t)l * D + nb * 64) * D + kb * 64); t.N = D; t.f8 = 0; return t; }
    r -= N_OUT;
    if (r < N_GU) { const int le = r / I_GU, q = r % I_GU, kb = q / 32, nb = q % 32, n0 = nb * 64, half = n0 >> 10, j = n0 & 1023;
        const int drow = 256 * (j >> 7) + 128 * half + (j & 127);
        t.src = GIN(I_WGU) + (size_t)le * D * 2048 + (size_t)kb * 64 * 2048 + n0; t.dst = wgu_t + ((size_t)le * 2048 + drow) * D + kb * 64; t.N = 2048; t.f8 = 1; return t; }
    r -= N_GU;
    { const int le = r / I_DN, q = r % I_DN, kb = q / 16, nb = q % 16;
        t.src = GIN(I_WDN) + (size_t)le * FF * D + (size_t)kb * 64 * D + nb * 64; t.dst = wdn_t + ((size_t)le * D + nb * 64) * FF + kb * 64; t.N = D; t.f8 = 1; return t; } }
__device__ __forceinline__ void load(const Item& t, f32x4 (&v)[16], int lane) { const int r4 = lane >> 4, c16 = lane & 15;
#pragma unroll
    for (int i = 0; i < 16; ++i) v[i] = __builtin_nontemporal_load((const f32x4*)(t.src + (size_t)(4 * i + r4) * t.N + 4 * c16)); }
template <int F8C = -1> __device__ __forceinline__ void to_lds(const Item& t, const f32x4 (&v)[16], LAS float* scr, int lane) {
    const int r4 = lane >> 4, c16 = lane & 15; const float sc = (F8C == 1 || t.f8) ? 32.0f : 1.0f;
#pragma unroll
    for (int i = 0; i < 16; ++i) *(LAS f32x4*)(scr + (4 * i + r4) * 64 + 4 * (c16 ^ i)) = v[i] * sc;
    LDS_WAIT(); asm volatile("" ::: "memory"); }
template <int F8C = -1> __device__ __forceinline__ void finish(const Item& t, LAS float* scr, int lane) {
    const int q = lane & 3, a = lane >> 4, n3 = (lane >> 2) & 3;
    const LAS float* base0 = scr + q * 1024 + n3;
    int Y[4];
#pragma unroll
    for (int b = 0; b < 4; ++b) Y[b] = 4 * (a ^ b);
#pragma unroll
    for (int p = 0; p < 4; ++p) { const int n = 16 * p + (lane >> 2); const LAS float* bp = base0 + 16 * (p ^ q); float e[16];
#pragma unroll
        for (int kk = 0; kk < 16; ++kk) e[kk] = bp[kk * 64 + Y[kk >> 2]];
        if (F8C == 1 || t.f8) { u32x4 o; o.x = cvt4_fp8(e[0], e[1], e[2], e[3]); o.y = cvt4_fp8(e[4], e[5], e[6], e[7]); o.z = cvt4_fp8(e[8], e[9], e[10], e[11]); o.w = cvt4_fp8(e[12], e[13], e[14], e[15]);
            *(u32x4*)(t.dst + (size_t)n * D + 16 * q) = o; }
        else { u32x4* dp = (u32x4*)(t.dst + ((size_t)n * D + 16 * q) * 2);
#pragma unroll
            for (int h = 0; h < 2; ++h) { u32x4 o; o.x = cvtpk(e[8 * h], e[8 * h + 1]); o.y = cvtpk(e[8 * h + 2], e[8 * h + 3]); o.z = cvtpk(e[8 * h + 4], e[8 * h + 5]); o.w = cvtpk(e[8 * h + 6], e[8 * h + 7]); dp[h] = o; } } }
    LDS_WAIT(); asm volatile("" ::: "memory"); }
__device__ __forceinline__ void run(Frame& F, int it0, int step, int end) {
    LAS float* scr = (LAS float*)(F.lds + F.wave * 16384);
    int it = it0;
    if (it < end) { Item cur = decode(F, it); f32x4 vc[16]; load(cur, vc, F.lane);
        for (;;) { const int itn = it + step; const bool hn = itn < end; Item nx = cur; f32x4 vn[16];
            if (hn) { nx = decode(F, itn); load(nx, vn, F.lane); }
            to_lds(cur, vc, scr, F.lane); finish(cur, scr, F.lane);
            if (!hn) break;
            cur = nx; it = itn;
#pragma unroll
            for (int i = 0; i < 16; ++i) vc[i] = vn[i]; } }
}
constexpr int BATCH_ITEMS = 32, NB_GU = NE * I_GU / BATCH_ITEMS, NB_DN = NE * I_DN / BATCH_ITEMS, NB_LAYER = NB_GU + NB_DN;
__device__ __forceinline__ void run_batch(Frame& F, int base) {
    LAS float* scr = (LAS float*)(F.lds + F.wave * 16384);
    const int i0 = base + 4 * F.wave;
    f32x4 vA[16], vB[16];
    const Item t0 = decode(F, i0), t1 = decode(F, i0 + 1), t2 = decode(F, i0 + 2), t3 = decode(F, i0 + 3);
#define CV_ARRIVED(V, n) do { asm volatile("s_waitcnt vmcnt(" #n ")" ::: "memory"); _Pragma("unroll") for (int _i = 0; _i < 16; ++_i) asm volatile("" : "+v"(V[_i])); } while (0)
    load(t0, vA, F.lane); load(t1, vB, F.lane);
    CV_ARRIVED(vA, 16); to_lds<1>(t0, vA, scr, F.lane); finish<1>(t0, scr, F.lane); load(t2, vA, F.lane);
    CV_ARRIVED(vB, 16); to_lds<1>(t1, vB, scr, F.lane); finish<1>(t1, scr, F.lane); load(t3, vB, F.lane);
    CV_ARRIVED(vA, 16); to_lds<1>(t2, vA, scr, F.lane); finish<1>(t2, scr, F.lane);
    CV_ARRIVED(vB, 0);  to_lds<1>(t3, vB, scr, F.lane); finish<1>(t3, scr, F.lane);
}
__device__ __forceinline__ void run_half(Frame& F, int base16) {
    LAS float* scr = (LAS float*)(F.lds + F.wave * 16384);
    const int i0 = base16 + 2 * F.wave;
    f32x4 vA[16], vB[16];
    const Item t0 = decode(F, i0), t1 = decode(F, i0 + 1);
    load(t0, vA, F.lane); load(t1, vB, F.lane);
    CV_ARRIVED(vA, 16); to_lds<1>(t0, vA, scr, F.lane); finish<1>(t0, scr, F.lane);
    CV_ARRIVED(vB, 0);  to_lds<1>(t1, vB, scr, F.lane); finish<1>(t1, scr, F.lane);
#undef CV_ARRIVED
}
__device__ __forceinline__ int batch_base(int l, int id) { return id < NB_GU ? N_PROJ + l * (NE * I_GU) + id * BATCH_ITEMS : N_PROJ + N_GU + l * (NE * I_DN) + (id - NB_GU) * BATCH_ITEMS; }
__device__ __forceinline__ int tail_batches(int l) { return l >= 1 ? 160 : 0; }
}
__device__ __forceinline__ void conv_one(Frame& F, int l, bool tail = false) {
    { int _t = (F.wave << 6) | lane_id(); asm volatile("" : "+v"(_t)); F.tid = _t; F.lane = _t & 63; }
    volatile LAS int* sq = (volatile LAS int*)(F.lds + MISC_OFF + 1024);
    unsigned* head = (unsigned*)(F.ctl + CW_Q + 64 * l + (tail ? 40 : 32));
    __syncthreads();
    if (F.tid == 0) *sq = (int)xb_add(head, 1u);
    __syncthreads();
    const int id = __builtin_amdgcn_readfirstlane(*sq);
    __syncthreads();
    const int nbm = cv::NB_LAYER - cv::tail_batches(l);
    if (tail) { if (id < 2 * cv::tail_batches(l)) cv::run_half(F, cv::batch_base(l, nbm + (id >> 1)) + 16 * (id & 1)); }
    else if (id < nbm) cv::run_batch(F, cv::batch_base(l, id));
    __syncthreads();
}
__device__ __forceinline__ void p0_convert(Frame& F) {
    const int gw = F.vcu * NWAVES + F.wave, NGW = F.G * NWAVES;
    bf16_t* win_t = (bf16_t*)(F.ws + WS_WIN);
    for (int i = gw * 64 + F.lane; i < DEPTH * 128 * D / 8; i += NGW * 64) { const int l = i / (128 * D / 8), r = i % (128 * D / 8);
        *(u32x4*)(win_t + ((size_t)l * PP + INW) * D + (size_t)r * 8) = (u32x4){0u, 0u, 0u, 0u}; }
    cv::run(F, gw, NGW, cv::N_PROJ);
    __syncthreads();
}

__device__ __forceinline__ void modnorm_store(const f32x4 (&v)[4], const float* nw, const float* scale, const float* shift, bf16_t* orow, int lane) {
    float s = 0.f;
#pragma unroll
    for (int j = 0; j < 4; ++j) s += (v[j].x * v[j].x + v[j].y * v[j].y) + (v[j].z * v[j].z + v[j].w * v[j].w);
    const float rstd = 1.0f / sqrtf(wave_sum(s) * (1.0f / D) + NORM_EPS);
#pragma unroll
    for (int j = 0; j < 4; ++j) { const int k = 4 * lane + 256 * j; const f32x4 w = *(const f32x4*)(nw + k), sc = *(const f32x4*)(scale + k), sh = *(const f32x4*)(shift + k);
        const f32x4 h = v[j] * rstd * w * (sc + 1.0f) + sh;
        u32x2 o; o.x = pk2(h.x, h.y); o.y = pk2(h.z, h.w); *(u32x2*)(orow + k) = o; }
}
__device__ __forceinline__ void p0b_norm(Frame& F) {
    const int gw = F.vcu * NWAVES + F.wave, NGW = F.G * NWAVES;
    const float* mod = (const float*)(F.ws + WS_MOD); bf16_t* hb = (bf16_t*)(F.ws + WS_H);
    for (int tok = gw; tok < T; tok += NGW) { const int b = tok / SEQ; const float* xr = GIN(I_X) + (size_t)tok * D;
        f32x4 v[4];
#pragma unroll
        for (int j = 0; j < 4; ++j) v[j] = *(const f32x4*)(xr + 4 * F.lane + 256 * j);
        modnorm_store(v, GIN(I_NMIX), mod + (size_t)b * 6144 + 1024, mod + (size_t)b * 6144, hb + (size_t)tok * D, F.lane); }
}

__device__ __forceinline__ float sigmoid_f(float x) { return frcp(1.0f + fexp(-x)); }
__device__ __forceinline__ float gelu_tanh(float x) { const float u = 0.7978845608028654f * (x + 0.044715f * x * x * x); return x * frcp(1.0f + fexp(-2.0f * u)); }
constexpr int LRU_WT = 0, LRU_A = 18432, LRU_LS = 68, LRU_B = LRU_A + LCH * LRU_LS * 4, LRU_SEG = LRU_B + LCH * LRU_LS * 4, LRU_CARRY = LRU_SEG + 4096;
__device__ __forceinline__ void lru_unit(Frame& F, int l, int b, int g, int c4) {
    const int tid = F.tid, lane = F.lane, wave = F.wave;
    LAS unsigned char* lds = F.lds;
    const bf16_t* proj = (const bf16_t*)(F.ws + WS_PROJ);
    float* lrusum = (float*)(F.ws + WS_LRUSUM);
    const int gc0 = l * 384 + g * 64;
    { const float* wa = GIN(I_WA) + ((size_t)l * 6 + g) * 4096; const float* wx = GIN(I_WX) + ((size_t)l * 6 + g) * 4096;
      for (int idx = tid; idx < 8192; idx += 512) { const int gate = idx >> 12, i = (idx >> 6) & 63, j = idx & 63; const float v = (gate ? wx : wa)[i * 64 + j];
          *(LAS unsigned short*)(lds + LRU_WT + (gate * 64 + j) * 144 + i * 2) = (unsigned short)f2bf(v); } }
    float bavq[4], bxvq[4], c8q[4];
#pragma unroll
    for (int nt = 0; nt < 4; ++nt) { const int chq = 16 * nt + (lane & 15); bavq[nt] = GIN(I_BA)[gc0 + chq]; bxvq[nt] = GIN(I_BX)[gc0 + chq]; c8q[nt] = -8.0f * log1pf(__expf(-GIN(I_LAM)[gc0 + chq])); }
    u32x4 xq[2][4];
    { const int pos0 = 4 * c4 * LCH + wave * 16 + (lane & 15);
#pragma unroll
      for (int ks = 0; ks < 2; ++ks)
#pragma unroll
          for (int w = 0; w < 4; ++w) { const int p = pos0 - 3 + w; xq[ks][w] = (u32x4){0u, 0u, 0u, 0u}; if (p >= 0) xq[ks][w] = *(const u32x4*)(proj + (size_t)(b * SEQ + p) * PP + C_LX + g * 64 + 32 * ks + 8 * (lane >> 4)); } }
    __syncthreads();
#pragma unroll 1
  for (int c = 4 * c4; c < 4 * c4 + 4; ++c) {
    const int tt = lane & 15, kg = lane >> 4;
    const int tl = wave * 16 + tt;
    const int pos = c * LCH + tl;
    bf16x8 af[2];
    u32x4 xc[2][4];
#pragma unroll
    for (int ks = 0; ks < 2; ++ks)
#pragma unroll
        for (int w = 0; w < 4; ++w) xc[ks][w] = xq[ks][w];
    if (c + 1 < 4 * c4 + 4) {
#pragma unroll
        for (int ks = 0; ks < 2; ++ks)
#pragma unroll
            for (int w = 0; w < 4; ++w) xq[ks][w] = *(const u32x4*)(proj + (size_t)(b * SEQ + pos + LCH - 3 + w) * PP + C_LX + g * 64 + 32 * ks + 8 * kg); }
#pragma unroll
    for (int ks = 0; ks < 2; ++ks) { const int ch0 = 32 * ks + 8 * kg; float u[8];
        { const f32x4 cb0 = *(const f32x4*)(GIN(I_CONVB) + gc0 + ch0), cb1 = *(const f32x4*)(GIN(I_CONVB) + gc0 + ch0 + 4);
          u[0] = cb0.x; u[1] = cb0.y; u[2] = cb0.z; u[3] = cb0.w; u[4] = cb1.x; u[5] = cb1.y; u[6] = cb1.z; u[7] = cb1.w; }
#pragma unroll
        for (int w = 0; w < 4; ++w) { const int p = pos - 3 + w;
            if (p >= 0) { const u32x4 xv = xc[ks][w];
                const float* cw = GIN(I_CONVW) + (size_t)l * 4 * 384 + w * 384 + g * 64 + ch0; const f32x4 w0 = *(const f32x4*)cw, w1 = *(const f32x4*)(cw + 4);
                u[0] += bflo(xv.x) * w0.x; u[1] += bfhi(xv.x) * w0.y; u[2] += bflo(xv.y) * w0.z; u[3] += bfhi(xv.y) * w0.w;
                u[4] += bflo(xv.z) * w1.x; u[5] += bfhi(xv.z) * w1.y; u[6] += bflo(xv.w) * w1.z; u[7] += bfhi(xv.w) * w1.w; } }
        LAS float* ub = (LAS float*)(lds + LRU_B) + tl * LRU_LS + ch0;
        *(LAS f32x4*)ub = (f32x4){u[0], u[1], u[2], u[3]}; *(LAS f32x4*)(ub + 4) = (f32x4){u[4], u[5], u[6], u[7]};
        u32x4 pk; pk.x = pk2(u[0], u[1]); pk.y = pk2(u[2], u[3]); pk.z = pk2(u[4], u[5]); pk.w = pk2(u[6], u[7]); af[ks] = __builtin_bit_cast(bf16x8, pk); }
    LDS_WAIT(); asm volatile("" ::: "memory");
#pragma unroll
    for (int nt = 0; nt < 4; ++nt) { f32x4 pa = (f32x4){0.f, 0.f, 0.f, 0.f}, px = pa;
#pragma unroll
        for (int ks = 0; ks < 2; ++ks) { const bf16x8 ba = *(const LAS bf16x8*)(lds + LRU_WT + (16 * nt + tt) * 144 + (32 * ks + 8 * kg) * 2);
            const bf16x8 bx = *(const LAS bf16x8*)(lds + LRU_WT + (64 + 16 * nt + tt) * 144 + (32 * ks + 8 * kg) * 2);
            pa = __builtin_amdgcn_mfma_f32_16x16x32_bf16(af[ks], ba, pa, 0, 0, 0); px = __builtin_amdgcn_mfma_f32_16x16x32_bf16(af[ks], bx, px, 0, 0, 0); }
        const int ch = 16 * nt + tt; const float bav = bavq[nt], bxv = bxvq[nt], c8 = c8q[nt];
#pragma unroll
        for (int j = 0; j < 4; ++j) { const int t2 = wave * 16 + 4 * kg + j;
            const float r = sigmoid_f(pa[j] + bav), ii = sigmoid_f(px[j] + bxv), la = c8 * r, a = fexp(la), bc = __builtin_amdgcn_sqrtf(fmaxf(1.0f - a * a, 0.f));
            LAS float* pb = (LAS float*)(lds + LRU_B) + t2 * LRU_LS + ch; const float uv = *pb;
            *((LAS float*)(lds + LRU_A) + t2 * LRU_LS + ch) = a; *pb = bc * ii * uv; } }
    __syncthreads();
    const int ch = tid & 63, seg = tid >> 6;
    const LAS float* Ab = (const LAS float*)(lds + LRU_A) + (seg * 16) * LRU_LS + ch; const LAS float* Bb = (const LAS float*)(lds + LRU_B) + (seg * 16) * LRU_LS + ch;
    float ar[16], br[16];
    { float h = 0.f, A = 1.f;
#pragma unroll
      for (int t = 0; t < 16; ++t) { ar[t] = Ab[t * LRU_LS]; br[t] = Bb[t * LRU_LS]; }
#pragma unroll
      for (int t = 0; t < 16; ++t) { h = ar[t] * h + br[t]; A *= ar[t]; }
      LAS float* sg = (LAS float*)(lds + LRU_SEG); sg[(seg * 2) * 64 + ch] = A; sg[(seg * 2 + 1) * 64 + ch] = h; }
    __syncthreads();
    const LAS float* sg = (const LAS float*)(lds + LRU_SEG);
    if (tid < 64) { float H = 0.f, At = 1.f;
#pragma unroll
        for (int s = 0; s < 8; ++s) { const float a = sg[(s * 2) * 64 + ch]; H = a * H + sg[(s * 2 + 1) * 64 + ch]; At *= a; }
        float* o = lrusum + (((size_t)(b * 6 + g) * NLCH + c) * 2) * 64; o[ch] = At; o[64 + ch] = H; }
    { float h = 0.f, A = 1.f;
#pragma unroll
      for (int s = 0; s < 8; ++s) if (s < seg) { const float a = sg[(s * 2) * 64 + ch]; h = a * h + sg[(s * 2 + 1) * 64 + ch]; A *= a; }
      bf16_t* lh = (bf16_t*)(F.ws + WS_LRUH); bf16_t* la = (bf16_t*)(F.ws + WS_LRUA);
      const size_t row0 = (size_t)b * SEQ + c * LCH + seg * 16;
#pragma unroll
      for (int t = 0; t < 16; ++t) { const float a = ar[t]; h = a * h + br[t]; A *= a; const unsigned w = cvtpk(h, A);
          lh[(row0 + t) * 384 + g * 64 + ch] = (bf16_t)(w & 0xffffu); la[(row0 + t) * 384 + g * 64 + ch] = (bf16_t)(w >> 16); } }
    __syncthreads();
  }
}
__device__ __forceinline__ void lru_fix(Frame& F, int b, int g, int c) {
    const int tid = F.tid, ch = tid & 63, seg = tid >> 6;
    const float* lrusum = (const float*)(F.ws + WS_LRUSUM);
    LAS float* cy = (LAS float*)(F.lds + LRU_CARRY);
    if (tid < 64) { const float* s0 = lrusum + ((size_t)(b * 6 + g) * NLCH) * 128; float sa[NLCH], sh[NLCH];
#pragma unroll
        for (int cc = 0; cc < NLCH; ++cc) { sa[cc] = (cc < c) ? s0[cc * 128 + ch] : 1.0f; sh[cc] = (cc < c) ? s0[cc * 128 + 64 + ch] : 0.0f; }
        float hin = 0.f;
#pragma unroll
        for (int cc = 0; cc < NLCH; ++cc) hin = sa[cc] * hin + sh[cc];
        cy[ch] = hin; }
    const bf16_t* proj = (const bf16_t*)(F.ws + WS_PROJ); const bf16_t* lh = (const bf16_t*)(F.ws + WS_LRUH); const bf16_t* la = (const bf16_t*)(F.ws + WS_LRUA); bf16_t* ymix = (bf16_t*)(F.ws + WS_YMIX);
    const int tl = tid >> 2, c0 = 16 * (tid & 3);
    const size_t row = (size_t)b * SEQ + c * LCH + tl;
    const u32x4 g0 = *(const u32x4*)(proj + row * PP + C_LG + g * 64 + c0), g1 = *(const u32x4*)(proj + row * PP + C_LG + g * 64 + c0 + 8);
    const u32x4 h0 = *(const u32x4*)(lh + row * 384 + g * 64 + c0), h1 = *(const u32x4*)(lh + row * 384 + g * 64 + c0 + 8);
    const u32x4 a0 = *(const u32x4*)(la + row * 384 + g * 64 + c0), a1 = *(const u32x4*)(la + row * 384 + g * 64 + c0 + 8);
    __syncthreads();
    const unsigned gw[8] = {g0.x, g0.y, g0.z, g0.w, g1.x, g1.y, g1.z, g1.w}, hw[8] = {h0.x, h0.y, h0.z, h0.w, h1.x, h1.y, h1.z, h1.w}, aw[8] = {a0.x, a0.y, a0.z, a0.w, a1.x, a1.y, a1.z, a1.w};
    unsigned ow[8];
#pragma unroll
    for (int i = 0; i < 8; ++i) { const float hin0 = cy[c0 + 2 * i], hin1 = cy[c0 + 2 * i + 1];
        const float y0 = gelu_tanh(bflo(gw[i])) * (bflo(hw[i]) + bflo(aw[i]) * hin0), y1 = gelu_tanh(bfhi(gw[i])) * (bfhi(hw[i]) + bfhi(aw[i]) * hin1);
        ow[i] = cvtpk(y0, y1); }
    bf16_t* yp = ymix + row * D + Y_LRU + g * 64 + c0;
    *(u32x4*)yp = (u32x4){ow[0], ow[1], ow[2], ow[3]}; *(u32x4*)(yp + 8) = (u32x4){ow[4], ow[5], ow[6], ow[7]};
    __syncthreads();
}

constexpr int AT_KS = 144;
constexpr int AT_K = 0, AT_V = 2 * 64 * AT_KS;
__device__ __forceinline__ s16x4 vtr(const LAS unsigned char* p) { return __builtin_bit_cast(s16x4, __builtin_amdgcn_ds_read_tr16_b64_v4i16((LAS v4i16_t*)p)); }
template <int MODE>
__device__ __forceinline__ void attn_unit(Frame& F, int l, int b, int h, int qb) {
    const int tid = F.tid, lane = F.lane, wave = F.wave;
    LAS unsigned char* lds = F.lds;
    const bf16_t* proj = (const bf16_t*)(F.ws + WS_PROJ); bf16_t* ymix = (bf16_t*)(F.ws + WS_YMIX);
    const int colQ = (MODE == 0 ? C_MQ : C_RQ) + h * 64, colK = (MODE == 0 ? C_MK : C_RK) + h * 64, colV = (MODE == 0 ? C_MV : C_RV) + h * 64;
    const int ql = lane & 15, g4 = lane >> 4;
    const size_t rowb = (size_t)b * SEQ;
    int qidx[2]; bf16x8 qf[2][2];
#pragma unroll
    for (int mt = 0; mt < 2; ++mt) { qidx[mt] = qb * 256 + wave * 32 + mt * 16 + ql;
#pragma unroll
        for (int ks = 0; ks < 2; ++ks) qf[mt][ks] = *(const bf16x8*)(proj + (rowb + qidx[mt]) * PP + colQ + 32 * ks + 8 * g4); }
    const int own = qb;
    unsigned amask[2] = {0u, 0u};
    if constexpr (MODE == 0) {
        const float* km = (const float*)(F.ws + WS_KMEAN) + ((size_t)(b * 6 + h) * 8) * 64;
#pragma unroll
        for (int mt = 0; mt < 2; ++mt) { float gs[8];
#pragma unroll
            for (int n = 0; n < 8; ++n) { float s = 0.f;
                if (n < own) {
#pragma unroll
                    for (int ks = 0; ks < 2; ++ks) { const f32x4 k0 = *(const f32x4*)(km + n * 64 + 32 * ks + 8 * g4), k1 = *(const f32x4*)(km + n * 64 + 32 * ks + 8 * g4 + 4);
                        const u32x4 qw = __builtin_bit_cast(u32x4, qf[mt][ks]);
                        s += bflo(qw.x) * k0.x + bfhi(qw.x) * k0.y + bflo(qw.y) * k0.z + bfhi(qw.y) * k0.w + bflo(qw.z) * k1.x + bfhi(qw.z) * k1.y + bflo(qw.w) * k1.z + bfhi(qw.w) * k1.w; } }
                s += __shfl_xor(s, 16); s += __shfl_xor(s, 32);
                gs[n] = (n < own) ? s : -INFINITY; }
#pragma unroll
            for (int n = 0; n < 8; ++n) { int cnt = 0;
#pragma unroll
                for (int m = 0; m < 8; ++m) if (m != n) cnt += (gs[m] > gs[n] || (gs[m] == gs[n] && m < n)) ? 1 : 0;
                if (n < own && cnt < 3) amask[mt] |= (1u << n); } }
    }
    const float log2g = (MODE == 1) ? log2f(1.0f - exp2f(-5.0f - (float)h)) : 0.f;
    float dc[4][4];
    if constexpr (MODE == 1) {
#pragma unroll
        for (int t = 0; t < 4; ++t)
#pragma unroll
            for (int j = 0; j < 4; ++j) dc[t][j] = ex2(-(float)(16 * t + 4 * g4 + j) * log2g);
    }
    const int lt = tid & 255, lrow = lt >> 2, lc = lt & 3;
    const bf16_t* gsrc = proj + (rowb + lrow) * PP + (tid < 256 ? colK : colV) + lc * 8;
    const int ldst = (tid < 256 ? AT_K : AT_V) + lrow * AT_KS + lc * 16;
    const int nkt = 4 * qb + 4;
    u32x4 pre0 = *(const u32x4*)(gsrc), pre1 = *(const u32x4*)(gsrc + 32);
    *(LAS u32x4*)(lds + ldst) = pre0; *(LAS u32x4*)(lds + ldst + 64) = pre1;
    __syncthreads();
    f32x4 o[2][4];
#pragma unroll
    for (int mt = 0; mt < 2; ++mt)
#pragma unroll
        for (int dt = 0; dt < 4; ++dt) o[mt][dt] = (f32x4){0.f, 0.f, 0.f, 0.f};
    float mrun[2] = {-1e30f, -1e30f}, lsum[2] = {0.f, 0.f};
    const int li = lane & 15, tq = li >> 2, tp = li & 3;
    auto tile = [&](const int kt, auto diag_c) {
        constexpr bool diag = decltype(diag_c)::value;
        const int buf = kt & 1;
        if (kt + 1 < nkt) { const bf16_t* gp = gsrc + (size_t)(kt + 1) * 64 * PP; pre0 = *(const u32x4*)(gp); pre1 = *(const u32x4*)(gp + 32); }
        f32x4 s[2][4];
        const LAS unsigned char* kb = lds + AT_K + buf * 64 * AT_KS;
#pragma unroll
        for (int t = 0; t < 4; ++t) { s[0][t] = (f32x4){0.f, 0.f, 0.f, 0.f}; s[1][t] = (f32x4){0.f, 0.f, 0.f, 0.f};
#pragma unroll
            for (int ks = 0; ks < 2; ++ks) { const bf16x8 kf = *(const LAS bf16x8*)(kb + (16 * t + ql) * AT_KS + (32 * ks + 8 * g4) * 2);
                s[0][t] = __builtin_amdgcn_mfma_f32_16x16x32_bf16(kf, qf[0][ks], s[0][t], 0, 0, 0);
                s[1][t] = __builtin_amdgcn_mfma_f32_16x16x32_bf16(kf, qf[1][ks], s[1][t], 0, 0, 0); } }
        bf16x8 pf[2][2];
#pragma unroll
        for (int mt = 0; mt < 2; ++mt) {
            float p[4][4];
            if constexpr (MODE == 0) {
                constexpr float SC = 0.125f * 1.4426950408889634f;
                const int kblk = kt >> 2;
                const bool allow = !(kblk < own && ((amask[mt] >> kblk) & 1u) == 0u);
                float mx = -INFINITY;
#pragma unroll
                for (int t = 0; t < 4; ++t)
#pragma unroll
                    for (int j = 0; j < 4; ++j) { float v = s[mt][t][j];
                        if constexpr (diag) { const int key = kt * 64 + 16 * t + 4 * g4 + j; v = (key <= qidx[mt]) ? v : -INFINITY; }
                        p[t][j] = v; mx = fmaxf(mx, v); }
                mx = allow ? mx * SC : -INFINITY;
                mx = fmaxf(mx, __shfl_xor(mx, 16)); mx = fmaxf(mx, __shfl_xor(mx, 32));
                const float mnew = fmaxf(mrun[mt], mx), alpha = ex2(mrun[mt] - mnew); mrun[mt] = mnew;
                const float nb = allow ? -mnew : -INFINITY;
                float ps = 0.f;
#pragma unroll
                for (int t = 0; t < 4; ++t)
#pragma unroll
                    for (int j = 0; j < 4; ++j) { const float e = ex2(fmaf(p[t][j], SC, nb)); p[t][j] = e; ps += e; }
                lsum[mt] = lsum[mt] * alpha + ps;
#pragma unroll
                for (int dt = 0; dt < 4; ++dt) o[mt][dt] = o[mt][dt] * alpha;
            } else {
                const float at = ex2((float)(qidx[mt] - kt * 64) * log2g);
#pragma unroll
                for (int t = 0; t < 4; ++t)
#pragma unroll
                    for (int j = 0; j < 4; ++j) { float v = s[mt][t][j] * (at * dc[t][j]);
                        if constexpr (diag) { const int key = kt * 64 + 16 * t + 4 * g4 + j; v = (key <= qidx[mt]) ? v : 0.f; }
                        p[t][j] = v; }
            }
#pragma unroll
            for (int s2 = 0; s2 < 2; ++s2) { u32x4 w; w.x = cvtpk(p[2 * s2][0], p[2 * s2][1]); w.y = cvtpk(p[2 * s2][2], p[2 * s2][3]); w.z = cvtpk(p[2 * s2 + 1][0], p[2 * s2 + 1][1]); w.w = cvtpk(p[2 * s2 + 1][2], p[2 * s2 + 1][3]);
                pf[mt][s2] = __builtin_bit_cast(bf16x8, w); }
        }
        const LAS unsigned char* vb = lds + AT_V + buf * 64 * AT_KS;
#pragma unroll
        for (int dt = 0; dt < 4; ++dt)
#pragma unroll
            for (int s2 = 0; s2 < 2; ++s2) { const s16x4 v0 = vtr(vb + (32 * s2 + 4 * g4 + tq) * AT_KS + (16 * dt + 4 * tp) * 2), v1 = vtr(vb + (32 * s2 + 16 + 4 * g4 + tq) * AT_KS + (16 * dt + 4 * tp) * 2);
                bf16x8 vf; vf[0] = v0[0]; vf[1] = v0[1]; vf[2] = v0[2]; vf[3] = v0[3]; vf[4] = v1[0]; vf[5] = v1[1]; vf[6] = v1[2]; vf[7] = v1[3];
                o[0][dt] = __builtin_amdgcn_mfma_f32_16x16x32_bf16(vf, pf[0][s2], o[0][dt], 0, 0, 0);
                o[1][dt] = __builtin_amdgcn_mfma_f32_16x16x32_bf16(vf, pf[1][s2], o[1][dt], 0, 0, 0); }
        if (kt + 1 < nkt) { const int nb = (buf ^ 1) * 64 * AT_KS; *(LAS u32x4*)(lds + ldst + nb) = pre0; *(LAS u32x4*)(lds + ldst + nb + 64) = pre1; }
        __syncthreads();
    };
    for (int kt = 0; kt < 4 * qb; ++kt) tile(kt, std::false_type{});
    for (int kt = 4 * qb; kt < nkt; ++kt) tile(kt, std::true_type{});
#pragma unroll
    for (int mt = 0; mt < 2; ++mt) {
        if constexpr (MODE == 0) {
            float ls = lsum[mt]; ls += __shfl_xor(ls, 16); ls += __shfl_xor(ls, 32);
            const float inv = 1.0f / ls;
#pragma unroll
            for (int dt = 0; dt < 4; ++dt) { const f32x4 v = o[mt][dt] * inv; u32x2 w; w.x = cvtpk(v.x, v.y); w.y = cvtpk(v.z, v.w);
                *(u32x2*)(ymix + (rowb + qidx[mt]) * D + Y_MOBA + h * 64 + 16 * dt + 4 * g4) = w; }
        } else {
            float sm = 0.f;
#pragma unroll
            for (int dt = 0; dt < 4; ++dt) sm += (o[mt][dt].x + o[mt][dt].y) + (o[mt][dt].z + o[mt][dt].w);
            sm += __shfl_xor(sm, 16); sm += __shfl_xor(sm, 32);
            const float mu = sm * (1.0f / 64.0f); float vs = 0.f;
#pragma unroll
            for (int dt = 0; dt < 4; ++dt) { const f32x4 dv = o[mt][dt] - mu; vs += (dv.x * dv.x + dv.y * dv.y) + (dv.z * dv.z + dv.w * dv.w); }
            vs += __shfl_xor(vs, 16); vs += __shfl_xor(vs, 32);
            const float rstd = 1.0f / sqrtf(vs * (1.0f / 64.0f) + NORM_EPS);
#pragma unroll
            for (int dt = 0; dt < 4; ++dt) { const int d0 = h * 64 + 16 * dt + 4 * g4;
                const f32x4 nw = *(const f32x4*)(GIN(I_RETNW) + l * 256 + d0);
                const u32x2 gw2 = *(const u32x2*)(proj + (rowb + qidx[mt]) * PP + C_RG + d0);
                const float g0 = bflo(gw2.x), g1 = bfhi(gw2.x), g2 = bflo(gw2.y), g3 = bfhi(gw2.y);
                const f32x4 y = (o[mt][dt] - mu) * rstd * nw;
                u32x2 w; w.x = cvtpk(y.x * silu_f(g0), y.y * silu_f(g1)); w.y = cvtpk(y.z * silu_f(g2), y.w * silu_f(g3));
                *(u32x2*)(ymix + (rowb + qidx[mt]) * D + Y_RET + d0) = w; }
        }
    }
}

__device__ __forceinline__ void p2a(Frame& F, int l, int rep) {
    for (int u = F.bx; u < BATCH * 6 * (NLCH / 4); u += F.G) lru_unit(F, l, u / (6 * (NLCH / 4)), (u / (NLCH / 4)) % 6, u % (NLCH / 4));
    if (rep == 0 && F.bx >= BATCH * 6 * (NLCH / 4)) conv_one(F, l);
    bf16_t* proj = (bf16_t*)(F.ws + WS_PROJ);
    for (int u = (F.G - 1 - F.bx); u < BATCH * 6; u += F.G) { const int b = u / 6, h = u % 6, rg = F.lane >> 3, c8 = F.lane & 7;
        const bf16_t* kp = proj + ((size_t)b * SEQ + F.wave * 256 + rg) * PP + C_MK + h * 64 + c8 * 8;
        float a[8];
#pragma unroll
        for (int i = 0; i < 8; ++i) a[i] = 0.f;
#pragma unroll 4
        for (int it = 0; it < 32; ++it) { const u32x4 v = *(const u32x4*)(kp + (size_t)it * 8 * PP);
            a[0] += bflo(v.x); a[1] += bfhi(v.x); a[2] += bflo(v.y); a[3] += bfhi(v.y); a[4] += bflo(v.z); a[5] += bfhi(v.z); a[6] += bflo(v.w); a[7] += bfhi(v.w); }
#pragma unroll
        for (int i = 0; i < 8; ++i) { a[i] += __shfl_xor(a[i], 8); a[i] += __shfl_xor(a[i], 16); a[i] += __shfl_xor(a[i], 32); }
        if (rg == 0) { float* o = (float*)(F.ws + WS_KMEAN) + ((size_t)(b * 6 + h) * 8 + F.wave) * 64 + c8 * 8;
            *(f32x4*)o = (f32x4){a[0], a[1], a[2], a[3]} * (1.0f / 256.0f); *(f32x4*)(o + 4) = (f32x4){a[4], a[5], a[6], a[7]} * (1.0f / 256.0f); } }
    const int gw = F.vcu * NWAVES + F.wave, NGW = F.G * NWAVES;
    const float* rc = (const float*)(F.ws + WS_ROT); const float* rs = rc + SEQ * 32;
    const int which = F.lane >> 5, hh = (F.lane >> 3) & 3, i0 = (F.lane & 7) * 4;
    if (rep == 0) for (int tok = gw; tok < T; tok += NGW) { const int pos = tok % SEQ;
        bf16_t* p = proj + (size_t)tok * PP + which * 256 + hh * 64 + i0;
        const u32x2 a = *(const u32x2*)p, bb = *(const u32x2*)(p + 32);
        const f32x4 cs = *(const f32x4*)(rc + pos * 32 + i0), sn = *(const f32x4*)(rs + pos * 32 + i0);
        const float x1[4] = {bflo(a.x), bfhi(a.x), bflo(a.y), bfhi(a.y)}, x2[4] = {bflo(bb.x), bfhi(bb.x), bflo(bb.y), bfhi(bb.y)};
        const float sc = which ? 0.125f : 1.0f; float y1[4], y2[4];
#pragma unroll
        for (int i = 0; i < 4; ++i) { y1[i] = (x1[i] * cs[i] - x2[i] * sn[i]) * sc; y2[i] = (x2[i] * cs[i] + x1[i] * sn[i]) * sc; }
        u32x2 o1, o2; o1.x = pk2(y1[0], y1[1]); o1.y = pk2(y1[2], y1[3]); o2.x = pk2(y2[0], y2[1]); o2.y = pk2(y2[2], y2[3]);
        *(u32x2*)p = o1; *(u32x2*)(p + 32) = o2; }
}

__device__ __forceinline__ void p2b(Frame& F, int l, int rep) {
    volatile LAS int* sq = (volatile LAS int*)(F.lds + MISC_OFF + 1024);
    unsigned* head = (unsigned*)(F.ctl + CW_Q + 64 * l + rep);
    constexpr int N_ATT = 8 * 80, N_ALL = N_ATT + BATCH * 6 * NLCH;
    int q = (((F.bx >> 3) & 7) < 3) ? 1 : 0;
#pragma unroll 1
    for (int pass = 0; pass < 2; ++pass, q ^= 1) {
        q = __builtin_amdgcn_readfirstlane(q);
        { int _t = (F.wave << 6) | lane_id(); asm volatile("" : "+v"(_t)); F.tid = _t; F.lane = _t & 63;
          GAS unsigned char* _w = (GAS unsigned char*)F.ws; asm volatile("" : "+s"(_w)); F.ws = (unsigned char*)_w; F.ctl = (gu32*)(F.ws + WS_CTL); }
        if (q == 0) {
            for (;;) {
                if (F.tid == 0) *sq = (int)xb_add(head, 1u);
                __syncthreads();
                const int id = __builtin_amdgcn_readfirstlane(*sq);
                __syncthreads();
                if (id >= N_ALL) break;
                if (id < N_ATT) { const int qi = 7 - id / 80, r = id % 80;
                    if (r < 48) attn_unit<0>(F, l, r / 6, r % 6, qi); else attn_unit<1>(F, l, (r - 48) / 4, (r - 48) % 4, qi); }
                else { const int u = id - N_ATT; lru_fix(F, u / (6 * NLCH), (u / NLCH) % 6, u % NLCH); }
            }
        } else {
            unsigned nxt = 0u; unsigned zoff = 0u; asm volatile("" : "+v"(zoff));
            if (F.tid == 0) nxt = xb_add(head + 32 + zoff, 1u);
            for (;;) {
                if (F.tid == 0) *sq = (int)nxt;
                asm volatile("s_waitcnt lgkmcnt(0)\n\ts_barrier" ::: "memory");
                const int id = __builtin_amdgcn_readfirstlane(*sq);
                asm volatile("s_waitcnt lgkmcnt(0)\n\ts_barrier" ::: "memory");
                if (id >= cv::NB_LAYER - cv::tail_batches(l)) break;
                if (F.tid == 0) nxt = xb_add(head + 32 + zoff, 1u);
                cv::run_batch(F, cv::batch_base(l, id));
            }
            if (cv::tail_batches(l) > 0) for (;;) {
                if (F.tid == 0) *sq = (int)xb_add(head + 40 + zoff, 1u);
                asm volatile("s_waitcnt lgkmcnt(0)\n\ts_barrier" ::: "memory");
                const int id = __builtin_amdgcn_readfirstlane(*sq);
                asm volatile("s_waitcnt lgkmcnt(0)\n\ts_barrier" ::: "memory");
                if (id >= 2 * cv::tail_batches(l)) break;
                cv::run_half(F, cv::batch_base(l, cv::NB_LAYER - cv::tail_batches(l) + (id >> 1)) + 16 * (id & 1));
            }
        }
    }
}

constexpr int P4_SELE = MISC_OFF + 2048, P4_SELG = P4_SELE + 1024, P4_HIST = P4_SELG + 1024, P4_BASE = P4_HIST + 128, P4_RANK = P4_BASE + 128;
constexpr int P4_AS = 2064;
constexpr int P4_AHI = 0, P4_ALO = 16 * P4_AS, P4_PART = 2 * 16 * P4_AS, P4_LOG = P4_PART + 8 * 16 * 32 * 4;
__device__ __forceinline__ void p4_router(Frame& F, int l) {
    LAS unsigned char* lds = F.lds;
    LAS int* selE = (LAS int*)(lds + P4_SELE); LAS float* selG = (LAS float*)(lds + P4_SELG);
    LAS int* hist = (LAS int*)(lds + P4_HIST); LAS int* base = (LAS int*)(lds + P4_BASE); LAS int* lrank = (LAS int*)(lds + P4_RANK);
    const float* mod = (const float*)(F.ws + WS_MOD) + (size_t)l * BATCH * 6144;
    const bf16_t* x1 = (const bf16_t*)(F.ws + WS_X1); unsigned char* hb8 = (unsigned char*)(F.ws + WS_H8);
    i32x2* slot = (i32x2*)(F.ws + WS_SLOT);
    unsigned* cntg = (unsigned*)(F.ctl + CW_CNT + 64 * l);
    const int lane = F.lane, wave = F.wave, tid = F.tid, tt = lane & 15, g4 = lane >> 4;
    bf16x8 bh[2][4], bl[2][4];
    { const bf16_t* rwt = (const bf16_t*)(F.ws + WS_RWT) + (size_t)l * 2 * NE * D;
#pragma unroll
      for (int nt = 0; nt < 2; ++nt)
#pragma unroll
          for (int ks = 0; ks < 4; ++ks) { const size_t o = (size_t)(16 * nt + tt) * D + 128 * wave + 32 * ks + 8 * g4; bh[nt][ks] = *(const bf16x8*)(rwt + o); bl[nt][ks] = *(const bf16x8*)(rwt + (size_t)NE * D + o); } }
    for (int tg = F.bx; tg < T / 64; tg += F.G) {
        if (tid < 32) hist[tid] = 0;
        const int tok0 = tg * 64, b = tok0 / SEQ;
        f32x4 mA[4], mB[4];
#pragma unroll
        for (int j = 0; j < 4; ++j) { const int k = 4 * lane + 256 * j; const f32x4 w = *(const f32x4*)(GIN(I_NFFN) + l * D + k), sc = *(const f32x4*)(mod + (size_t)b * 6144 + 4096 + k);
            mA[j] = w * (sc + 1.0f); mB[j] = *(const f32x4*)(mod + (size_t)b * 6144 + 3072 + k); }
#pragma unroll 1
        for (int grp = 0; grp < 4; ++grp) {
            { f32x4 v[2][4];
#pragma unroll
              for (int q = 0; q < 2; ++q)
#pragma unroll
                  for (int j = 0; j < 4; ++j) { const u32x2 w = *(const u32x2*)(x1 + ((size_t)tok0 + grp * 16 + 2 * wave + q) * D + 4 * lane + 256 * j); v[q][j] = (f32x4){bflo(w.x), bfhi(w.x), bflo(w.y), bfhi(w.y)}; }
#pragma unroll
              for (int q = 0; q < 2; ++q) { const int tl = 2 * wave + q; const size_t tok = (size_t)tok0 + grp * 16 + tl; float sa = 0.f;
#pragma unroll
                for (int j = 0; j < 4; ++j) sa += (v[q][j].x * v[q][j].x + v[q][j].y * v[q][j].y) + (v[q][j].z * v[q][j].z + v[q][j].w * v[q][j].w);
                const float ra = 1.0f / sqrtf(wave_sum(sa) * (1.0f / D) + NORM_EPS);
#pragma unroll
                for (int j = 0; j < 4; ++j) { const int k = 4 * lane + 256 * j;
                    const f32x4 hv = v[q][j] * ra * mA[j] + mB[j];
                    u32x2 hi; hi.x = cvtpk(hv.x, hv.y); hi.y = cvtpk(hv.z, hv.w);
                    const f32x4 lo = hv - (f32x4){bflo(hi.x), bfhi(hi.x), bflo(hi.y), bfhi(hi.y)};
                    u32x2 lw; lw.x = cvtpk(lo.x, lo.y); lw.y = cvtpk(lo.z, lo.w);
                    *(unsigned*)(hb8 + tok * D + k) = cvt4_fp8(hv.x, hv.y, hv.z, hv.w);
                    *(LAS u32x2*)(lds + P4_AHI + tl * P4_AS + k * 2) = hi; *(LAS u32x2*)(lds + P4_ALO + tl * P4_AS + k * 2) = lw; } } }
            __syncthreads();
            { f32x4 acc[2] = {(f32x4){0.f, 0.f, 0.f, 0.f}, (f32x4){0.f, 0.f, 0.f, 0.f}};
#pragma unroll
              for (int ks = 0; ks < 4; ++ks) { const int ao = tt * P4_AS + (128 * wave + 32 * ks + 8 * g4) * 2;
                  const bf16x8 ah = *(const LAS bf16x8*)(lds + P4_AHI + ao), al = *(const LAS bf16x8*)(lds + P4_ALO + ao);
#pragma unroll
                  for (int nt = 0; nt < 2; ++nt) { acc[nt] = __builtin_amdgcn_mfma_f32_16x16x32_bf16(ah, bh[nt][ks], acc[nt], 0, 0, 0);
                      acc[nt] = __builtin_amdgcn_mfma_f32_16x16x32_bf16(ah, bl[nt][ks], acc[nt], 0, 0, 0); acc[nt] = __builtin_amdgcn_mfma_f32_16x16x32_bf16(al, bh[nt][ks], acc[nt], 0, 0, 0); } }
              LAS float* part = (LAS float*)(lds + P4_PART) + wave * 512;
#pragma unroll
              for (int nt = 0; nt < 2; ++nt)
#pragma unroll
                  for (int j = 0; j < 4; ++j) part[(4 * g4 + j) * 32 + 16 * nt + tt] = acc[nt][j]; }
            __syncthreads();
            { const LAS float* part = (const LAS float*)(lds + P4_PART); float sum = 0.f;
#pragma unroll
              for (int w = 0; w < 8; ++w) sum += part[w * 512 + tid];
              const int e = tid & 31; float v = sum + GIN(I_RB)[l * NE + e];
              float tv[4]; int te[4];
#pragma unroll
              for (int k = 0; k < 4; ++k) { float bv = v; int be = e;
#pragma unroll
                  for (int msk = 16; msk >= 1; msk >>= 1) { const float ov = __shfl_xor(bv, msk); const int oe = __shfl_xor(be, msk); const bool take = (ov > bv) || (ov == bv && oe < be); bv = take ? ov : bv; be = take ? oe : be; }
                  tv[k] = bv; te[k] = be; if (e == be) v = -INFINITY; }
              if (e == 0) { const float e1 = fexp(tv[1] - tv[0]), e2 = fexp(tv[2] - tv[0]), e3 = fexp(tv[3] - tv[0]), inv = 1.0f / (1.0f + e1 + e2 + e3);
                  const int s0 = (grp * 16 + (tid >> 5)) * 4; selE[s0] = te[0]; selE[s0 + 1] = te[1]; selE[s0 + 2] = te[2]; selE[s0 + 3] = te[3];
                  selG[s0] = inv; selG[s0 + 1] = e1 * inv; selG[s0 + 2] = e2 * inv; selG[s0 + 3] = e3 * inv; } }
        }
        __syncthreads();
        if (tid < 256) lrank[tid] = __hip_atomic_fetch_add(&hist[selE[tid]], 1, __ATOMIC_RELAXED, __HIP_MEMORY_SCOPE_WORKGROUP);
        __syncthreads();
        if (tid < 32) base[tid] = (int)xb_add(cntg + tid, (unsigned)hist[tid]);
        __syncthreads();
        if (tid < 256) { const int e = selE[tid], rank = base[e] + lrank[tid]; i32x2 ent; ent.x = (tok0 + (tid >> 2)) * 4 + (tid & 3); ent.y = __builtin_bit_cast(int, selG[tid]); slot[(size_t)e * CAP + rank] = ent; }
        __syncthreads();
    }
}
__device__ __forceinline__ int moe_table(Frame& F, int l) {
    LAS int* tab = (LAS int*)(F.lds + MISC_OFF + 1536);
    if (F.tid < 32) {
        const int e = F.tid; const int cn = (int)__hip_atomic_load((unsigned*)(F.ctl + CW_CNT + 64 * l + e), RLX_AGENT); const int nb = (cn + 255) >> 8;
        int inc = nb;
#pragma unroll
        for (int d = 1; d < 32; d <<= 1) { const int o = __shfl_up(inc, d); if (e >= d) inc += o; }
        tab[e] = inc - nb; tab[33 + e] = cn; if (e == 31) tab[32] = inc; }
    __syncthreads();
    return __builtin_amdgcn_readfirstlane(tab[32]);
}

__device__ __forceinline__ void p7_combine(Frame& F, int l) {
    const int gw = F.vcu * NWAVES + F.wave, NGW = F.G * NWAVES, lane = F.lane;
    const float* mod = (const float*)(F.ws + WS_MOD);
    const bf16_t* x1 = (const bf16_t*)(F.ws + WS_X1); bf16_t* x2 = (bf16_t*)(F.ws + WS_X2); const unsigned char* yb = (const unsigned char*)(F.ws + WS_YBUF); bf16_t* hb = (bf16_t*)(F.ws + WS_H);
    constexpr int TPI = 4;
    for (int t2 = gw; t2 < T / TPI; t2 += NGW) { const int b = (TPI * t2) / SEQ;
        f32x4 v[TPI][4];
#pragma unroll
        for (int q = 0; q < TPI; ++q) { const size_t tok = (size_t)TPI * t2 + q;
#pragma unroll
            for (int j = 0; j < 4; ++j) { const int k = 4 * lane + 256 * j; f32x4 s = (f32x4){0.f, 0.f, 0.f, 0.f};
#pragma unroll
                for (int kk = 0; kk < 4; ++kk) { const unsigned w = *(const unsigned*)(yb + (tok * 4 + kk) * D + k); const f32x2 lo = __builtin_amdgcn_cvt_pk_f32_fp8((int)w, false), hi = __builtin_amdgcn_cvt_pk_f32_fp8((int)w, true); s += (f32x4){lo.x, lo.y, hi.x, hi.y}; }
                s = s * 0.0625f;
                const f32x4 g2 = *(const f32x4*)(mod + ((size_t)l * BATCH + b) * 6144 + 5120 + k);
                const u32x2 xw = *(const u32x2*)(x1 + tok * D + k);
                v[q][j] = (f32x4){bflo(xw.x), bfhi(xw.x), bflo(xw.y), bfhi(xw.y)} + g2 * s * (l == 0 ? DBG_MOE0 : DBG_MOE1); } }
#pragma unroll
        for (int q = 0; q < TPI; ++q) { const size_t tok = (size_t)TPI * t2 + q;
            if (l + 1 < DEPTH) {
#pragma unroll
                for (int j = 0; j < 4; ++j) { u32x2 ow; ow.x = cvtpk(v[q][j].x, v[q][j].y); ow.y = cvtpk(v[q][j].z, v[q][j].w); *(u32x2*)(x2 + tok * D + 4 * lane + 256 * j) = ow; }
                const float* m1 = mod + ((size_t)(l + 1) * BATCH + b) * 6144;
                modnorm_store(v[q], GIN(I_NMIX) + (l + 1) * D, m1 + 1024, m1, hb + tok * D, lane);
            } else {
                float s = 0.f;
#pragma unroll
                for (int j = 0; j < 4; ++j) s += (v[q][j].x * v[q][j].x + v[q][j].y * v[q][j].y) + (v[q][j].z * v[q][j].z + v[q][j].w * v[q][j].w);
                const float rstd = 1.0f / sqrtf(wave_sum(s) * (1.0f / D) + NORM_EPS);
#pragma unroll
                for (int j = 0; j < 4; ++j) { const int k = 4 * lane + 256 * j; *(f32x4*)(F.out + tok * D + k) = v[q][j] * rstd * *(const f32x4*)(GIN(I_FNW) + k); }
            } }
    }
}

constexpr int N_PHASES = 2 + 8 * DEPTH;
struct Args { const float* in[23]; float* out; unsigned char* ws; int ph_lo, ph_hi; };
__global__ void __launch_bounds__(NWAVES * 64, 2) fwd_kernel(Args args) {
    extern __shared__ __attribute__((aligned(16))) unsigned char lds_raw[];
    Frame F;
    F.lds = (LAS unsigned char*)lds_raw;
    F.tid = threadIdx.x; F.lane = F.tid & 63; F.wave = __builtin_amdgcn_readfirstlane(F.tid >> 6);
    const int wv0 = F.wave;
    F.bx = blockIdx.x; F.G = gridDim.x; { const int bx = blockIdx.x; F.vcu = (F.G % 8 == 0) ? (bx % 8) * (F.G / 8) + bx / 8 : bx; }
    F.ws = (unsigned char*)(GAS unsigned char*)args.ws; F.ctl = (gu32*)(F.ws + WS_CTL); F.out = (float*)(GAS float*)args.out;
    F.in = (const CAS PFC*)__builtin_amdgcn_kernarg_segment_ptr();
    volatile LAS unsigned* MISC = (volatile LAS unsigned*)(F.lds + MISC_OFF);
    for (int u = F.tid; u < 256; u += NWAVES * 64) MISC[u] = 0u;
    __syncthreads();
    if (MK_N_LAUNCHES == 1) (void)xcd_barrier_post((unsigned*)(F.ctl + CW_BAR), MISC + 8, F.tid);
    const int lo = (MK_N_LAUNCHES == 1) ? 0 : args.ph_lo, hi = (MK_N_LAUNCHES == 1) ? N_PHASES : args.ph_hi;
#ifndef PH_MASK
#define PH_MASK 0xffff
#endif
#define PHEN(j) (((PH_MASK) >> (j)) & 1)
#define IN(k) (lo <= (k) && (k) < hi)
#define REFRESH() do { int _t = (wv0 << 6) | lane_id(); asm volatile("" : "+v"(_t)); F.tid = _t; F.lane = _t & 63; F.wave = __builtin_amdgcn_readfirstlane(_t >> 6); \
        GAS unsigned char* _w = (GAS unsigned char*)args.ws; asm volatile("" : "+s"(_w)); F.ws = (unsigned char*)_w; F.ctl = (gu32*)(F.ws + WS_CTL);     { const CAS PFC* _p = (const CAS PFC*)__builtin_amdgcn_kernarg_segment_ptr(); asm volatile("" : "+s"(_p)); F.in = _p; }     int _b = blockIdx.x; asm volatile("" : "+s"(_b)); F.bx = _b; } while (0)
#define GRID_BAR(k) do { if (MK_N_LAUNCHES == 1) { XcdBarrier _b; _b.bar = (unsigned*)(F.ctl + CW_BAR); _b.x = xb_xcc_id(); _b.st = (volatile LAS unsigned*)(F.lds + MISC_OFF) + 8; xcd_barrier(_b, (wv0 << 6) | lane_id()); } } while (0)

    if (PHEN(0) && IN(0)) { asm volatile("; PHASE_MARK 0");
#pragma unroll 1
        for (int rep = 0; rep < NREP(0); ++rep) { p0_prologue(F); if (F.bx >= DEPTH * 96) conv_one(F, 0); GRID_BAR(0); } }
    if (PHEN(1) && IN(1)) { asm volatile("; PHASE_MARK 1");
#pragma unroll 1
        for (int rep = 0; rep < NREP(1); ++rep) { p0b_norm(F); p0_convert(F); GRID_BAR(1); } }
#pragma unroll 1
    for (int l = 0; l < DEPTH; ++l) {
        const int pb = 2 + 8 * l;
        const float* mod = (const float*)(F.ws + WS_MOD) + (size_t)l * BATCH * 6144;
        if (PHEN(2) && IN(pb + 0)) { asm volatile("; PHASE_MARK 2");
#pragma unroll 1
          for (int rep = 0; rep < NREP(2); ++rep) { REFRESH();
            pg8::DenseSched S; S.init(F.ws + WS_H, F.ws + WS_WIN + (size_t)l * PP * D * 2, T, PP, D, F.G, F.bx);
            pg8::EpiProj E{(bf16_t*)(F.ws + WS_PROJ), PP};
            pg8::gemm_phase<pg8::EpiProj, pg8::DenseSched, false>(F.lds, D, S, E, F.tid);
            GRID_BAR(pb + 0); }
        }
        if (PHEN(3) && IN(pb + 1)) { asm volatile("; PHASE_MARK 3");
#pragma unroll 1
          for (int rep = 0; rep < NREP(3); ++rep) { REFRESH(); p2a(F, l, rep); GRID_BAR(pb + 1); } }
        if (PHEN(4) && IN(pb + 2)) { asm volatile("; PHASE_MARK 4");
#pragma unroll 1
          for (int rep = 0; rep < NREP(4); ++rep) { REFRESH(); p2b(F, l, rep); GRID_BAR(pb + 2); } }
        if (PHEN(5) && IN(pb + 3)) { asm volatile("; PHASE_MARK 5");
#pragma unroll 1
          for (int rep = 0; rep < NREP(5); ++rep) { REFRESH();
            pg8::DenseSched S; S.init(F.ws + WS_YMIX, F.ws + WS_WOUT + (size_t)l * D * D * 2, T, D, D, F.G, F.bx);
            if (l == 0) { pg8::EpiResGateT<false> E{GIN(I_X), (const bf16_t*)nullptr, (bf16_t*)(F.ws + WS_X1), mod + 2048, DBG_MIX0};
                pg8::gemm_phase<pg8::EpiResGateT<false>, pg8::DenseSched, false>(F.lds, D, S, E, F.tid); }
            else { pg8::EpiResGateT<true> E{(const float*)nullptr, (const bf16_t*)(F.ws + WS_X2), (bf16_t*)(F.ws + WS_X1), mod + 2048, DBG_MIX1};
                pg8::gemm_phase<pg8::EpiResGateT<true>, pg8::DenseSched, false>(F.lds, D, S, E, F.tid); }
            GRID_BAR(pb + 3); }
        }
        if (PHEN(6) && IN(pb + 4)) { asm volatile("; PHASE_MARK 6"); REFRESH(); p4_router(F, l); GRID_BAR(pb + 4); }
        if (PHEN(7) && IN(pb + 5)) { asm volatile("; PHASE_MARK 7");
#pragma unroll 1
          for (int rep = 0; rep < NREP(7); ++rep) {
            REFRESH(); const int nblk = moe_table(F, l);
            pg8::MoeSched<true> S; S.A = (const char*)(F.ws + WS_H8); S.Bt = (const char*)(F.ws + WS_WGU + (size_t)l * NE * 2048 * D); S.K = D; S.nN = 8; S.G = F.G; S.c = F.bx; S.total = nblk * 8; S.lj_in = F.lane & 31;
            S.tab = (const LAS int*)(F.lds + MISC_OFF + 1536); S.slot = (const i32x2*)(F.ws + WS_SLOT);
            pg8::EpiSwiGLU E{(unsigned char*)(F.ws + WS_ACT), GIN(I_BGU) + (size_t)l * NE * 2048};
            pg8::gemm_phase<pg8::EpiSwiGLU, pg8::MoeSched<true>, true, true>(F.lds, D, S, E, F.tid);
            if (l + 1 < DEPTH && rep == 0 && (F.G % 64) == 0) {
                const int BR = F.G / 8, off = (F.bx & 7) * (BR >> 3) + (F.bx >> 3) / 8;
                if ((nblk > off ? (nblk - off + BR - 1) / BR : 0) < (nblk + BR - 1) / BR) conv_one(F, l + 1, true); }
            GRID_BAR(pb + 5); }
        }
        if (PHEN(8) && IN(pb + 6)) { asm volatile("; PHASE_MARK 8");
#pragma unroll 1
          for (int rep = 0; rep < NREP(8); ++rep) {
            REFRESH(); const int nblk = moe_table(F, l);
            pg8::MoeSched<false> S; S.A = (const char*)(F.ws + WS_ACT); S.Bt = (const char*)(F.ws + WS_WDN + (size_t)l * NE * D * FF); S.K = FF; S.nN = 4; S.G = F.G; S.c = F.bx; S.total = nblk * 4; S.lj_in = F.lane & 31;
            S.tab = (const LAS int*)(F.lds + MISC_OFF + 1536); S.slot = (const i32x2*)(F.ws + WS_SLOT);
            pg8::EpiDown E{(unsigned char*)(F.ws + WS_YBUF), GIN(I_BDN) + (size_t)l * NE * D, (const i32x2*)(F.ws + WS_SLOT)};
            pg8::gemm_phase<pg8::EpiDown, pg8::MoeSched<false>, false, true>(F.lds, FF, S, E, F.tid);
            if (l + 1 < DEPTH && rep == 0 && (F.G % 64) == 0) {
                const int BR = F.G / 4, off = (F.bx & 7) * (BR >> 3) + (F.bx >> 3) / 4;
                if ((nblk > off ? (nblk - off + BR - 1) / BR : 0) < (nblk + BR - 1) / BR) conv_one(F, l + 1, true); }
            GRID_BAR(pb + 6); }
        }
        if (PHEN(9) && IN(pb + 7)) { asm volatile("; PHASE_MARK 9");
#pragma unroll 1
          for (int rep = 0; rep < NREP(9); ++rep) { REFRESH(); p7_combine(F, l); if (l + 1 < DEPTH || rep + 1 < NREP(9)) GRID_BAR(pb + 7); } }
    }
#undef IN
#undef GRID_BAR
}

extern "C" void kernel_launch(void* const* d_in, const int* in_sizes, int n_in, void* d_out, int out_size, void* d_ws, size_t ws_size, hipStream_t stream) {
    static int grid = 0;
    if (grid == 0) {
        if (n_in != 23 || out_size != T * D || ws_size < WS_END) { fprintf(stderr, "kernel_launch: unexpected shapes (n_in %d, out %d, ws %zu)\n", n_in, out_size, ws_size); grid = -1; return; }
        int dev = 0, cus = 0, per_cu = 0;
        if (hipGetDevice(&dev) != hipSuccess || hipDeviceGetAttribute(&cus, hipDeviceAttributeMultiprocessorCount, dev) != hipSuccess) { grid = -1; return; }
        if (hipFuncSetAttribute((const void*)fwd_kernel, hipFuncAttributeMaxDynamicSharedMemorySize, LDS_BYTES) != hipSuccess) { fprintf(stderr, "kernel_launch: hipFuncSetAttribute failed\n"); grid = -1; return; }
        if (hipOccupancyMaxActiveBlocksPerMultiprocessor(&per_cu, (const void*)fwd_kernel, NWAVES * 64, LDS_BYTES) != hipSuccess || per_cu < 1) { fprintf(stderr, "kernel_launch: occupancy query says %d\n", per_cu); }
        (void)hipGetLastError();
        grid = cus;
    }
    if (grid < 0) return;
    (void)hipMemsetAsync((char*)d_ws + WS_CTL, 0, CTL_ZERO_BYTES, stream);
    Args a{};
    for (int i = 0; i < 23; ++i) a.in[i] = (const float*)d_in[i];
    a.out = (float*)d_out; a.ws = (unsigned char*)d_ws;
    if (MK_N_LAUNCHES == 1) { a.ph_lo = 0; a.ph_hi = N_PHASES; hipLaunchKernelGGL(fwd_kernel, dim3(grid), dim3(NWAVES * 64), LDS_BYTES, stream, a); }
    else for (int p = 0; p < N_PHASES; ++p) { a.ph_lo = p; a.ph_hi = p + 1; hipLaunchKernelGGL(fwd_kernel, dim3(grid), dim3(NWAVES * 64), LDS_BYTES, stream, a); }
}
```

```cpp
#include <hip/hip_runtime.h>
#include <cstdio>
#include <cstdint>
#include <cmath>
#include <type_traits>

#ifndef MK_N_LAUNCHES
#define MK_N_LAUNCHES 1
#endif

#ifndef DBG_REP_PHASE
#define DBG_REP_PHASE -1
#endif
#ifndef DBG_REP_N
#define DBG_REP_N 2
#endif
#define NREP(j) ((DBG_REP_PHASE) == (j) ? (DBG_REP_N) : 1)
#ifndef DBG_MIX0
#define DBG_MIX0 1.0f
#endif
#ifndef DBG_MIX1
#define DBG_MIX1 1.0f
#endif
#ifndef DBG_MOE0
#define DBG_MOE0 1.0f
#endif
#ifndef DBG_MOE1
#define DBG_MOE1 1.0f
#endif
#define GAS __attribute__((address_space(1)))
#define LAS __attribute__((address_space(3)))
typedef unsigned short bf16_t;
typedef short bf16x8 __attribute__((ext_vector_type(8)));
typedef short s16x4 __attribute__((ext_vector_type(4)));
typedef short v4i16_t __attribute__((ext_vector_type(4)));
typedef float f32x4 __attribute__((ext_vector_type(4)));
typedef float f32x2 __attribute__((ext_vector_type(2)));
typedef unsigned u32x4 __attribute__((ext_vector_type(4)));
typedef unsigned u32x2 __attribute__((ext_vector_type(2)));
typedef int i32x2 __attribute__((ext_vector_type(2)));
typedef int i32x8 __attribute__((ext_vector_type(8)));
typedef GAS unsigned gu32;

constexpr int D = 1024, BATCH = 8, SEQ = 2048, T = BATCH * SEQ, DEPTH = 2;
constexpr int INW = 2944, PP = 3072;
constexpr int C_RQ = 0, C_RK = 256, C_RV = 512, C_RG = 768, C_MQ = 1024, C_MK = 1408, C_MV = 1792, C_LX = 2176, C_LG = 2560;
constexpr int Y_RET = 0, Y_MOBA = 256, Y_LRU = 640;
constexpr int NE = 32, FF = 1024, CAP = 16384;
constexpr int LCH = 128, NLCH = SEQ / LCH;
constexpr float NORM_EPS = 1e-6f;

constexpr size_t MiB = 1u << 20;
constexpr size_t WS_CTL = 0, CTL_ZERO_BYTES = 1 * MiB;
constexpr size_t WS_MOD = 1 * MiB;
constexpr size_t WS_ROT = 2 * MiB;
constexpr size_t WS_LRUSUM = 3 * MiB;
constexpr size_t WS_KMEAN = 4 * MiB;
constexpr size_t WS_SLOT = 5 * MiB;
constexpr size_t WS_GATE = 9 * MiB;
constexpr size_t WS_WIN = 10 * MiB;
constexpr size_t WS_WOUT = 22 * MiB;
constexpr size_t WS_RWT = 26 * MiB;
constexpr size_t WS_WGU = 32 * MiB;
constexpr size_t WS_WDN = 288 * MiB;
constexpr size_t WS_H = 416 * MiB;
constexpr size_t WS_PROJ = 448 * MiB;
constexpr size_t WS_YMIX = 544 * MiB;
constexpr size_t WS_X1 = 576 * MiB;
constexpr size_t WS_X2 = 640 * MiB;
constexpr size_t WS_ACT = 704 * MiB;
constexpr size_t WS_YBUF = 848 * MiB;
constexpr size_t WS_LRUH = 976 * MiB;
constexpr size_t WS_LRUA = 992 * MiB;
constexpr size_t WS_H8 = 1008 * MiB;
constexpr size_t WS_END = 1024 * MiB;
constexpr int CW_TMO = 0, CW_CODE = 1;
constexpr int CW_BAR = 4096;
constexpr int CW_CNT = 8192;
constexpr int CW_Q = 8192 + 256;

constexpr int RING_BYTES = 131072;
constexpr int MISC_OFF = RING_BYTES;
constexpr int LDS_BYTES = 147456;
constexpr int NWAVES = 8;

#define RLX_AGENT __ATOMIC_RELAXED, __HIP_MEMORY_SCOPE_AGENT
#define LDS_WAIT() asm volatile("s_waitcnt lgkmcnt(0)" ::: "memory")
#define VM_WAIT() asm volatile("s_waitcnt vmcnt(0)" ::: "memory")

__device__ __forceinline__ unsigned f2bf(float f) { unsigned u = __builtin_bit_cast(unsigned, f); return (u + 0x7fffu + ((u >> 16) & 1u)) >> 16; }
__device__ __forceinline__ unsigned pk2(float lo, float hi) { return f2bf(lo) | (f2bf(hi) << 16); }
__device__ __forceinline__ unsigned cvtpk(float lo, float hi) { typedef __bf16 bf2_t __attribute__((ext_vector_type(2))); f32x2 v = {lo, hi}; bf2_t b = __builtin_convertvector(v, bf2_t); return __builtin_bit_cast(unsigned, b); }
__device__ __forceinline__ unsigned cvt4_fp8(float a, float b, float c, float d) { int w = 0; w = __builtin_amdgcn_cvt_pk_fp8_f32(a, b, w, false); w = __builtin_amdgcn_cvt_pk_fp8_f32(c, d, w, true); return (unsigned)w; }
__device__ __forceinline__ float sat448(float x) { return __builtin_amdgcn_fmed3f(x, -448.0f, 448.0f); }
__device__ __forceinline__ unsigned cvt4_fp8_sat(float a, float b, float c, float d) { return cvt4_fp8(sat448(a), sat448(b), sat448(c), sat448(d)); }
__device__ __forceinline__ float ex2(float x) { return __builtin_amdgcn_exp2f(x); }
__device__ __forceinline__ float fexp(float x) { return __builtin_amdgcn_exp2f(x * 1.4426950408889634f); }
__device__ __forceinline__ float frcp(float x) { return __builtin_amdgcn_rcpf(x); }
__device__ __forceinline__ float bf2f(unsigned short b) { return __builtin_bit_cast(float, ((unsigned)b) << 16); }
__device__ __forceinline__ float bflo(unsigned w) { return __builtin_bit_cast(float, w << 16); }
__device__ __forceinline__ float bfhi(unsigned w) { return __builtin_bit_cast(float, w & 0xffff0000u); }
__device__ __forceinline__ int lane_id() { int l; asm volatile("v_mbcnt_lo_u32_b32 %0, -1, 0\n\tv_mbcnt_hi_u32_b32 %0, -1, %0" : "=v"(l)); return l; }
__device__ __forceinline__ float wave_sum(float v) {
#pragma unroll
    for (int o = 1; o < 64; o <<= 1) v += __shfl_xor(v, o);
    return v;
}

namespace pg8 {
constexpr int BM = 256, BK = 64, HALF = 128, HTB = HALF * BK * 2, STAGE_BYTES = 8 * HTB, NXCD = 8, WGM = 8;
__host__ __device__ __forceinline__ int lds_byte(int r, int c) { const int st = (r >> 4) * 2 + (c >> 5), rr = r & 15, cc = c & 31, ob = rr * 64 + cc * 2; return st * 1024 + (ob ^ (((ob >> 9) & 1) << 5)); }
__host__ __device__ __forceinline__ void stage_rc(int b, int& R, int& C) { const int st = b / 1024, sb = b % 1024, swz = sb ^ (((sb >> 9) & 1) << 5); R = (st >> 1) * 16 + swz / 64; C = (st & 1) * 32 + (swz % 64) / 2; }
__host__ __device__ __forceinline__ int perm32(int rho) { const int n = rho >> 4, i = rho & 15; return 8 * (i >> 2) + 4 * n + (i & 3); }

struct Unit { int pm, pn, e, srow, nv; };

__device__ __forceinline__ unsigned cvt_pk_bf16(float lo, float hi) { unsigned r; asm volatile("v_cvt_pk_bf16_f32 %0, %1, %2" : "=v"(r) : "v"(lo), "v"(hi)); return r; }

struct DenseSched {
    const char* A; const char* Bt; int K; int nM, nN, nwg, G, c;
    __device__ __forceinline__ void init(const void* A_, const void* Bt_, int M, int N, int K_, int G_, int c_) { A = (const char*)A_; Bt = (const char*)Bt_; K = K_; nM = M / BM; nN = N / BM; nwg = nM * nN; G = G_; c = c_; }
    __device__ __forceinline__ bool next(int i, Unit& u) const {
        const long L = (long)i * G + c; if (L >= nwg) return false;
        int wgid = (int)L; { const int q = nwg / NXCD, r = nwg % NXCD, xcd = wgid % NXCD, off = wgid / NXCD; wgid = (xcd < r ? xcd * (q + 1) : r * (q + 1) + (xcd - r) * q) + off; }
        const int nig = WGM * nN, gid = wgid / nig, fm = gid * WGM, gsz = (nM - fm) < WGM ? (nM - fm) : WGM;
        u.pm = fm + ((wgid % nig) % gsz); u.pn = (wgid % nig) / gsz; u.e = 0; u.srow = 0; u.nv = BM; return true;
    }
    __device__ __forceinline__ const char* a_base(const Unit& u) const { return A + (size_t)u.pm * (size_t)BM * K * 2; }
    __device__ __forceinline__ const char* b_base(const Unit& u) const { return Bt + (size_t)u.pn * (size_t)BM * K * 2; }
    __device__ __forceinline__ void a_offs(const Unit&, unsigned (&)[4], const int (&)[2], const int (&)[2]) const {}
};
template <bool GATHER> struct MoeSched {
    const char* A; const char* Bt; int K  , nN, G, c, total, lj_in  ; const LAS int* tab; const i32x2* slot;
    __device__ __forceinline__ bool next(int i, Unit& u) const {
        int blk;
        if ((G % (8 * nN)) == 0) {
            const int BR = G / nN, bpx = BR >> 3, xcd = c & 7, slot = c >> 3;
            blk = i * BR + xcd * bpx + slot / nN; u.pn = slot % nN; if (blk * nN >= total) return false;
        } else { const int L = i * G + c; if (L >= total) return false; blk = L / nN; u.pn = L - blk * nN; }
        u.pm = blk;
        const int lj = lane_id() & 31;
        const unsigned long long bal = __ballot(lj >= 1 && tab[lj] <= blk);
        const int e = __builtin_popcount((unsigned)(bal & 0xffffffffull));
        const int rb = blk - __builtin_amdgcn_readfirstlane(tab[e]); const int cn = __builtin_amdgcn_readfirstlane(tab[33 + e]);
        u.e = e; u.srow = e * CAP + rb * BM; const int rem = cn - rb * BM; u.nv = rem < BM ? rem : BM; return true;
    }
    __device__ __forceinline__ const char* a_base(const Unit& u) const { return GATHER ? A : A + (size_t)u.pm * (size_t)BM * K; }
    __device__ __forceinline__ const char* b_base(const Unit& u) const { return Bt + ((size_t)u.e * nN + u.pn) * (size_t)BM * K; }
    __device__ __forceinline__ void a_offs(const Unit& u, unsigned (&vo)[4], const int (&R)[2], const int (&C)[2]) const {
#pragma unroll
        for (int h = 0; h < 2; ++h)
#pragma unroll
            for (int i = 0; i < 2; ++i) { const int r = h * HALF + R[i]; int ent = 0; if (r < u.nv) ent = slot[u.srow + r].x; vo[h * 2 + i] = (unsigned)(ent >> 2) * (unsigned)K + (unsigned)(C[i] * 2); }
    }
};

struct EpiProj { static constexpr bool PREFETCH = false; static constexpr bool BIAS_LDS = false;
    static constexpr bool PERM = true;
    bf16_t* O; int ldc;
    __device__ __forceinline__ void operator()(const f32x4 (&acc)[2][2][4][2], const Unit& u, int wr, int wc, int fr, int fq) const {
        const int row0 = u.pm * BM + wr * 64 + fr, col0 = u.pn * BM + wc * 32 + 8 * fq;
#pragma unroll
        for (int ai = 0; ai < 2; ++ai)
#pragma unroll
            for (int m = 0; m < 4; ++m) { bf16_t* rowp = O + (size_t)(row0 + ai * HALF + m * 16) * ldc + col0;
#pragma unroll
                for (int bj = 0; bj < 2; ++bj) { const f32x4 v0 = acc[ai][bj][m][0], v1 = acc[ai][bj][m][1];
                    u32x4 w; w.x = cvt_pk_bf16(v0[0], v0[1]); w.y = cvt_pk_bf16(v0[2], v0[3]); w.z = cvt_pk_bf16(v1[0], v1[1]); w.w = cvt_pk_bf16(v1[2], v1[3]);
                    *(u32x4*)(rowp + bj * HALF) = w; } }
    }
};
template <bool IN16> struct EpiResGateT { static constexpr bool PREFETCH = false; static constexpr bool BIAS_LDS = false;
    static constexpr bool PERM = true;
    const float* xin32; const bf16_t* xin16; bf16_t* out; const float* gate; float dbg;
    __device__ __forceinline__ void operator()(const f32x4 (&acc)[2][2][4][2], const Unit& u, int wr, int wc, int fr, int fq) const {
        const int row0 = u.pm * BM + wr * 64 + fr, col0 = u.pn * BM + wc * 32 + 8 * fq; const int b = (u.pm * BM) / SEQ;
        f32x4 gv[2][2];
#pragma unroll
        for (int bj = 0; bj < 2; ++bj)
#pragma unroll
            for (int n = 0; n < 2; ++n) gv[bj][n] = *(const f32x4*)(gate + (size_t)b * 6144 + col0 + bj * HALF + n * 4) * dbg;
        constexpr int MB = IN16 ? 4 : 2;
#pragma unroll
        for (int ai = 0; ai < 2; ++ai)
#pragma unroll
          for (int m0 = 0; m0 < 4; m0 += MB) {
            u32x4 xw[MB][2]; f32x4 xf[MB][2][2];
#pragma unroll
            for (int mm = 0; mm < MB; ++mm) { const size_t off = (size_t)(row0 + ai * HALF + (m0 + mm) * 16) * D + col0;
#pragma unroll
                for (int bj = 0; bj < 2; ++bj) {
                    if constexpr (!IN16) { xf[mm][bj][0] = *(const f32x4*)(xin32 + off + bj * HALF); xf[mm][bj][1] = *(const f32x4*)(xin32 + off + bj * HALF + 4); }
                    else xw[mm][bj] = *(const u32x4*)(xin16 + off + bj * HALF); } }
#pragma unroll
            for (int mm = 0; mm < MB; ++mm) { const int m = m0 + mm; const size_t off = (size_t)(row0 + ai * HALF + m * 16) * D + col0;
#pragma unroll
                for (int bj = 0; bj < 2; ++bj) { f32x4 x0, x1;
                    if constexpr (!IN16) { x0 = xf[mm][bj][0]; x1 = xf[mm][bj][1]; }
                    else { const u32x4 w = xw[mm][bj]; x0 = (f32x4){bflo(w.x), bfhi(w.x), bflo(w.y), bfhi(w.y)}; x1 = (f32x4){bflo(w.z), bfhi(w.z), bflo(w.w), bfhi(w.w)}; }
                    const f32x4 o0 = x0 + gv[bj][0] * acc[ai][bj][m][0], o1 = x1 + gv[bj][1] * acc[ai][bj][m][1];
                    u32x4 ow; ow.x = cvt_pk_bf16(o0[0], o0[1]); ow.y = cvt_pk_bf16(o0[2], o0[3]); ow.z = cvt_pk_bf16(o1[0], o1[1]); ow.w = cvt_pk_bf16(o1[2], o1[3]);
                    *(u32x4*)(out + off + bj * HALF) = ow; } }
            asm volatile("" ::: "memory"); }
    }
};
struct EpiSwiGLU { static constexpr bool PREFETCH = false; static constexpr bool BIAS_LDS = true;
    static constexpr bool PERM = true;
    unsigned char* O; const float* bgu;
    __device__ __forceinline__ const float* bias_src(const Unit& u, int lane) const { return bgu + (size_t)u.e * 2048 + u.pn * HALF + (lane < 32 ? lane * 4 : 1024 + (lane - 32) * 4); }
    __device__ __forceinline__ void operator()(const f32x4 (&acc)[2][2][4][2], const Unit& u, int wr, int wc, int fr, int fq, const LAS float* bl) const {
        const int row0 = u.pm * BM + wr * 64 + fr, jc0 = u.pn * HALF + wc * 32 + 8 * fq;
        f32x4 bg[2], bu[2];
#pragma unroll
        for (int n = 0; n < 2; ++n) { bg[n] = *(const LAS f32x4*)(bl + wc * 32 + 8 * fq + 4 * n); bu[n] = *(const LAS f32x4*)(bl + 128 + wc * 32 + 8 * fq + 4 * n); }
#pragma unroll
        for (int ai = 0; ai < 2; ++ai)
#pragma unroll
            for (int m = 0; m < 4; ++m) { float a[8];
#pragma unroll
                for (int n = 0; n < 2; ++n)
#pragma unroll
                    for (int jp = 0; jp < 2; ++jp) {
                        const f32x2 ag = {acc[ai][0][m][n][2 * jp], acc[ai][0][m][n][2 * jp + 1]}, au = {acc[ai][1][m][n][2 * jp], acc[ai][1][m][n][2 * jp + 1]};
                        const f32x2 bgp = {bg[n][2 * jp], bg[n][2 * jp + 1]}, bup = {bu[n][2 * jp], bu[n][2 * jp + 1]};
                        f32x2 g = ag * 0.03125f + bgp, up = au * 0.03125f + bup;
                        g.x = fminf(g.x, 7.0f); g.y = fminf(g.y, 7.0f); up.x = __builtin_amdgcn_fmed3f(up.x, -7.0f, 7.0f); up.y = __builtin_amdgcn_fmed3f(up.y, -7.0f, 7.0f);
                        const f32x2 z = g * (-1.702f * 1.4426950408889634f);
                        f32x2 d; d.x = __builtin_amdgcn_exp2f(z.x); d.y = __builtin_amdgcn_exp2f(z.y); d = d + 1.0f;
                        f32x2 sg; sg.x = __builtin_amdgcn_rcpf(d.x); sg.y = __builtin_amdgcn_rcpf(d.y);
                        const f32x2 r = (up + 1.0f) * g * sg; a[n * 4 + 2 * jp] = r.x; a[n * 4 + 2 * jp + 1] = r.y; }
                u32x2 w; w.x = cvt4_fp8(a[0], a[1], a[2], a[3]); w.y = cvt4_fp8(a[4], a[5], a[6], a[7]);
                *(u32x2*)(O + (size_t)(row0 + ai * HALF + m * 16) * FF + jc0) = w; }
    }
};
struct EpiDown { static constexpr bool PREFETCH = true; static constexpr bool BIAS_LDS = true;
    static constexpr int PERM = 2;
    unsigned char* Y; const float* bdn; const i32x2* slot;
    __device__ __forceinline__ void pre1(const Unit& u, int wr, int fr, unsigned (&pk)[8]) const {
#pragma unroll
        for (int i = 0; i < 8; ++i) { const int r = (i >> 2) * HALF + wr * 64 + (i & 3) * 16 + fr; i32x2 ent = {0, 0}; if (r < u.nv) ent = slot[u.srow + r];
            const int ex = ent.x, ey = ent.y;
            pk[i] = (cvtpk(0.f, __builtin_bit_cast(float, ey)) & 0xffff0000u) | ((unsigned)ex & 0xffffu); }
    }
    __device__ __forceinline__ const float* bias_src(const Unit& u, int lane) const { return bdn + (size_t)u.e * 1024 + u.pn * BM + lane * 4; }
    __device__ __forceinline__ void operator()(const f32x4 (&acc)[2][2][4][2], const Unit& u, int wr, int wc, int fr, int fq, const unsigned (&pk)[8], const LAS float* bl) const {
        const int col0 = u.pn * BM + wc * 64 + 16 * fq;
        f32x4 bv[2][2];
#pragma unroll
        for (int bj = 0; bj < 2; ++bj)
#pragma unroll
            for (int n = 0; n < 2; ++n) bv[bj][n] = *(const LAS f32x4*)(bl + wc * 64 + 16 * fq + 8 * bj + 4 * n);
#pragma unroll
        for (int ai = 0; ai < 2; ++ai)
#pragma unroll
            for (int m = 0; m < 4; ++m) { const unsigned e = pk[ai * 4 + m];
                if ((e >> 16) != 0u) { const float g = __builtin_bit_cast(float, e & 0xffff0000u) * 16.0f; unsigned char* rowp = Y + (size_t)(e & 0xffffu) * D + col0;
                    u32x4 w;
#pragma unroll
                    for (int bj = 0; bj < 2; ++bj) { const f32x4 v0 = (acc[ai][bj][m][0] * 0.03125f + bv[bj][0]) * g, v1 = (acc[ai][bj][m][1] * 0.03125f + bv[bj][1]) * g;
                        w[2 * bj] = cvt4_fp8_sat(v0[0], v0[1], v0[2], v0[3]); w[2 * bj + 1] = cvt4_fp8_sat(v1[0], v1[1], v1[2], v1[3]); }
                    *(u32x4*)rowp = w; } }
    }
};

template <class Epi, class Sched, bool GATHER, bool F8 = false>
__device__ __forceinline__ void gemm_phase(LAS unsigned char* lds, const int K, const Sched& S, const Epi& E, const int tid_in) {
    int tz = tid_in; asm volatile("" : "+v"(tz));
    const int tid = tz, wid = __builtin_amdgcn_readfirstlane(tid >> 6), lane = tid & 63, wr = wid >> 2, wc = wid & 3, fr = lane & 15, fq = lane >> 4;
    const int RB = F8 ? K : 2 * K;
    int nt = RB / 128; asm volatile("" : "+s"(nt));
    int Rr[2], Cc[2]; unsigned voffB[2], voffC[4], voffN[4];
#pragma unroll
    for (int i = 0; i < 2; ++i) { int R, C; stage_rc(tid * 16 + i * 8192, R, C); Rr[i] = R; Cc[i] = C; const int Rb = (int)Epi::PERM == 2 ? (64 * ((R >> 5) & 3) + 16 * ((R >> 2) & 3) + 4 * ((R >> 4) & 1) + (R & 3)) : Epi::PERM ? ((R & ~31) + perm32(R & 31)) : R;
        voffB[i] = (unsigned)(Rb * RB + C * 2); voffC[i] = (unsigned)(R * RB + C * 2); voffC[2 + i] = (unsigned)((R + HALF) * RB + C * 2); }
#pragma unroll
    for (int i = 0; i < 4; ++i) voffN[i] = voffC[i];
    const size_t kstep = (size_t)(BK * 2);
    const size_t hstep = (size_t)((int)Epi::PERM == 2 ? 8 : HALF) * RB;
    const unsigned ldsw = (unsigned)wid * 1024u;
    unsigned aoff = (unsigned)lds_byte(wr * 64 + fr, fq * (F8 ? 16 : 8)), boff = 65536u + (unsigned)lds_byte(wc * 32 + fr, fq * (F8 ? 16 : 8));
    asm volatile("" : "+v"(aoff), "+v"(boff));
    unsigned aoff1 = aoff, boff1 = boff;
    if constexpr (F8) { aoff += 16u * (unsigned)(fq & 1); boff += 16u * (unsigned)(fq & 1); aoff1 = aoff ^ 16u; boff1 = boff ^ 16u; asm volatile("" : "+v"(aoff), "+v"(boff), "+v"(aoff1), "+v"(boff1)); }
#define PG8_SA(b, h) (((b) * 2 + (h)) * HTB)
#define PG8_SB(b, h) ((4 + (b) * 2 + (h)) * HTB)
#define PG8_SBR(b, h) (((b) * 2 + (h)) * HTB)
#define PG8_STAGE_B(bufoff, gbase) do { _Pragma("unroll") for (int _i = 0; _i < 2; ++_i) \
        __builtin_amdgcn_global_load_lds((const unsigned*)((const char*)(gbase) + voffB[_i]), (LAS unsigned*)(lds + (bufoff) + ldsw + _i * 8192), 16, 0, 0); } while (0)
#define PG8_STAGE_A(bufoff, gbase, o0, o1) do { \
        __builtin_amdgcn_global_load_lds((const unsigned*)((const char*)(gbase) + (o0)), (LAS unsigned*)(lds + (bufoff) + ldsw), 16, 0, 0); \
        __builtin_amdgcn_global_load_lds((const unsigned*)((const char*)(gbase) + (o1)), (LAS unsigned*)(lds + (bufoff) + ldsw + 8192), 16, 0, 0); } while (0)
#define PG8_RD16(off) (*(const LAS u32x4*)(lds + (off)))
#define PG8_MK8(x0, x1) ((i32x8){(int)(x0).x, (int)(x0).y, (int)(x0).z, (int)(x0).w, (int)(x1).x, (int)(x1).y, (int)(x1).z, (int)(x1).w})
#define PG8_LDA(dst, b, h) do { _Pragma("unroll") for (int m = 0; m < 4; ++m) { \
        if constexpr (F8) { const u32x4 _x0 = PG8_RD16(aoff + (PG8_SA(b, h) + m * 2048)), _x1 = PG8_RD16(aoff1 + (PG8_SA(b, h) + m * 2048)); dst##8[m] = PG8_MK8(_x0, _x1); } \
        else { _Pragma("unroll") for (int k = 0; k < 2; ++k) dst[m][k] = *(const LAS bf16x8*)(lds + aoff + (PG8_SA(b, h) + m * 2048 + k * 1024)); } } } while (0)
#define PG8_LDB(dst, b, h) do { _Pragma("unroll") for (int n = 0; n < 2; ++n) { \
        if constexpr (F8) { const u32x4 _x0 = PG8_RD16(boff + (PG8_SBR(b, h) + n * 2048)), _x1 = PG8_RD16(boff1 + (PG8_SBR(b, h) + n * 2048)); dst##8[n] = PG8_MK8(_x0, _x1); } \
        else { _Pragma("unroll") for (int k = 0; k < 2; ++k) dst[n][k] = *(const LAS bf16x8*)(lds + boff + (PG8_SBR(b, h) + n * 2048 + k * 1024)); } } } while (0)
#define PG8_MMA(ai, bj, At, Bt) do { __builtin_amdgcn_s_setprio(1); _Pragma("unroll") for (int m = 0; m < 4; ++m) _Pragma("unroll") for (int n = 0; n < 2; ++n) { \
        if constexpr (F8) asm volatile("v_mfma_scale_f32_16x16x128_f8f6f4 %0, %1, %2, %0, %3, %3 op_sel_hi:[0,0,0]" : "+v"(acc[ai][bj][m][n]) : "v"(Bt##8[n]), "v"(At##8[m]), "v"(f8scale));   \
        else { _Pragma("unroll") for (int k = 0; k < 2; ++k) acc[ai][bj][m][n] = __builtin_amdgcn_mfma_f32_16x16x32_bf16(Bt[n][k], At[m][k], acc[ai][bj][m][n], 0, 0, 0); } } \
        __builtin_amdgcn_s_setprio(0); } while (0)
#define PG8_WAIT_V(n) asm volatile("s_waitcnt vmcnt(" #n ")" ::: "memory")
#define PG8_WAIT_L(n) asm volatile("s_waitcnt lgkmcnt(" #n ")" ::: "memory")
#define PG8_BAR __builtin_amdgcn_s_barrier()
#define PG8_SCHED __builtin_amdgcn_sched_barrier(0)
    Unit cur, nxt; int ui = 0;
    if (!S.next(0, cur)) return;
    f32x4 acc[2][2][4][2];
#pragma unroll
    for (int a = 0; a < 2; ++a)
#pragma unroll
        for (int b = 0; b < 2; ++b)
#pragma unroll
            for (int m = 0; m < 4; ++m)
#pragma unroll
                for (int n = 0; n < 2; ++n) acc[a][b][m][n] = (f32x4){0.f, 0.f, 0.f, 0.f};
    int f8scale = 0x7f7f7f7f; asm volatile("" : "+v"(f8scale));
    bf16x8 At[4][2], B0[2][2], B1[2][2]; i32x8 At8[4], B08[2], B18[2];
    const char* cA = S.a_base(cur); const char* cB = S.b_base(cur);
    if constexpr (GATHER) S.a_offs(cur, voffC, Rr, Cc);
    unsigned epk[8];
    if constexpr (Epi::PREFETCH) E.pre1(cur, wr, fr, epk);
    LAS unsigned char* const bias_lds = lds + MISC_OFF + 8192;
    if constexpr (Epi::BIAS_LDS) { if (wid == 0) __builtin_amdgcn_global_load_lds((const unsigned*)E.bias_src(cur, lane_id()), (LAS unsigned*)bias_lds, 16, 0, 0); }
    PG8_STAGE_B(PG8_SB(0, 0), cB); PG8_STAGE_B(PG8_SB(0, 1), cB + hstep); PG8_STAGE_A(PG8_SA(0, 0), cA, voffC[0], voffC[1]); PG8_STAGE_A(PG8_SA(0, 1), cA, voffC[2], voffC[3]);
    if (wr == 1) PG8_BAR;
    PG8_WAIT_V(2); PG8_BAR;
    PG8_STAGE_B(PG8_SB(1, 0), cB + kstep); PG8_STAGE_A(PG8_SA(1, 0), cA + kstep, voffC[0], voffC[1]); PG8_STAGE_B(PG8_SB(1, 1), cB + hstep + kstep);
    PG8_WAIT_V(6); PG8_BAR;
    for (;;) {
        const bool has_next = S.next(ui + 1, nxt);
        const char* nA = has_next ? S.a_base(nxt) : cA; const char* nB = has_next ? S.b_base(nxt) : cB;
        if constexpr (GATHER) { if (has_next) S.a_offs(nxt, voffN, Rr, Cc); else {
#pragma unroll
            for (int i = 0; i < 4; ++i) voffN[i] = voffC[i]; } }
#pragma unroll 1
        for (int t = 0; t < nt; t += 2) {
            const bool last = (t == nt - 2);
            const char* a1 = cA + (size_t)(t + 1) * kstep;
            const char* a2 = last ? nA : cA + (size_t)(t + 2) * kstep; const char* b2 = last ? nB : cB + (size_t)(t + 2) * kstep;
            const char* a3 = a2 + kstep; const char* b3 = b2 + kstep;
            unsigned o2[4];
#pragma unroll
            for (int i = 0; i < 4; ++i) o2[i] = GATHER ? (last ? voffN[i] : voffC[i]) : voffC[i];
            PG8_LDB(B0, 0, 0); PG8_LDB(B1, 0, 1); PG8_SCHED; PG8_LDA(At, 0, 0); PG8_STAGE_A(PG8_SA(1, 1), a1, voffC[2], voffC[3]);
            PG8_WAIT_V(8); PG8_WAIT_L(0); PG8_BAR; PG8_MMA(0, 0, At, B0); PG8_MMA(0, 1, At, B1); PG8_BAR; PG8_SCHED;
            PG8_LDA(At, 0, 1); PG8_STAGE_B(PG8_SB(0, 0), b2); PG8_STAGE_B(PG8_SB(0, 1), b2 + hstep); PG8_STAGE_A(PG8_SA(0, 0), a2, o2[0], o2[1]);
            PG8_WAIT_V(8); PG8_WAIT_L(0); PG8_BAR; PG8_MMA(1, 0, At, B0); PG8_MMA(1, 1, At, B1); PG8_BAR; PG8_SCHED;
            PG8_LDB(B0, 1, 0); PG8_LDB(B1, 1, 1); PG8_SCHED; PG8_LDA(At, 1, 0); PG8_STAGE_A(PG8_SA(0, 1), a2, o2[2], o2[3]);
            PG8_WAIT_V(8); PG8_WAIT_L(0); PG8_BAR; PG8_MMA(0, 0, At, B0); PG8_MMA(0, 1, At, B1); PG8_BAR; PG8_SCHED;
            PG8_LDA(At, 1, 1); PG8_STAGE_B(PG8_SB(1, 0), b3); PG8_STAGE_B(PG8_SB(1, 1), b3 + hstep); PG8_STAGE_A(PG8_SA(1, 0), a3, o2[0], o2[1]);
            PG8_WAIT_V(8); PG8_WAIT_L(0); PG8_BAR; PG8_MMA(1, 0, At, B0); PG8_MMA(1, 1, At, B1); PG8_BAR; PG8_SCHED;
        }
        if (wr == 0) PG8_BAR;
        if constexpr (F8) asm volatile("s_nop 15\n\ts_nop 15" ::: "memory");
        { const LAS float* bl = (const LAS float*)(bias_lds + (ui & 1) * 1024);
          if constexpr (Epi::PREFETCH && Epi::BIAS_LDS) E(acc, cur, wr, wc, fr, fq, epk, bl); else if constexpr (Epi::BIAS_LDS) E(acc, cur, wr, wc, fr, fq, bl); else if constexpr (Epi::PREFETCH) E(acc, cur, wr, wc, fr, fq, epk); else E(acc, cur, wr, wc, fr, fq); }
        if (!has_next) break;
#pragma unroll
        for (int a = 0; a < 2; ++a)
#pragma unroll
            for (int b = 0; b < 2; ++b)
#pragma unroll
                for (int m = 0; m < 4; ++m)
#pragma unroll
                    for (int n = 0; n < 2; ++n) acc[a][b][m][n] = (f32x4){0.f, 0.f, 0.f, 0.f};
        cur = nxt; cA = nA; cB = nB; ++ui;
        if constexpr (Epi::PREFETCH) E.pre1(cur, wr, fr, epk);
        if constexpr (Epi::BIAS_LDS) { if (wid == 0) __builtin_amdgcn_global_load_lds((const unsigned*)E.bias_src(cur, lane_id()), (LAS unsigned*)(bias_lds + (ui & 1) * 1024), 16, 0, 0); }
#pragma unroll
        for (int i = 0; i < 4; ++i) voffC[i] = voffN[i];
        if (wr == 1) PG8_BAR;
    }
    PG8_WAIT_V(0);
    PG8_BAR;
#undef PG8_SA
#undef PG8_SB
#undef PG8_SBR
#undef PG8_STAGE_A
#undef PG8_STAGE_B
#undef PG8_LDA
#undef PG8_RD16
#undef PG8_MK8
#undef PG8_LDB
#undef PG8_MMA
#undef PG8_WAIT_V
#undef PG8_WAIT_L
#undef PG8_BAR
#undef PG8_SCHED
}
}

#define XB_TMO      128
#define XB_XCNT(j)  (256  + 64 * (j))
#define XB_XSUB(j)  (1280 + 64 * (j))
#define XB_XGEN(j)  (2304 + 64 * (j))
#define XB_TOP      3328
#define XB_TOPGEN   3392
#define XCD_BAR_WORDS 3456
#define XB_SPIN_CAP (1u << 18)
__device__ __forceinline__ unsigned xb_ld(unsigned* p)              { return __hip_atomic_load(p, __ATOMIC_RELAXED, __HIP_MEMORY_SCOPE_AGENT); }
__device__ __forceinline__ unsigned xb_add(unsigned* p, unsigned v) { return __hip_atomic_fetch_add(p, v, __ATOMIC_RELAXED, __HIP_MEMORY_SCOPE_AGENT); }
__device__ __forceinline__ unsigned xb_xcc_id() { return (unsigned)__builtin_amdgcn_s_getreg((3 << 11) | 20) & 0xFu; }
#define XB_SPIN(cond, bar) do { unsigned _sp = 0; while (cond) { __builtin_amdgcn_s_sleep(1); \
    if ((++_sp & 255u) == 0u) { if (xb_ld(&(bar)[XB_TMO])) break; if (_sp > XB_SPIN_CAP) { atomicAdd(&(bar)[XB_TMO], 1u); break; } } } } while (0)
struct XcdBarrier { unsigned* bar; unsigned x; volatile LAS unsigned* st; };
__device__ __forceinline__ XcdBarrier xcd_barrier_post(unsigned* bar, volatile LAS unsigned* st, int tid) {
    XcdBarrier b; b.bar = bar; b.x = xb_xcc_id(); b.st = st;
    if (tid == 0) (void)xb_add(&bar[XB_XCNT(b.x)], 1u);
    return b;
}
__device__ __forceinline__ void xcd_barrier_complete(unsigned* bar, unsigned x, unsigned& nloc, unsigned& nx) {
    const unsigned G = gridDim.x * gridDim.y * gridDim.z;
    unsigned sum, cnt, mine, sp = 0u;
    for (;;) {
        sum = 0u; cnt = 0u; mine = 0u;
#pragma unroll
        for (unsigned j = 0; j < 16; ++j) { const unsigned c = xb_ld(&bar[XB_XCNT(j)]); sum += c; cnt += (c > 0u) ? 1u : 0u; mine = (j == x) ? c : mine; }
        if (sum == G) break;
        __builtin_amdgcn_s_sleep(1);
        if ((++sp & 255u) == 0u) { if (xb_ld(&bar[XB_TMO])) break; if (sp > XB_SPIN_CAP) { atomicAdd(&bar[XB_TMO], 1u); break; } }
    }
    nloc = mine > 0u ? mine : 1u; nx = cnt > 0u ? cnt : 1u;
}
__device__ __forceinline__ void xcd_barrier(const XcdBarrier& b, int tid) {
    asm volatile("s_waitcnt vmcnt(0)" ::: "memory");
    __syncthreads();
    if (tid == 0) {
        unsigned* bar = b.bar;
        __builtin_amdgcn_s_waitcnt(0);
        unsigned nloc = b.st[0], nx = b.st[1];
        if (nloc == 0u) { xcd_barrier_complete(bar, b.x, nloc, nx); b.st[0] = nloc; b.st[1] = nx; }
        const unsigned old = xb_add(&bar[XB_XSUB(b.x)], 1u);
        const unsigned gen = old / nloc;
        if (old + 1u == (gen + 1u) * nloc) {
            __builtin_amdgcn_fence(__ATOMIC_RELEASE, "agent");
            asm volatile("s_waitcnt vmcnt(0)" ::: "memory");
            const unsigned og = xb_add(&bar[XB_TOP], 1u);
            const unsigned tg = og / nx;
            if (og + 1u == (tg + 1u) * nx) xb_add(&bar[XB_TOPGEN], 1u);
            else XB_SPIN(xb_ld(&bar[XB_TOPGEN]) == tg, bar);
            __builtin_amdgcn_fence(__ATOMIC_ACQUIRE, "agent");
            xb_add(&bar[XB_XGEN(b.x)], 1u);
            asm volatile("s_waitcnt vmcnt(0)" ::: "memory");
        } else {
            XB_SPIN(xb_ld(&bar[XB_XGEN(b.x)]) == gen, bar);
            __builtin_amdgcn_fence(__ATOMIC_ACQUIRE, "agent");
            asm volatile("s_waitcnt vmcnt(0)" ::: "memory");
        }
    }
    __syncthreads();
}

#define CAS __attribute__((address_space(4)))
typedef const float* PFC;
struct Frame {
    LAS unsigned char* lds;
    gu32* ctl;
    int tid, lane, wave, vcu, G, bx;
    const CAS PFC* in;
    float* out; unsigned char* ws;
};
#define GIN(i) ((const float*)(const GAS float*)F.in[i])
enum { I_X = 0, I_C, I_ADAW, I_ADAB, I_NMIX, I_WIN, I_RETNW, I_CONVW, I_CONVB, I_WA, I_BA, I_WX, I_BX, I_LAM, I_WOUT, I_NFFN, I_RW, I_RB, I_WGU, I_BGU, I_WDN, I_BDN, I_FNW };

__device__ __forceinline__ void p0_transpose_item(const float* W, int N, int k0, int n0, bf16_t* WTrow0  , int Kd, LAS float* scr, int lane) {
#pragma unroll 8
    for (int i = 0; i < 32; ++i) { const int kk = 2 * i + (lane >> 5); scr[kk * 33 + (lane & 31)] = W[(size_t)(k0 + kk) * N + n0 + (lane & 31)]; }
    LDS_WAIT(); asm volatile("" ::: "memory");
    const int c = lane & 7;
#pragma unroll
    for (int j = 0; j < 4; ++j) { const int n = (lane >> 3) + 8 * j; const LAS float* s = scr + (8 * c) * 33 + n;
        u32x4 o; o.x = pk2(s[0 * 33], s[1 * 33]); o.y = pk2(s[2 * 33], s[3 * 33]); o.z = pk2(s[4 * 33], s[5 * 33]); o.w = pk2(s[6 * 33], s[7 * 33]);
        *(u32x4*)(WTrow0 + (size_t)n * Kd + k0 + 8 * c) = o; }
    LDS_WAIT(); asm volatile("" ::: "memory");
}
__device__ __forceinline__ void p0_transpose_item8(const float* W, int N, int k0, int n0, unsigned char* WTrow0, int Kd, LAS float* scr, int lane) {
#pragma unroll 8
    for (int i = 0; i < 32; ++i) { const int kk = 2 * i + (lane >> 5); scr[kk * 33 + (lane & 31)] = W[(size_t)(k0 + kk) * N + n0 + (lane & 31)] * 32.0f; }
    LDS_WAIT(); asm volatile("" ::: "memory");
    const int c = lane & 7;
#pragma unroll
    for (int j = 0; j < 4; ++j) { const int n = (lane >> 3) + 8 * j; const LAS float* sp = scr + (8 * c) * 33 + n;
        u32x2 o; o.x = cvt4_fp8(sp[0 * 33], sp[1 * 33], sp[2 * 33], sp[3 * 33]); o.y = cvt4_fp8(sp[4 * 33], sp[5 * 33], sp[6 * 33], sp[7 * 33]);
        *(u32x2*)(WTrow0 + (size_t)n * Kd + k0 + 8 * c) = o; }
    LDS_WAIT(); asm volatile("" ::: "memory");
}
__device__ __forceinline__ float silu_f(float x) { return x * frcp(1.0f + fexp(-x)); }

__device__ __forceinline__ void p0_prologue(Frame& F) {
    const int gw = F.vcu * NWAVES + F.wave, NGW = F.G * NWAVES;
    {
        LAS float* cact = (LAS float*)(F.lds);
        LAS float* red = (LAS float*)(F.lds + 32768);
        for (int i = F.tid; i < BATCH * D; i += 512) cact[i] = silu_f(GIN(I_C)[i]);
        __syncthreads();
        float* mod = (float*)(F.ws + WS_MOD);
        for (int u = F.bx; u < DEPTH * 96; u += F.G) {
            const int l = u / 96, n0 = (u % 96) * 64, col = F.tid & 63, kg = F.tid >> 6;
            const float* w = GIN(I_ADAW) + (size_t)l * D * 6144 + n0 + col;
            float a[8];
#pragma unroll
            for (int b = 0; b < 8; ++b) a[b] = 0.f;
#pragma unroll 32
            for (int k = kg * 128; k < kg * 128 + 128; ++k) { const float wv = w[(size_t)k * 6144];
#pragma unroll
                for (int b = 0; b < 8; ++b) a[b] += cact[b * D + k] * wv; }
#pragma unroll
            for (int b = 0; b < 8; ++b) red[(kg * 8 + b) * 64 + col] = a[b];
            __syncthreads();
            { const int b = F.tid >> 6; float s = 0.f;
#pragma unroll
              for (int g = 0; g < 8; ++g) s += red[(g * 8 + b) * 64 + col];
              mod[((size_t)l * BATCH + b) * 6144 + n0 + col] = s + GIN(I_ADAB)[l * 6144 + n0 + col]; }
            __syncthreads();
        }
    }
    {
        float* rc = (float*)(F.ws + WS_ROT); float* rs = rc + SEQ * 32;
        for (int i = gw * 64 + F.lane; i < SEQ * 32; i += NGW * 64) { const int pos = i >> 5, j = i & 31;
            const double inv = pow(10000.0, -(double)j / 32.0), ang = (double)pos * inv; rc[i] = (float)cos(ang); rs[i] = (float)sin(ang); }
    }
    {
        bf16_t* rwt = (bf16_t*)(F.ws + WS_RWT);
        for (int i = gw * 64 + F.lane; i < DEPTH * NE * D; i += NGW * 64) { const int l = i / (NE * D), r = i % (NE * D), e = r / D, k = r % D;
            const float w = GIN(I_RW)[(size_t)l * D * NE + (size_t)k * NE + e]; const unsigned hi = f2bf(w); const float lo = w - __builtin_bit_cast(float, hi << 16);
            rwt[((size_t)l * 2 + 0) * NE * D + r] = (bf16_t)hi; rwt[((size_t)l * 2 + 1) * NE * D + r] = (bf16_t)f2bf(lo); }
    }
}
namespace cv {
constexpr int I_IN = 16 * (INW / 64), I_OUT = 16 * 16, I_GU = 16 * 32, I_DN = 16 * 16;
constexpr int N_IN = DEPTH * I_IN, N_OUT = DEPTH * I_OUT, N_GU = DEPTH * NE * I_GU, N_DN = DEPTH * NE * I_DN, N_PROJ = N_IN + N_OUT;
struct Item { const float* src; unsigned char* dst; int N, f8; };
__device__ __forceinline__ Item decode(Frame& F, int it) { Item t; int r = it;
    bf16_t* win_t = (bf16_t*)(F.ws + WS_WIN); bf16_t* wout_t = (bf16_t*)(F.ws + WS_WOUT); unsigned char* wgu_t = (unsigned char*)(F.ws + WS_WGU); unsigned char* wdn_t = (unsigned char*)(F.ws + WS_WDN);
    if (r < N_IN) { const int l = r / I_IN, q = r % I_IN, kb = q / (INW / 64), nb = q % (INW / 64);
        t.src = GIN(I_WIN) + (size_t)l * D * INW + (size_t)kb * 64 * INW + nb * 64; t.dst = (unsigned char*)(win_t + ((size_t)l * PP + nb * 64) * D + kb * 64); t.N = INW; t.f8 = 0; return t; }
    r -= N_IN;
    if (r < N_OUT) { const int l = r / I_OUT, q = r % I_OUT, kb = q / 16, nb = q % 16;
        t.src = GIN(I_WOUT) + (size_t)l * D * D + (size_t)kb * 64 * D + nb * 64; t.dst = (unsigned char*)(wout_t + ((size_t)l * D + nb * 64) * D + kb * 64); t.N = D; t.f8 = 0; return t; }
    r -= N_OUT;
    if (r < N_GU) { const int le = r / I_GU, q = r % I_GU, kb = q / 32, nb = q % 32, n0 = nb * 64, half = n0 >> 10, j = n0 & 1023;
        const int drow = 256 * (j >> 7) + 128 * half + (j & 127);
        t.src = GIN(I_WGU) + (size_t)le * D * 2048 + (size_t)kb * 64 * 2048 + n0; t.dst = wgu_t + ((size_t)le * 2048 + drow) * D + kb * 64; t.N = 2048; t.f8 = 1; return t; }
    r -= N_GU;
    { const int le = r / I_DN, q = r % I_DN, kb = q / 16, nb = q % 16;
        t.src = GIN(I_WDN) + (size_t)le * FF * D + (size_t)kb * 64 * D + nb * 64; t.dst = wdn_t + ((size_t)le * D + nb * 64) * FF + kb * 64; t.N = D; t.f8 = 1; return t; } }
__device__ __forceinline__ void load(const Item& t, f32x4 (&v)[16], int lane) { const int r4 = lane >> 4, c16 = lane & 15;
#pragma unroll
    for (int i = 0; i < 16; ++i) v[i] = __builtin_nontemporal_load((const f32x4*)(t.src + (size_t)(4 * i + r4) * t.N + 4 * c16)); }
template <int F8C = -1> __device__ __forceinline__ void to_lds(const Item& t, const f32x4 (&v)[16], LAS float* scr, int lane) {
    const int r4 = lane >> 4, c16 = lane & 15; const float sc = (F8C == 1 || t.f8) ? 32.0f : 1.0f;
#pragma unroll
    for (int i = 0; i < 16; ++i) *(LAS f32x4*)(scr + (4 * i + r4) * 64 + 4 * (c16 ^ i)) = v[i] * sc;
    LDS_WAIT(); asm volatile("" ::: "memory"); }
template <int F8C = -1> __device__ __forceinline__ void finish(const Item& t, LAS float* scr, int lane) {
    const int q = lane & 3, a = lane >> 4, n3 = (lane >> 2) & 3;
    const LAS float* base0 = scr + q * 1024 + n3;
    int Y[4];
#pragma unroll
    for (int b = 0; b < 4; ++b) Y[b] = 4 * (a ^ b);
#pragma unroll
    for (int p = 0; p < 4; ++p) { const int n = 16 * p + (lane >> 2); const LAS float* bp = base0 + 16 * (p ^ q); float e[16];
#pragma unroll
        for (int kk = 0; kk < 16; ++kk) e[kk] = bp[kk * 64 + Y[kk >> 2]];
        if (F8C == 1 || t.f8) { u32x4 o; o.x = cvt4_fp8(e[0], e[1], e[2], e[3]); o.y = cvt4_fp8(e[4], e[5], e[6], e[7]); o.z = cvt4_fp8(e[8], e[9], e[10], e[11]); o.w = cvt4_fp8(e[12], e[13], e[14], e[15]);
            *(u32x4*)(t.dst + (size_t)n * D + 16 * q) = o; }
        else { u32x4* dp = (u32x4*)(t.dst + ((size_t)n * D + 16 * q) * 2);
#pragma unroll
            for (int h = 0; h < 2; ++h) { u32x4 o; o.x = cvtpk(e[8 * h], e[8 * h + 1]); o.y = cvtpk(e[8 * h + 2], e[8 * h + 3]); o.z = cvtpk(e[8 * h + 4], e[8 * h + 5]); o.w = cvtpk(e[8 * h + 6], e[8 * h + 7]); dp[h] = o; } } }
    LDS_WAIT(); asm volatile("" ::: "memory"); }
__device__ __forceinline__ void run(Frame& F, int it0, int step, int end) {
    LAS float* scr = (LAS float*)(F.lds + F.wave * 16384);
    int it = it0;
    if (it < end) { Item cur = decode(F, it); f32x4 vc[16]; load(cur, vc, F.lane);
        for (;;) { const int itn = it + step; const bool hn = itn < end; Item nx = cur; f32x4 vn[16];
            if (hn) { nx = decode(F, itn); load(nx, vn, F.lane); }
            to_lds(cur, vc, scr, F.lane); finish(cur, scr, F.lane);
            if (!hn) break;
            cur = nx; it = itn;
#pragma unroll
            for (int i = 0; i < 16; ++i) vc[i] = vn[i]; } }
}
constexpr int BATCH_ITEMS = 32, NB_GU = NE * I_GU / BATCH_ITEMS, NB_DN = NE * I_DN / BATCH_ITEMS, NB_LAYER = NB_GU + NB_DN;
__device__ __forceinline__ void run_batch(Frame& F, int base) {
    LAS float* scr = (LAS float*)(F.lds + F.wave * 16384);
    const int i0 = base + 4 * F.wave;
    f32x4 vA[16], vB[16];
    const Item t0 = decode(F, i0), t1 = decode(F, i0 + 1), t2 = decode(F, i0 + 2), t3 = decode(F, i0 + 3);
#define CV_ARRIVED(V, n) do { asm volatile("s_waitcnt vmcnt(" #n ")" ::: "memory"); _Pragma("unroll") for (int _i = 0; _i < 16; ++_i) asm volatile("" : "+v"(V[_i])); } while (0)
    load(t0, vA, F.lane); load(t1, vB, F.lane);
    CV_ARRIVED(vA, 16); to_lds<1>(t0, vA, scr, F.lane); finish<1>(t0, scr, F.lane); load(t2, vA, F.lane);
    CV_ARRIVED(vB, 16); to_lds<1>(t1, vB, scr, F.lane); finish<1>(t1, scr, F.lane); load(t3, vB, F.lane);
    CV_ARRIVED(vA, 16); to_lds<1>(t2, vA, scr, F.lane); finish<1>(t2, scr, F.lane);
    CV_ARRIVED(vB, 0);  to_lds<1>(t3, vB, scr, F.lane); finish<1>(t3, scr, F.lane);
}
__device__ __forceinline__ void run_half(Frame& F, int base16) {
    LAS float* scr = (LAS float*)(F.lds + F.wave * 16384);
    const int i0 = base16 + 2 * F.wave;
    f32x4 vA[16], vB[16];
    const Item t0 = decode(F, i0), t1 = decode(F, i0 + 1);
    load(t0, vA, F.lane); load(t1, vB, F.lane);
    CV_ARRIVED(vA, 16); to_lds<1>(t0, vA, scr, F.lane); finish<1>(t0, scr, F.lane);
    CV_ARRIVED(vB, 0);  to_lds<1>(t1, vB, scr, F.lane); finish<1>(t1, scr, F.lane);
#undef CV_ARRIVED
}
__device__ __forceinline__ int batch_base(int l, int id) { return id < NB_GU ? N_PROJ + l * (NE * I_GU) + id * BATCH_ITEMS : N_PROJ + N_GU + l * (NE * I_DN) + (id - NB_GU) * BATCH_ITEMS; }
__device__ __forceinline__ int tail_batches(int l) { return l >= 1 ? 160 : 0; }
}
__device__ __forceinline__ void conv_one(Frame& F, int l, bool tail = false) {
    { int _t = (F.wave << 6) | lane_id(); asm volatile("" : "+v"(_t)); F.tid = _t; F.lane = _t & 63; }
    volatile LAS int* sq = (volatile LAS int*)(F.lds + MISC_OFF + 1024);
    unsigned* head = (unsigned*)(F.ctl + CW_Q + 64 * l + (tail ? 40 : 32));
    __syncthreads();
    if (F.tid == 0) *sq = (int)xb_add(head, 1u);
    __syncthreads();
    const int id = __builtin_amdgcn_readfirstlane(*sq);
    __syncthreads();
    const int nbm = cv::NB_LAYER - cv::tail_batches(l);
    if (tail) { if (id < 2 * cv::tail_batches(l)) cv::run_half(F, cv::batch_base(l, nbm + (id >> 1)) + 16 * (id & 1)); }
    else if (id < nbm) cv::run_batch(F, cv::batch_base(l, id));
    __syncthreads();
}
__device__ __forceinline__ void p0_convert(Frame& F) {
    const int gw = F.vcu * NWAVES + F.wave, NGW = F.G * NWAVES;
    bf16_t* win_t = (bf16_t*)(F.ws + WS_WIN);
    for (int i = gw * 64 + F.lane; i < DEPTH * 128 * D / 8; i += NGW * 64) { const int l = i / (128 * D / 8), r = i % (128 * D / 8);
        *(u32x4*)(win_t + ((size_t)l * PP + INW) * D + (size_t)r * 8) = (u32x4){0u, 0u, 0u, 0u}; }
    cv::run(F, gw, NGW, cv::N_PROJ);
    __syncthreads();
}

__device__ __forceinline__ void modnorm_store(const f32x4 (&v)[4], const float* nw, const float* scale, const float* shift, bf16_t* orow, int lane) {
    float s = 0.f;
#pragma unroll
    for (int j = 0; j < 4; ++j) s += (v[j].x * v[j].x + v[j].y * v[j].y) + (v[j].z * v[j].z + v[j].w * v[j].w);
    const float rstd = 1.0f / sqrtf(wave_sum(s) * (1.0f / D) + NORM_EPS);
#pragma unroll
    for (int j = 0; j < 4; ++j) { const int k = 4 * lane + 256 * j; const f32x4 w = *(const f32x4*)(nw + k), sc = *(const f32x4*)(scale + k), sh = *(const f32x4*)(shift + k);
        const f32x4 h = v[j] * rstd * w * (sc + 1.0f) + sh;
        u32x2 o; o.x = pk2(h.x, h.y); o.y = pk2(h.z, h.w); *(u32x2*)(orow + k) = o; }
}
__device__ __forceinline__ void p0b_norm(Frame& F) {
    const int gw = F.vcu * NWAVES + F.wave, NGW = F.G * NWAVES;
    const float* mod = (const float*)(F.ws + WS_MOD); bf16_t* hb = (bf16_t*)(F.ws + WS_H);
    for (int tok = gw; tok < T; tok += NGW) { const int b = tok / SEQ; const float* xr = GIN(I_X) + (size_t)tok * D;
        f32x4 v[4];
#pragma unroll
        for (int j = 0; j < 4; ++j) v[j] = *(const f32x4*)(xr + 4 * F.lane + 256 * j);
        modnorm_store(v, GIN(I_NMIX), mod + (size_t)b * 6144 + 1024, mod + (size_t)b * 6144, hb + (size_t)tok * D, F.lane); }
}

__device__ __forceinline__ float sigmoid_f(float x) { return frcp(1.0f + fexp(-x)); }
__device__ __forceinline__ float gelu_tanh(float x) { const float u = 0.7978845608028654f * (x + 0.044715f * x * x * x); return x * frcp(1.0f + fexp(-2.0f * u)); }
constexpr int LRU_WT = 0, LRU_A = 18432, LRU_LS = 68, LRU_B = LRU_A + LCH * LRU_LS * 4, LRU_SEG = LRU_B + LCH * LRU_LS * 4, LRU_CARRY = LRU_SEG + 4096;
__device__ __forceinline__ void lru_unit(Frame& F, int l, int b, int g, int c4) {
    const int tid = F.tid, lane = F.lane, wave = F.wave;
    LAS unsigned char* lds = F.lds;
    const bf16_t* proj = (const bf16_t*)(F.ws + WS_PROJ);
    float* lrusum = (float*)(F.ws + WS_LRUSUM);
    const int gc0 = l * 384 + g * 64;
    { const float* wa = GIN(I_WA) + ((size_t)l * 6 + g) * 4096; const float* wx = GIN(I_WX) + ((size_t)l * 6 + g) * 4096;
      for (int idx = tid; idx < 8192; idx += 512) { const int gate = idx >> 12, i = (idx >> 6) & 63, j = idx & 63; const float v = (gate ? wx : wa)[i * 64 + j];
          *(LAS unsigned short*)(lds + LRU_WT + (gate * 64 + j) * 144 + i * 2) = (unsigned short)f2bf(v); } }
    float bavq[4], bxvq[4], c8q[4];
#pragma unroll
    for (int nt = 0; nt < 4; ++nt) { const int chq = 16 * nt + (lane & 15); bavq[nt] = GIN(I_BA)[gc0 + chq]; bxvq[nt] = GIN(I_BX)[gc0 + chq]; c8q[nt] = -8.0f * log1pf(__expf(-GIN(I_LAM)[gc0 + chq])); }
    u32x4 xq[2][4];
    { const int pos0 = 4 * c4 * LCH + wave * 16 + (lane & 15);
#pragma unroll
      for (int ks = 0; ks < 2; ++ks)
#pragma unroll
          for (int w = 0; w < 4; ++w) { const int p = pos0 - 3 + w; xq[ks][w] = (u32x4){0u, 0u, 0u, 0u}; if (p >= 0) xq[ks][w] = *(const u32x4*)(proj + (size_t)(b * SEQ + p) * PP + C_LX + g * 64 + 32 * ks + 8 * (lane >> 4)); } }
    __syncthreads();
#pragma unroll 1
  for (int c = 4 * c4; c < 4 * c4 + 4; ++c) {
    const int tt = lane & 15, kg = lane >> 4;
    const int tl = wave * 16 + tt;
    const int pos = c * LCH + tl;
    bf16x8 af[2];
    u32x4 xc[2][4];
#pragma unroll
    for (int ks = 0; ks < 2; ++ks)
#pragma unroll
        for (int w = 0; w < 4; ++w) xc[ks][w] = xq[ks][w];
    if (c + 1 < 4 * c4 + 4) {
#pragma unroll
        for (int ks = 0; ks < 2; ++ks)
#pragma unroll
            for (int w = 0; w < 4; ++w) xq[ks][w] = *(const u32x4*)(proj + (size_t)(b * SEQ + pos + LCH - 3 + w) * PP + C_LX + g * 64 + 32 * ks + 8 * kg); }
#pragma unroll
    for (int ks = 0; ks < 2; ++ks) { const int ch0 = 32 * ks + 8 * kg; float u[8];
        { const f32x4 cb0 = *(const f32x4*)(GIN(I_CONVB) + gc0 + ch0), cb1 = *(const f32x4*)(GIN(I_CONVB) + gc0 + ch0 + 4);
          u[0] = cb0.x; u[1] = cb0.y; u[2] = cb0.z; u[3] = cb0.w; u[4] = cb1.x; u[5] = cb1.y; u[6] = cb1.z; u[7] = cb1.w; }
#pragma unroll
        for (int w = 0; w < 4; ++w) { const int p = pos - 3 + w;
            if (p >= 0) { const u32x4 xv = xc[ks][w];
                const float* cw = GIN(I_CONVW) + (size_t)l * 4 * 384 + w * 384 + g * 64 + ch0; const f32x4 w0 = *(const f32x4*)cw, w1 = *(const f32x4*)(cw + 4);
                u[0] += bflo(xv.x) * w0.x; u[1] += bfhi(xv.x) * w0.y; u[2] += bflo(xv.y) * w0.z; u[3] += bfhi(xv.y) * w0.w;
                u[4] += bflo(xv.z) * w1.x; u[5] += bfhi(xv.z) * w1.y; u[6] += bflo(xv.w) * w1.z; u[7] += bfhi(xv.w) * w1.w; } }
        LAS float* ub = (LAS float*)(lds + LRU_B) + tl * LRU_LS + ch0;
        *(LAS f32x4*)ub = (f32x4){u[0], u[1], u[2], u[3]}; *(LAS f32x4*)(ub + 4) = (f32x4){u[4], u[5], u[6], u[7]};
        u32x4 pk; pk.x = pk2(u[0], u[1]); pk.y = pk2(u[2], u[3]); pk.z = pk2(u[4], u[5]); pk.w = pk2(u[6], u[7]); af[ks] = __builtin_bit_cast(bf16x8, pk); }
    LDS_WAIT(); asm volatile("" ::: "memory");
#pragma unroll
    for (int nt = 0; nt < 4; ++nt) { f32x4 pa = (f32x4){0.f, 0.f, 0.f, 0.f}, px = pa;
#pragma unroll
        for (int ks = 0; ks < 2; ++ks) { const bf16x8 ba = *(const LAS bf16x8*)(lds + LRU_WT + (16 * nt + tt) * 144 + (32 * ks + 8 * kg) * 2);
            const bf16x8 bx = *(const LAS bf16x8*)(lds + LRU_WT + (64 + 16 * nt + tt) * 144 + (32 * ks + 8 * kg) * 2);
            pa = __builtin_amdgcn_mfma_f32_16x16x32_bf16(af[ks], ba, pa, 0, 0, 0); px = __builtin_amdgcn_mfma_f32_16x16x32_bf16(af[ks], bx, px, 0, 0, 0); }
        const int ch = 16 * nt + tt; const float bav = bavq[nt], bxv = bxvq[nt], c8 = c8q[nt];
#pragma unroll
        for (int j = 0; j < 4; ++j) { const int t2 = wave * 16 + 4 * kg + j;
            const float r = sigmoid_f(pa[j] + bav), ii = sigmoid_f(px[j] + bxv), la = c8 * r, a = fexp(la), bc = __builtin_amdgcn_sqrtf(fmaxf(1.0f - a * a, 0.f));
            LAS float* pb = (LAS float*)(lds + LRU_B) + t2 * LRU_LS + ch; const float uv = *pb;
            *((LAS float*)(lds + LRU_A) + t2 * LRU_LS + ch) = a; *pb = bc * ii * uv; } }
    __syncthreads();
    const int ch = tid & 63, seg = tid >> 6;
    const LAS float* Ab = (const LAS float*)(lds + LRU_A) + (seg * 16) * LRU_LS + ch; const LAS float* Bb = (const LAS float*)(lds + LRU_B) + (seg * 16) * LRU_LS + ch;
    float ar[16], br[16];
    { float h = 0.f, A = 1.f;
#pragma unroll
      for (int t = 0; t < 16; ++t) { ar[t] = Ab[t * LRU_LS]; br[t] = Bb[t * LRU_LS]; }
#pragma unroll
      for (int t = 0; t < 16; ++t) { h = ar[t] * h + br[t]; A *= ar[t]; }
      LAS float* sg = (LAS float*)(lds + LRU_SEG); sg[(seg * 2) * 64 + ch] = A; sg[(seg * 2 + 1) * 64 + ch] = h; }
    __syncthreads();
    const LAS float* sg = (const LAS float*)(lds + LRU_SEG);
    if (tid < 64) { float H = 0.f, At = 1.f;
#pragma unroll
        for (int s = 0; s < 8; ++s) { const float a = sg[(s * 2) * 64 + ch]; H = a * H + sg[(s * 2 + 1) * 64 + ch]; At *= a; }
        float* o = lrusum + (((size_t)(b * 6 + g) * NLCH + c) * 2) * 64; o[ch] = At; o[64 + ch] = H; }
    { float h = 0.f, A = 1.f;
#pragma unroll
      for (int s = 0; s < 8; ++s) if (s < seg) { const float a = sg[(s * 2) * 64 + ch]; h = a * h + sg[(s * 2 + 1) * 64 + ch]; A *= a; }
      bf16_t* lh = (bf16_t*)(F.ws + WS_LRUH); bf16_t* la = (bf16_t*)(F.ws + WS_LRUA);
      const size_t row0 = (size_t)b * SEQ + c * LCH + seg * 16;
#pragma unroll
      for (int t = 0; t < 16; ++t) { const float a = ar[t]; h = a * h + br[t]; A *= a; const unsigned w = cvtpk(h, A);
          lh[(row0 + t) * 384 + g * 64 + ch] = (bf16_t)(w & 0xffffu); la[(row0 + t) * 384 + g * 64 + ch] = (bf16_t)(w >> 16); } }
    __syncthreads();
  }
}
__device__ __forceinline__ void lru_fix(Frame& F, int b, int g, int c) {
    const int tid = F.tid, ch = tid & 63, seg = tid >> 6;
    const float* lrusum = (const float*)(F.ws + WS_LRUSUM);
    LAS float* cy = (LAS float*)(F.lds + LRU_CARRY);
    if (tid < 64) { const float* s0 = lrusum + ((size_t)(b * 6 + g) * NLCH) * 128; float sa[NLCH], sh[NLCH];
#pragma unroll
        for (int cc = 0; cc < NLCH; ++cc) { sa[cc] = (cc < c) ? s0[cc * 128 + ch] : 1.0f; sh[cc] = (cc < c) ? s0[cc * 128 + 64 + ch] : 0.0f; }
        float hin = 0.f;
#pragma unroll
        for (int cc = 0; cc < NLCH; ++cc) hin = sa[cc] * hin + sh[cc];
        cy[ch] = hin; }
    const bf16_t* proj = (const bf16_t*)(F.ws + WS_PROJ); const bf16_t* lh = (const bf16_t*)(F.ws + WS_LRUH); const bf16_t* la = (const bf16_t*)(F.ws + WS_LRUA); bf16_t* ymix = (bf16_t*)(F.ws + WS_YMIX);
    const int tl = tid >> 2, c0 = 16 * (tid & 3);
    const size_t row = (size_t)b * SEQ + c * LCH + tl;
    const u32x4 g0 = *(const u32x4*)(proj + row * PP + C_LG + g * 64 + c0), g1 = *(const u32x4*)(proj + row * PP + C_LG + g * 64 + c0 + 8);
    const u32x4 h0 = *(const u32x4*)(lh + row * 384 + g * 64 + c0), h1 = *(const u32x4*)(lh + row * 384 + g * 64 + c0 + 8);
    const u32x4 a0 = *(const u32x4*)(la + row * 384 + g * 64 + c0), a1 = *(const u32x4*)(la + row * 384 + g * 64 + c0 + 8);
    __syncthreads();
    const unsigned gw[8] = {g0.x, g0.y, g0.z, g0.w, g1.x, g1.y, g1.z, g1.w}, hw[8] = {h0.x, h0.y, h0.z, h0.w, h1.x, h1.y, h1.z, h1.w}, aw[8] = {a0.x, a0.y, a0.z, a0.w, a1.x, a1.y, a1.z, a1.w};
    unsigned ow[8];
#pragma unroll
    for (int i = 0; i < 8; ++i) { const float hin0 = cy[c0 + 2 * i], hin1 = cy[c0 + 2 * i + 1];
        const float y0 = gelu_tanh(bflo(gw[i])) * (bflo(hw[i]) + bflo(aw[i]) * hin0), y1 = gelu_tanh(bfhi(gw[i])) * (bfhi(hw[i]) + bfhi(aw[i]) * hin1);
        ow[i] = cvtpk(y0, y1); }
    bf16_t* yp = ymix + row * D + Y_LRU + g * 64 + c0;
    *(u32x4*)yp = (u32x4){ow[0], ow[1], ow[2], ow[3]}; *(u32x4*)(yp + 8) = (u32x4){ow[4], ow[5], ow[6], ow[7]};
    __syncthreads();
}

constexpr int AT_KS = 144;
constexpr int AT_K = 0, AT_V = 2 * 64 * AT_KS;
__device__ __forceinline__ s16x4 vtr(const LAS unsigned char* p) { return __builtin_bit_cast(s16x4, __builtin_amdgcn_ds_read_tr16_b64_v4i16((LAS v4i16_t*)p)); }
template <int MODE>
__device__ __forceinline__ void attn_unit(Frame& F, int l, int b, int h, int qb) {
    const int tid = F.tid, lane = F.lane, wave = F.wave;
    LAS unsigned char* lds = F.lds;
    const bf16_t* proj = (const bf16_t*)(F.ws + WS_PROJ); bf16_t* ymix = (bf16_t*)(F.ws + WS_YMIX);
    const int colQ = (MODE == 0 ? C_MQ : C_RQ) + h * 64, colK = (MODE == 0 ? C_MK : C_RK) + h * 64, colV = (MODE == 0 ? C_MV : C_RV) + h * 64;
    const int ql = lane & 15, g4 = lane >> 4;
    const size_t rowb = (size_t)b * SEQ;
    int qidx[2]; bf16x8 qf[2][2];
#pragma unroll
    for (int mt = 0; mt < 2; ++mt) { qidx[mt] = qb * 256 + wave * 32 + mt * 16 + ql;
#pragma unroll
        for (int ks = 0; ks < 2; ++ks) qf[mt][ks] = *(const bf16x8*)(proj + (rowb + qidx[mt]) * PP + colQ + 32 * ks + 8 * g4); }
    const int own = qb;
    unsigned amask[2] = {0u, 0u};
    if constexpr (MODE == 0) {
        const float* km = (const float*)(F.ws + WS_KMEAN) + ((size_t)(b * 6 + h) * 8) * 64;
#pragma unroll
        for (int mt = 0; mt < 2; ++mt) { float gs[8];
#pragma unroll
            for (int n = 0; n < 8; ++n) { float s = 0.f;
                if (n < own) {
#pragma unroll
                    for (int ks = 0; ks < 2; ++ks) { const f32x4 k0 = *(const f32x4*)(km + n * 64 + 32 * ks + 8 * g4), k1 = *(const f32x4*)(km + n * 64 + 32 * ks + 8 * g4 + 4);
                        const u32x4 qw = __builtin_bit_cast(u32x4, qf[mt][ks]);
                        s += bflo(qw.x) * k0.x + bfhi(qw.x) * k0.y + bflo(qw.y) * k0.z + bfhi(qw.y) * k0.w + bflo(qw.z) * k1.x + bfhi(qw.z) * k1.y + bflo(qw.w) * k1.z + bfhi(qw.w) * k1.w; } }
                s += __shfl_xor(s, 16); s += __shfl_xor(s, 32);
                gs[n] = (n < own) ? s : -INFINITY; }
#pragma unroll
            for (int n = 0; n < 8; ++n) { int cnt = 0;
#pragma unroll
                for (int m = 0; m < 8; ++m) if (m != n) cnt += (gs[m] > gs[n] || (gs[m] == gs[n] && m < n)) ? 1 : 0;
                if (n < own && cnt < 3) amask[mt] |= (1u << n); } }
    }
    const float log2g = (MODE == 1) ? log2f(1.0f - exp2f(-5.0f - (float)h)) : 0.f;
    float dc[4][4];
    if constexpr (MODE == 1) {
#pragma unroll
        for (int t = 0; t < 4; ++t)
#pragma unroll
            for (int j = 0; j < 4; ++j) dc[t][j] = ex2(-(float)(16 * t + 4 * g4 + j) * log2g);
    }
    const int lt = tid & 255, lrow = lt >> 2, lc = lt & 3;
    const bf16_t* gsrc = proj + (rowb + lrow) * PP + (tid < 256 ? colK : colV) + lc * 8;
    const int ldst = (tid < 256 ? AT_K : AT_V) + lrow * AT_KS + lc * 16;
    const int nkt = 4 * qb + 4;
    u32x4 pre0 = *(const u32x4*)(gsrc), pre1 = *(const u32x4*)(gsrc + 32);
    *(LAS u32x4*)(lds + ldst) = pre0; *(LAS u32x4*)(lds + ldst + 64) = pre1;
    __syncthreads();
    f32x4 o[2][4];
#pragma unroll
    for (int mt = 0; mt < 2; ++mt)
#pragma unroll
        for (int dt = 0; dt < 4; ++dt) o[mt][dt] = (f32x4){0.f, 0.f, 0.f, 0.f};
    float mrun[2] = {-1e30f, -1e30f}, lsum[2] = {0.f, 0.f};
    const int li = lane & 15, tq = li >> 2, tp = li & 3;
    auto tile = [&](const int kt, auto diag_c) {
        constexpr bool diag = decltype(diag_c)::value;
        const int buf = kt & 1;
        if (kt + 1 < nkt) { const bf16_t* gp = gsrc + (size_t)(kt + 1) * 64 * PP; pre0 = *(const u32x4*)(gp); pre1 = *(const u32x4*)(gp + 32); }
        f32x4 s[2][4];
        const LAS unsigned char* kb = lds + AT_K + buf * 64 * AT_KS;
#pragma unroll
        for (int t = 0; t < 4; ++t) { s[0][t] = (f32x4){0.f, 0.f, 0.f, 0.f}; s[1][t] = (f32x4){0.f, 0.f, 0.f, 0.f};
#pragma unroll
            for (int ks = 0; ks < 2; ++ks) { const bf16x8 kf = *(const LAS bf16x8*)(kb + (16 * t + ql) * AT_KS + (32 * ks + 8 * g4) * 2);
                s[0][t] = __builtin_amdgcn_mfma_f32_16x16x32_bf16(kf, qf[0][ks], s[0][t], 0, 0, 0);
                s[1][t] = __builtin_amdgcn_mfma_f32_16x16x32_bf16(kf, qf[1][ks], s[1][t], 0, 0, 0); } }
        bf16x8 pf[2][2];
#pragma unroll
        for (int mt = 0; mt < 2; ++mt) {
            float p[4][4];
            if constexpr (MODE == 0) {
                constexpr float SC = 0.125f * 1.4426950408889634f;
                const int kblk = kt >> 2;
                const bool allow = !(kblk < own && ((amask[mt] >> kblk) & 1u) == 0u);
                float mx = -INFINITY;
#pragma unroll
                for (int t = 0; t < 4; ++t)
#pragma unroll
                    for (int j = 0; j < 4; ++j) { float v = s[mt][t][j];
                        if constexpr (diag) { const int key = kt * 64 + 16 * t + 4 * g4 + j; v = (key <= qidx[mt]) ? v : -INFINITY; }
                        p[t][j] = v; mx = fmaxf(mx, v); }
                mx = allow ? mx * SC : -INFINITY;
                mx = fmaxf(mx, __shfl_xor(mx, 16)); mx = fmaxf(mx, __shfl_xor(mx, 32));
                const float mnew = fmaxf(mrun[mt], mx), alpha = ex2(mrun[mt] - mnew); mrun[mt] = mnew;
                const float nb = allow ? -mnew : -INFINITY;
                float ps = 0.f;
#pragma unroll
                for (int t = 0; t < 4; ++t)
#pragma unroll
                    for (int j = 0; j < 4; ++j) { const float e = ex2(fmaf(p[t][j], SC, nb)); p[t][j] = e; ps += e; }
                lsum[mt] = lsum[mt] * alpha + ps;
#pragma unroll
                for (int dt = 0; dt < 4; ++dt) o[mt][dt] = o[mt][dt] * alpha;
            } else {
                const float at = ex2((float)(qidx[mt] - kt * 64) * log2g);
#pragma unroll
                for (int t = 0; t < 4; ++t)
#pragma unroll
                    for (int j = 0; j < 4; ++j) { float v = s[mt][t][j] * (at * dc[t][j]);
                        if constexpr (diag) { const int key = kt * 64 + 16 * t + 4 * g4 + j; v = (key <= qidx[mt]) ? v : 0.f; }
                        p[t][j] = v; }
            }
#pragma unroll
            for (int s2 = 0; s2 < 2; ++s2) { u32x4 w; w.x = cvtpk(p[2 * s2][0], p[2 * s2][1]); w.y = cvtpk(p[2 * s2][2], p[2 * s2][3]); w.z = cvtpk(p[2 * s2 + 1][0], p[2 * s2 + 1][1]); w.w = cvtpk(p[2 * s2 + 1][2], p[2 * s2 + 1][3]);
                pf[mt][s2] = __builtin_bit_cast(bf16x8, w); }
        }
        const LAS unsigned char* vb = lds + AT_V + buf * 64 * AT_KS;
#pragma unroll
        for (int dt = 0; dt < 4; ++dt)
#pragma unroll
            for (int s2 = 0; s2 < 2; ++s2) { const s16x4 v0 = vtr(vb + (32 * s2 + 4 * g4 + tq) * AT_KS + (16 * dt + 4 * tp) * 2), v1 = vtr(vb + (32 * s2 + 16 + 4 * g4 + tq) * AT_KS + (16 * dt + 4 * tp) * 2);
                bf16x8 vf; vf[0] = v0[0]; vf[1] = v0[1]; vf[2] = v0[2]; vf[3] = v0[3]; vf[4] = v1[0]; vf[5] = v1[1]; vf[6] = v1[2]; vf[7] = v1[3];
                o[0][dt] = __builtin_amdgcn_mfma_f32_16x16x32_bf16(vf, pf[0][s2], o[0][dt], 0, 0, 0);
                o[1][dt] = __builtin_amdgcn_mfma_f32_16x16x32_bf16(vf, pf[1][s2], o[1][dt], 0, 0, 0); }
        if (kt + 1 < nkt) { const int nb = (buf ^ 1) * 64 * AT_KS; *(LAS u32x4*)(lds + ldst + nb) = pre0; *(LAS u32x4*)(lds + ldst + nb + 64) = pre1; }
        __syncthreads();
    };
    for (int kt = 0; kt < 4 * qb; ++kt) tile(kt, std::false_type{});
    for (int kt = 4 * qb; kt < nkt; ++kt) tile(kt, std::true_type{});
#pragma unroll
    for (int mt = 0; mt < 2; ++mt) {
        if constexpr (MODE == 0) {
            float ls = lsum[mt]; ls += __shfl_xor(ls, 16); ls += __shfl_xor(ls, 32);
            const float inv = 1.0f / ls;
#pragma unroll
            for (int dt = 0; dt < 4; ++dt) { const f32x4 v = o[mt][dt] * inv; u32x2 w; w.x = cvtpk(v.x, v.y); w.y = cvtpk(v.z, v.w);
                *(u32x2*)(ymix + (rowb + qidx[mt]) * D + Y_MOBA + h * 64 + 16 * dt + 4 * g4) = w; }
        } else {
            float sm = 0.f;
#pragma unroll
            for (int dt = 0; dt < 4; ++dt) sm += (o[mt][dt].x + o[mt][dt].y) + (o[mt][dt].z + o[mt][dt].w);
            sm += __shfl_xor(sm, 16); sm += __shfl_xor(sm, 32);
            const float mu = sm * (1.0f / 64.0f); float vs = 0.f;
#pragma unroll
            for (int dt = 0; dt < 4; ++dt) { const f32x4 dv = o[mt][dt] - mu; vs += (dv.x * dv.x + dv.y * dv.y) + (dv.z * dv.z + dv.w * dv.w); }
            vs += __shfl_xor(vs, 16); vs += __shfl_xor(vs, 32);
            const float rstd = 1.0f / sqrtf(vs * (1.0f / 64.0f) + NORM_EPS);
#pragma unroll
            for (int dt = 0; dt < 4; ++dt) { const int d0 = h * 64 + 16 * dt + 4 * g4;
                const f32x4 nw = *(const f32x4*)(GIN(I_RETNW) + l * 256 + d0);
                const u32x2 gw2 = *(const u32x2*)(proj + (rowb + qidx[mt]) * PP + C_RG + d0);
                const float g0 = bflo(gw2.x), g1 = bfhi(gw2.x), g2 = bflo(gw2.y), g3 = bfhi(gw2.y);
                const f32x4 y = (o[mt][dt] - mu) * rstd * nw;
                u32x2 w; w.x = cvtpk(y.x * silu_f(g0), y.y * silu_f(g1)); w.y = cvtpk(y.z * silu_f(g2), y.w * silu_f(g3));
                *(u32x2*)(ymix + (rowb + qidx[mt]) * D + Y_RET + d0) = w; }
        }
    }
}

__device__ __forceinline__ void p2a(Frame& F, int l, int rep) {
    for (int u = F.bx; u < BATCH * 6 * (NLCH / 4); u += F.G) lru_unit(F, l, u / (6 * (NLCH / 4)), (u / (NLCH / 4)) % 6, u % (NLCH / 4));
    if (rep == 0 && F.bx >= BATCH * 6 * (NLCH / 4)) conv_one(F, l);
    bf16_t* proj = (bf16_t*)(F.ws + WS_PROJ);
    for (int u = (F.G - 1 - F.bx); u < BATCH * 6; u += F.G) { const int b = u / 6, h = u % 6, rg = F.lane >> 3, c8 = F.lane & 7;
        const bf16_t* kp = proj + ((size_t)b * SEQ + F.wave * 256 + rg) * PP + C_MK + h * 64 + c8 * 8;
        float a[8];
#pragma unroll
        for (int i = 0; i < 8; ++i) a[i] = 0.f;
#pragma unroll 4
        for (int it = 0; it < 32; ++it) { const u32x4 v = *(const u32x4*)(kp + (size_t)it * 8 * PP);
            a[0] += bflo(v.x); a[1] += bfhi(v.x); a[2] += bflo(v.y); a[3] += bfhi(v.y); a[4] += bflo(v.z); a[5] += bfhi(v.z); a[6] += bflo(v.w); a[7] += bfhi(v.w); }
#pragma unroll
        for (int i = 0; i < 8; ++i) { a[i] += __shfl_xor(a[i], 8); a[i] += __shfl_xor(a[i], 16); a[i] += __shfl_xor(a[i], 32); }
        if (rg == 0) { float* o = (float*)(F.ws + WS_KMEAN) + ((size_t)(b * 6 + h) * 8 + F.wave) * 64 + c8 * 8;
            *(f32x4*)o = (f32x4){a[0], a[1], a[2], a[3]} * (1.0f / 256.0f); *(f32x4*)(o + 4) = (f32x4){a[4], a[5], a[6], a[7]} * (1.0f / 256.0f); } }
    const int gw = F.vcu * NWAVES + F.wave, NGW = F.G * NWAVES;
    const float* rc = (const float*)(F.ws + WS_ROT); const float* rs = rc + SEQ * 32;
    const int which = F.lane >> 5, hh = (F.lane >> 3) & 3, i0 = (F.lane & 7) * 4;
    if (rep == 0) for (int tok = gw; tok < T; tok += NGW) { const int pos = tok % SEQ;
        bf16_t* p = proj + (size_t)tok * PP + which * 256 + hh * 64 + i0;
        const u32x2 a = *(const u32x2*)p, bb = *(const u32x2*)(p + 32);
        const f32x4 cs = *(const f32x4*)(rc + pos * 32 + i0), sn = *(const f32x4*)(rs + pos * 32 + i0);
        const float x1[4] = {bflo(a.x), bfhi(a.x), bflo(a.y), bfhi(a.y)}, x2[4] = {bflo(bb.x), bfhi(bb.x), bflo(bb.y), bfhi(bb.y)};
        const float sc = which ? 0.125f : 1.0f; float y1[4], y2[4];
#pragma unroll
        for (int i = 0; i < 4; ++i) { y1[i] = (x1[i] * cs[i] - x2[i] * sn[i]) * sc; y2[i] = (x2[i] * cs[i] + x1[i] * sn[i]) * sc; }
        u32x2 o1, o2; o1.x = pk2(y1[0], y1[1]); o1.y = pk2(y1[2], y1[3]); o2.x = pk2(y2[0], y2[1]); o2.y = pk2(y2[2], y2[3]);
        *(u32x2*)p = o1; *(u32x2*)(p + 32) = o2; }
}

__device__ __forceinline__ void p2b(Frame& F, int l, int rep) {
    volatile LAS int* sq = (volatile LAS int*)(F.lds + MISC_OFF + 1024);
    unsigned* head = (unsigned*)(F.ctl + CW_Q + 64 * l + rep);
    constexpr int N_ATT = 8 * 80, N_ALL = N_ATT + BATCH * 6 * NLCH;
    int q = (((F.bx >> 3) & 7) < 3) ? 1 : 0;
#pragma unroll 1
    for (int pass = 0; pass < 2; ++pass, q ^= 1) {
        q = __builtin_amdgcn_readfirstlane(q);
        { int _t = (F.wave << 6) | lane_id(); asm volatile("" : "+v"(_t)); F.tid = _t; F.lane = _t & 63;
          GAS unsigned char* _w = (GAS unsigned char*)F.ws; asm volatile("" : "+s"(_w)); F.ws = (unsigned char*)_w; F.ctl = (gu32*)(F.ws + WS_CTL); }
        if (q == 0) {
            for (;;) {
                if (F.tid == 0) *sq = (int)xb_add(head, 1u);
                __syncthreads();
                const int id = __builtin_amdgcn_readfirstlane(*sq);
                __syncthreads();
                if (id >= N_ALL) break;
                if (id < N_ATT) { const int qi = 7 - id / 80, r = id % 80;
                    if (r < 48) attn_unit<0>(F, l, r / 6, r % 6, qi); else attn_unit<1>(F, l, (r - 48) / 4, (r - 48) % 4, qi); }
                else { const int u = id - N_ATT; lru_fix(F, u / (6 * NLCH), (u / NLCH) % 6, u % NLCH); }
            }
        } else {
            unsigned nxt = 0u; unsigned zoff = 0u; asm volatile("" : "+v"(zoff));
            if (F.tid == 0) nxt = xb_add(head + 32 + zoff, 1u);
            for (;;) {
                if (F.tid == 0) *sq = (int)nxt;
                asm volatile("s_waitcnt lgkmcnt(0)\n\ts_barrier" ::: "memory");
                const int id = __builtin_amdgcn_readfirstlane(*sq);
                asm volatile("s_waitcnt lgkmcnt(0)\n\ts_barrier" ::: "memory");
                if (id >= cv::NB_LAYER - cv::tail_batches(l)) break;
                if (F.tid == 0) nxt = xb_add(head + 32 + zoff, 1u);
                cv::run_batch(F, cv::batch_base(l, id));
            }
            if (cv::tail_batches(l) > 0) for (;;) {
                if (F.tid == 0) *sq = (int)xb_add(head + 40 + zoff, 1u);
                asm volatile("s_waitcnt lgkmcnt(0)\n\ts_barrier" ::: "memory");
                const int id = __builtin_amdgcn_readfirstlane(*sq);
                asm volatile("s_waitcnt lgkmcnt(0)\n\ts_barrier" ::: "memory");
                if (id >= 2 * cv::tail_batches(l)) break;
                cv::run_half(F, cv::batch_base(l, cv::NB_LAYER - cv::tail_batches(l) + (id >> 1)) + 16 * (id & 1));
            }
        }
    }
}

constexpr int P4_SELE = MISC_OFF + 2048, P4_SELG = P4_SELE + 1024, P4_HIST = P4_SELG + 1024, P4_BASE = P4_HIST + 128, P4_RANK = P4_BASE + 128;
constexpr int P4_AS = 2064;
constexpr int P4_AHI = 0, P4_ALO = 16 * P4_AS, P4_PART = 2 * 16 * P4_AS, P4_LOG = P4_PART + 8 * 16 * 32 * 4;
__device__ __forceinline__ void p4_router(Frame& F, int l) {
    LAS unsigned char* lds = F.lds;
    LAS int* selE = (LAS int*)(lds + P4_SELE); LAS float* selG = (LAS float*)(lds + P4_SELG);
    LAS int* hist = (LAS int*)(lds + P4_HIST); LAS int* base = (LAS int*)(lds + P4_BASE); LAS int* lrank = (LAS int*)(lds + P4_RANK);
    const float* mod = (const float*)(F.ws + WS_MOD) + (size_t)l * BATCH * 6144;
    const bf16_t* x1 = (const bf16_t*)(F.ws + WS_X1); unsigned char* hb8 = (unsigned char*)(F.ws + WS_H8);
    i32x2* slot = (i32x2*)(F.ws + WS_SLOT);
    unsigned* cntg = (unsigned*)(F.ctl + CW_CNT + 64 * l);
    const int lane = F.lane, wave = F.wave, tid = F.tid, tt = lane & 15, g4 = lane >> 4;
    bf16x8 bh[2][4], bl[2][4];
    { const bf16_t* rwt = (const bf16_t*)(F.ws + WS_RWT) + (size_t)l * 2 * NE * D;
#pragma unroll
      for (int nt = 0; nt < 2; ++nt)
#pragma unroll
          for (int ks = 0; ks < 4; ++ks) { const size_t o = (size_t)(16 * nt + tt) * D + 128 * wave + 32 * ks + 8 * g4; bh[nt][ks] = *(const bf16x8*)(rwt + o); bl[nt][ks] = *(const bf16x8*)(rwt + (size_t)NE * D + o); } }
    for (int tg = F.bx; tg < T / 64; tg += F.G) {
        if (tid < 32) hist[tid] = 0;
        const int tok0 = tg * 64, b = tok0 / SEQ;
        f32x4 mA[4], mB[4];
#pragma unroll
        for (int j = 0; j < 4; ++j) { const int k = 4 * lane + 256 * j; const f32x4 w = *(const f32x4*)(GIN(I_NFFN) + l * D + k), sc = *(const f32x4*)(mod + (size_t)b * 6144 + 4096 + k);
            mA[j] = w * (sc + 1.0f); mB[j] = *(const f32x4*)(mod + (size_t)b * 6144 + 3072 + k); }
#pragma unroll 1
        for (int grp = 0; grp < 4; ++grp) {
            { f32x4 v[2][4];
#pragma unroll
              for (int q = 0; q < 2; ++q)
#pragma unroll
                  for (int j = 0; j < 4; ++j) { const u32x2 w = *(const u32x2*)(x1 + ((size_t)tok0 + grp * 16 + 2 * wave + q) * D + 4 * lane + 256 * j); v[q][j] = (f32x4){bflo(w.x), bfhi(w.x), bflo(w.y), bfhi(w.y)}; }
#pragma unroll
              for (int q = 0; q < 2; ++q) { const int tl = 2 * wave + q; const size_t tok = (size_t)tok0 + grp * 16 + tl; float sa = 0.f;
#pragma unroll
                for (int j = 0; j < 4; ++j) sa += (v[q][j].x * v[q][j].x + v[q][j].y * v[q][j].y) + (v[q][j].z * v[q][j].z + v[q][j].w * v[q][j].w);
                const float ra = 1.0f / sqrtf(wave_sum(sa) * (1.0f / D) + NORM_EPS);
#pragma unroll
                for (int j = 0; j < 4; ++j) { const int k = 4 * lane + 256 * j;
                    const f32x4 hv = v[q][j] * ra * mA[j] + mB[j];
                    u32x2 hi; hi.x = cvtpk(hv.x, hv.y); hi.y = cvtpk(hv.z, hv.w);
                    const f32x4 lo = hv - (f32x4){bflo(hi.x), bfhi(hi.x), bflo(hi.y), bfhi(hi.y)};
                    u32x2 lw; lw.x = cvtpk(lo.x, lo.y); lw.y = cvtpk(lo.z, lo.w);
                    *(unsigned*)(hb8 + tok * D + k) = cvt4_fp8(hv.x, hv.y, hv.z, hv.w);
                    *(LAS u32x2*)(lds + P4_AHI + tl * P4_AS + k * 2) = hi; *(LAS u32x2*)(lds + P4_ALO + tl * P4_AS + k * 2) = lw; } } }
            __syncthreads();
            { f32x4 acc[2] = {(f32x4){0.f, 0.f, 0.f, 0.f}, (f32x4){0.f, 0.f, 0.f, 0.f}};
#pragma unroll
              for (int ks = 0; ks < 4; ++ks) { const int ao = tt * P4_AS + (128 * wave + 32 * ks + 8 * g4) * 2;
                  const bf16x8 ah = *(const LAS bf16x8*)(lds + P4_AHI + ao), al = *(const LAS bf16x8*)(lds + P4_ALO + ao);
#pragma unroll
                  for (int nt = 0; nt < 2; ++nt) { acc[nt] = __builtin_amdgcn_mfma_f32_16x16x32_bf16(ah, bh[nt][ks], acc[nt], 0, 0, 0);
                      acc[nt] = __builtin_amdgcn_mfma_f32_16x16x32_bf16(ah, bl[nt][ks], acc[nt], 0, 0, 0); acc[nt] = __builtin_amdgcn_mfma_f32_16x16x32_bf16(al, bh[nt][ks], acc[nt], 0, 0, 0); } }
              LAS float* part = (LAS float*)(lds + P4_PART) + wave * 512;
#pragma unroll
              for (int nt = 0; nt < 2; ++nt)
#pragma unroll
                  for (int j = 0; j < 4; ++j) part[(4 * g4 + j) * 32 + 16 * nt + tt] = acc[nt][j]; }
            __syncthreads();
            { const LAS float* part = (const LAS float*)(lds + P4_PART); float sum = 0.f;
#pragma unroll
              for (int w = 0; w < 8; ++w) sum += part[w * 512 + tid];
              const int e = tid & 31; float v = sum + GIN(I_RB)[l * NE + e];
              float tv[4]; int te[4];
#pragma unroll
              for (int k = 0; k < 4; ++k) { float bv = v; int be = e;
#pragma unroll
                  for (int msk = 16; msk >= 1; msk >>= 1) { const float ov = __shfl_xor(bv, msk); const int oe = __shfl_xor(be, msk); const bool take = (ov > bv) || (ov == bv && oe < be); bv = take ? ov : bv; be = take ? oe : be; }
                  tv[k] = bv; te[k] = be; if (e == be) v = -INFINITY; }
              if (e == 0) { const float e1 = fexp(tv[1] - tv[0]), e2 = fexp(tv[2] - tv[0]), e3 = fexp(tv[3] - tv[0]), inv = 1.0f / (1.0f + e1 + e2 + e3);
                  const int s0 = (grp * 16 + (tid >> 5)) * 4; selE[s0] = te[0]; selE[s0 + 1] = te[1]; selE[s0 + 2] = te[2]; selE[s0 + 3] = te[3];
                  selG[s0] = inv; selG[s0 + 1] = e1 * inv; selG[s0 + 2] = e2 * inv; selG[s0 + 3] = e3 * inv; } }
        }
        __syncthreads();
        if (tid < 256) lrank[tid] = __hip_atomic_fetch_add(&hist[selE[tid]], 1, __ATOMIC_RELAXED, __HIP_MEMORY_SCOPE_WORKGROUP);
        __syncthreads();
        if (tid < 32) base[tid] = (int)xb_add(cntg + tid, (unsigned)hist[tid]);
        __syncthreads();
        if (tid < 256) { const int e = selE[tid], rank = base[e] + lrank[tid]; i32x2 ent; ent.x = (tok0 + (tid >> 2)) * 4 + (tid & 3); ent.y = __builtin_bit_cast(int, selG[tid]); slot[(size_t)e * CAP + rank] = ent; }
        __syncthreads();
    }
}
__device__ __forceinline__ int moe_table(Frame& F, int l) {
    LAS int* tab = (LAS int*)(F.lds + MISC_OFF + 1536);
    if (F.tid < 32) {
        const int e = F.tid; const int cn = (int)__hip_atomic_load((unsigned*)(F.ctl + CW_CNT + 64 * l + e), RLX_AGENT); const int nb = (cn + 255) >> 8;
        int inc = nb;
#pragma unroll
        for (int d = 1; d < 32; d <<= 1) { const int o = __shfl_up(inc, d); if (e >= d) inc += o; }
        tab[e] = inc - nb; tab[33 + e] = cn; if (e == 31) tab[32] = inc; }
    __syncthreads();
    return __builtin_amdgcn_readfirstlane(tab[32]);
}

__device__ __forceinline__ void p7_combine(Frame& F, int l) {
    const int gw = F.vcu * NWAVES + F.wave, NGW = F.G * NWAVES, lane = F.lane;
    const float* mod = (const float*)(F.ws + WS_MOD);
    const bf16_t* x1 = (const bf16_t*)(F.ws + WS_X1); bf16_t* x2 = (bf16_t*)(F.ws + WS_X2); const unsigned char* yb = (const unsigned char*)(F.ws + WS_YBUF); bf16_t* hb = (bf16_t*)(F.ws + WS_H);
    constexpr int TPI = 4;
    for (int t2 = gw; t2 < T / TPI; t2 += NGW) { const int b = (TPI * t2) / SEQ;
        f32x4 v[TPI][4];
#pragma unroll
        for (int q = 0; q < TPI; ++q) { const size_t tok = (size_t)TPI * t2 + q;
#pragma unroll
            for (int j = 0; j < 4; ++j) { const int k = 4 * lane + 256 * j; f32x4 s = (f32x4){0.f, 0.f, 0.f, 0.f};
#pragma unroll
                for (int kk = 0; kk < 4; ++kk) { const unsigned w = *(const unsigned*)(yb + (tok * 4 + kk) * D + k); const f32x2 lo = __builtin_amdgcn_cvt_pk_f32_fp8((int)w, false), hi = __builtin_amdgcn_cvt_pk_f32_fp8((int)w, true); s += (f32x4){lo.x, lo.y, hi.x, hi.y}; }
                s = s * 0.0625f;
                const f32x4 g2 = *(const f32x4*)(mod + ((size_t)l * BATCH + b) * 6144 + 5120 + k);
                const u32x2 xw = *(const u32x2*)(x1 + tok * D + k);
                v[q][j] = (f32x4){bflo(xw.x), bfhi(xw.x), bflo(xw.y), bfhi(xw.y)} + g2 * s * (l == 0 ? DBG_MOE0 : DBG_MOE1); } }
#pragma unroll
        for (int q = 0; q < TPI; ++q) { const size_t tok = (size_t)TPI * t2 + q;
            if (l + 1 < DEPTH) {
#pragma unroll
                for (int j = 0; j < 4; ++j) { u32x2 ow; ow.x = cvtpk(v[q][j].x, v[q][j].y); ow.y = cvtpk(v[q][j].z, v[q][j].w); *(u32x2*)(x2 + tok * D + 4 * lane + 256 * j) = ow; }
                const float* m1 = mod + ((size_t)(l + 1) * BATCH + b) * 6144;
                modnorm_store(v[q], GIN(I_NMIX) + (l + 1) * D, m1 + 1024, m1, hb + tok * D, lane);
            } else {
                float s = 0.f;
#pragma unroll
                for (int j = 0; j < 4; ++j) s += (v[q][j].x * v[q][j].x + v[q][j].y * v[q][j].y) + (v[q][j].z * v[q][j].z + v[q][j].w * v[q][j].w);
                const float rstd = 1.0f / sqrtf(wave_sum(s) * (1.0f / D) + NORM_EPS);
#pragma unroll
                for (int j = 0; j < 4; ++j) { const int k = 4 * lane + 256 * j; *(f32x4*)(F.out + tok * D + k) = v[q][j] * rstd * *(const f32x4*)(GIN(I_FNW) + k); }
            } }
    }
}

constexpr int N_PHASES = 2 + 8 * DEPTH;
struct Args { const float* in[23]; float* out; unsigned char* ws; int ph_lo, ph_hi; };
__global__ void __launch_bounds__(NWAVES * 64, 2) fwd_kernel(Args args) {
    extern __shared__ __attribute__((aligned(16))) unsigned char lds_raw[];
    Frame F;
    F.lds = (LAS unsigned char*)lds_raw;
    F.tid = threadIdx.x; F.lane = F.tid & 63; F.wave = __builtin_amdgcn_readfirstlane(F.tid >> 6);
    const int wv0 = F.wave;
    F.bx = blockIdx.x; F.G = gridDim.x; { const int bx = blockIdx.x; F.vcu = (F.G % 8 == 0) ? (bx % 8) * (F.G / 8) + bx / 8 : bx; }
    F.ws = (unsigned char*)(GAS unsigned char*)args.ws; F.ctl = (gu32*)(F.ws + WS_CTL); F.out = (float*)(GAS float*)args.out;
    F.in = (const CAS PFC*)__builtin_amdgcn_kernarg_segment_ptr();
    volatile LAS unsigned* MISC = (volatile LAS unsigned*)(F.lds + MISC_OFF);
    for (int u = F.tid; u < 256; u += NWAVES * 64) MISC[u] = 0u;
    __syncthreads();
    if (MK_N_LAUNCHES == 1) (void)xcd_barrier_post((unsigned*)(F.ctl + CW_BAR), MISC + 8, F.tid);
    const int lo = (MK_N_LAUNCHES == 1) ? 0 : args.ph_lo, hi = (MK_N_LAUNCHES == 1) ? N_PHASES : args.ph_hi;
#ifndef PH_MASK
#define PH_MASK 0xffff
#endif
#define PHEN(j) (((PH_MASK) >> (j)) & 1)
#define IN(k) (lo <= (k) && (k) < hi)
#define REFRESH() do { int _t = (wv0 << 6) | lane_id(); asm volatile("" : "+v"(_t)); F.tid = _t; F.lane = _t & 63; F.wave = __builtin_amdgcn_readfirstlane(_t >> 6); \
        GAS unsigned char* _w = (GAS unsigned char*)args.ws; asm volatile("" : "+s"(_w)); F.ws = (unsigned char*)_w; F.ctl = (gu32*)(F.ws + WS_CTL);     { const CAS PFC* _p = (const CAS PFC*)__builtin_amdgcn_kernarg_segment_ptr(); asm volatile("" : "+s"(_p)); F.in = _p; }     int _b = blockIdx.x; asm volatile("" : "+s"(_b)); F.bx = _b; } while (0)
#define GRID_BAR(k) do { if (MK_N_LAUNCHES == 1) { XcdBarrier _b; _b.bar = (unsigned*)(F.ctl + CW_BAR); _b.x = xb_xcc_id(); _b.st = (volatile LAS unsigned*)(F.lds + MISC_OFF) + 8; xcd_barrier(_b, (wv0 << 6) | lane_id()); } } while (0)

    if (PHEN(0) && IN(0)) { asm volatile("; PHASE_MARK 0");
#pragma unroll 1
        for (int rep = 0; rep < NREP(0); ++rep) { p0_prologue(F); if (F.bx >= DEPTH * 96) conv_one(F, 0); GRID_BAR(0); } }
    if (PHEN(1) && IN(1)) { asm volatile("; PHASE_MARK 1");
#pragma unroll 1
        for (int rep = 0; rep < NREP(1); ++rep) { p0b_norm(F); p0_convert(F); GRID_BAR(1); } }
#pragma unroll 1
    for (int l = 0; l < DEPTH; ++l) {
        const int pb = 2 + 8 * l;
        const float* mod = (const float*)(F.ws + WS_MOD) + (size_t)l * BATCH * 6144;
        if (PHEN(2) && IN(pb + 0)) { asm volatile("; PHASE_MARK 2");
#pragma unroll 1
          for (int rep = 0; rep < NREP(2); ++rep) { REFRESH();
            pg8::DenseSched S; S.init(F.ws + WS_H, F.ws + WS_WIN + (size_t)l * PP * D * 2, T, PP, D, F.G, F.bx);
            pg8::EpiProj E{(bf16_t*)(F.ws + WS_PROJ), PP};
            pg8::gemm_phase<pg8::EpiProj, pg8::DenseSched, false>(F.lds, D, S, E, F.tid);
            GRID_BAR(pb + 0); }
        }
        if (PHEN(3) && IN(pb + 1)) { asm volatile("; PHASE_MARK 3");
#pragma unroll 1
          for (int rep = 0; rep < NREP(3); ++rep) { REFRESH(); p2a(F, l, rep); GRID_BAR(pb + 1); } }
        if (PHEN(4) && IN(pb + 2)) { asm volatile("; PHASE_MARK 4");
#pragma unroll 1
          for (int rep = 0; rep < NREP(4); ++rep) { REFRESH(); p2b(F, l, rep); GRID_BAR(pb + 2); } }
        if (PHEN(5) && IN(pb + 3)) { asm volatile("; PHASE_MARK 5");
#pragma unroll 1
          for (int rep = 0; rep < NREP(5); ++rep) { REFRESH();
            pg8::DenseSched S; S.init(F.ws + WS_YMIX, F.ws + WS_WOUT + (size_t)l * D * D * 2, T, D, D, F.G, F.bx);
            if (l == 0) { pg8::EpiResGateT<false> E{GIN(I_X), (const bf16_t*)nullptr, (bf16_t*)(F.ws + WS_X1), mod + 2048, DBG_MIX0};
                pg8::gemm_phase<pg8::EpiResGateT<false>, pg8::DenseSched, false>(F.lds, D, S, E, F.tid); }
            else { pg8::EpiResGateT<true> E{(const float*)nullptr, (const bf16_t*)(F.ws + WS_X2), (bf16_t*)(F.ws + WS_X1), mod + 2048, DBG_MIX1};
                pg8::gemm_phase<pg8::EpiResGateT<true>, pg8::DenseSched, false>(F.lds, D, S, E, F.tid); }
            GRID_BAR(pb + 3); }
        }
        if (PHEN(6) && IN(pb + 4)) { asm volatile("; PHASE_MARK 6"); REFRESH(); p4_router(F, l); GRID_BAR(pb + 4); }
        if (PHEN(7) && IN(pb + 5)) { asm volatile("; PHASE_MARK 7");
#pragma unroll 1
          for (int rep = 0; rep < NREP(7); ++rep) {
            REFRESH(); const int nblk = moe_table(F, l);
            pg8::MoeSched<true> S; S.A = (const char*)(F.ws + WS_H8); S.Bt = (const char*)(F.ws + WS_WGU + (size_t)l * NE * 2048 * D); S.K = D; S.nN = 8; S.G = F.G; S.c = F.bx; S.total = nblk * 8; S.lj_in = F.lane & 31;
            S.tab = (const LAS int*)(F.lds + MISC_OFF + 1536); S.slot = (const i32x2*)(F.ws + WS_SLOT);
            pg8::EpiSwiGLU E{(unsigned char*)(F.ws + WS_ACT), GIN(I_BGU) + (size_t)l * NE * 2048};
            pg8::gemm_phase<pg8::EpiSwiGLU, pg8::MoeSched<true>, true, true>(F.lds, D, S, E, F.tid);
            if (l + 1 < DEPTH && rep == 0 && (F.G % 64) == 0) {
                const int BR = F.G / 8, off = (F.bx & 7) * (BR >> 3) + (F.bx >> 3) / 8;
                if ((nblk > off ? (nblk - off + BR - 1) / BR : 0) < (nblk + BR - 1) / BR) conv_one(F, l + 1, true); }
            GRID_BAR(pb + 5); }
        }
        if (PHEN(8) && IN(pb + 6)) { asm volatile("; PHASE_MARK 8");
#pragma unroll 1
          for (int rep = 0; rep < NREP(8); ++rep) {
            REFRESH(); const int nblk = moe_table(F, l);
            pg8::MoeSched<false> S; S.A = (const char*)(F.ws + WS_ACT); S.Bt = (const char*)(F.ws + WS_WDN + (size_t)l * NE * D * FF); S.K = FF; S.nN = 4; S.G = F.G; S.c = F.bx; S.total = nblk * 4; S.lj_in = F.lane & 31;
            S.tab = (const LAS int*)(F.lds + MISC_OFF + 1536); S.slot = (const i32x2*)(F.ws + WS_SLOT);
            pg8::EpiDown E{(unsigned char*)(F.ws + WS_YBUF), GIN(I_BDN) + (size_t)l * NE * D, (const i32x2*)(F.ws + WS_SLOT)};
            pg8::gemm_phase<pg8::EpiDown, pg8::MoeSched<false>, false, true>(F.lds, FF, S, E, F.tid);
            if (l + 1 < DEPTH && rep == 0 && (F.G % 64) == 0) {
                const int BR = F.G / 4, off = (F.bx & 7) * (BR >> 3) + (F.bx >> 3) / 4;
                if ((nblk > off ? (nblk - off + BR - 1) / BR : 0) < (nblk + BR - 1) / BR) conv_one(F, l + 1, true); }
            GRID_BAR(pb + 6); }
        }
        if (PHEN(9) && IN(pb + 7)) { asm volatile("; PHASE_MARK 9");
#pragma unroll 1
          for (int rep = 0; rep < NREP(9); ++rep) { REFRESH(); p7_combine(F, l); if (l + 1 < DEPTH || rep + 1 < NREP(9)) GRID_BAR(pb + 7); } }
    }
#undef IN
#undef GRID_BAR
}

extern "C" void kernel_launch(void* const* d_in, const int* in_sizes, int n_in, void* d_out, int out_size, void* d_ws, size_t ws_size, hipStream_t stream) {
    static int grid = 0;
    if (grid == 0) {
        if (n_in != 23 || out_size != T * D || ws_size < WS_END) { fprintf(stderr, "kernel_launch: unexpected shapes (n_in %d, out %d, ws %zu)\n", n_in, out_size, ws_size); grid = -1; return; }
        int dev = 0, cus = 0, per_cu = 0;
        if (hipGetDevice(&dev) != hipSuccess || hipDeviceGetAttribute(&cus, hipDeviceAttributeMultiprocessorCount, dev) != hipSuccess) { grid = -1; return; }
        if (hipFuncSetAttribute((const void*)fwd_kernel, hipFuncAttributeMaxDynamicSharedMemorySize, LDS_BYTES) != hipSuccess) { fprintf(stderr, "kernel_launch: hipFuncSetAttribute failed\n"); grid = -1; return; }
        if (hipOccupancyMaxActiveBlocksPerMultiprocessor(&per_cu, (const void*)fwd_kernel, NWAVES * 64, LDS_BYTES) != hipSuccess || per_cu < 1) { fprintf(stderr, "kernel_launch: occupancy query says %d\n", per_cu); }
        (void)hipGetLastError();
        grid = cus;
    }
    if (grid < 0) return;
    (void)hipMemsetAsync((char*)d_ws + WS_CTL, 0, CTL_ZERO_BYTES, stream);
    Args a{};
    for (int i = 0; i < 23; ++i) a.in[i] = (const float*)d_in[i];
    a.out = (float*)d_out; a.ws = (unsigned char*)d_ws;
    if (MK_N_LAUNCHES == 1) { a.ph_lo = 0; a.ph_hi = N_PHASES; hipLaunchKernelGGL(fwd_kernel, dim3(grid), dim3(NWAVES * 64), LDS_BYTES, stream, a); }
    else for (int p = 0; p < N_PHASES; ++p) { a.ph_lo = p; a.ph_hi = p + 1; hipLaunchKernelGGL(fwd_kernel, dim3(grid), dim3(NWAVES * 64), LDS_BYTES, stream, a); }
}
```

```cpp
#include <hip/hip_runtime.h>
#include <cstdio>
#include <cstdint>
#include <cmath>
#include <type_traits>

#ifndef MK_N_LAUNCHES
#define MK_N_LAUNCHES 1
#endif

#ifndef DBG_REP_PHASE
#define DBG_REP_PHASE -1
#endif
#ifndef DBG_REP_N
#define DBG_REP_N 2
#endif
#define NREP(j) ((DBG_REP_PHASE) == (j) ? (DBG_REP_N) : 1)
#ifndef DBG_MIX0
#define DBG_MIX0 1.0f
#endif
#ifndef DBG_MIX1
#define DBG_MIX1 1.0f
#endif
#ifndef DBG_MOE0
#define DBG_MOE0 1.0f
#endif
#ifndef DBG_MOE1
#define DBG_MOE1 1.0f
#endif
#define GAS __attribute__((address_space(1)))
#define LAS __attribute__((address_space(3)))
typedef unsigned short bf16_t;
typedef short bf16x8 __attribute__((ext_vector_type(8)));
typedef short s16x4 __attribute__((ext_vector_type(4)));
typedef short v4i16_t __attribute__((ext_vector_type(4)));
typedef float f32x4 __attribute__((ext_vector_type(4)));
typedef float f32x2 __attribute__((ext_vector_type(2)));
typedef unsigned u32x4 __attribute__((ext_vector_type(4)));
typedef unsigned u32x2 __attribute__((ext_vector_type(2)));
typedef int i32x2 __attribute__((ext_vector_type(2)));
typedef int i32x8 __attribute__((ext_vector_type(8)));
typedef GAS unsigned gu32;

constexpr int D = 1024, BATCH = 8, SEQ = 2048, T = BATCH * SEQ, DEPTH = 2;
constexpr int INW = 2944, PP = 3072;
constexpr int C_RQ = 0, C_RK = 256, C_RV = 512, C_RG = 768, C_MQ = 1024, C_MK = 1408, C_MV = 1792, C_LX = 2176, C_LG = 2560;
constexpr int Y_RET = 0, Y_MOBA = 256, Y_LRU = 640;
constexpr int NE = 32, FF = 1024, CAP = 16384;
constexpr int LCH = 128, NLCH = SEQ / LCH;
constexpr float NORM_EPS = 1e-6f;

constexpr size_t MiB = 1u << 20;
constexpr size_t WS_CTL = 0, CTL_ZERO_BYTES = 1 * MiB;
constexpr size_t WS_MOD = 1 * MiB;
constexpr size_t WS_ROT = 2 * MiB;
constexpr size_t WS_LRUSUM = 3 * MiB;
constexpr size_t WS_KMEAN = 4 * MiB;
constexpr size_t WS_SLOT = 5 * MiB;
constexpr size_t WS_GATE = 9 * MiB;
constexpr size_t WS_WIN = 10 * MiB;
constexpr size_t WS_WOUT = 22 * MiB;
constexpr size_t WS_RWT = 26 * MiB;
constexpr size_t WS_WGU = 32 * MiB;
constexpr size_t WS_WDN = 288 * MiB;
constexpr size_t WS_H = 416 * MiB;
constexpr size_t WS_PROJ = 448 * MiB;
constexpr size_t WS_YMIX = 544 * MiB;
constexpr size_t WS_X1 = 576 * MiB;
constexpr size_t WS_X2 = 640 * MiB;
constexpr size_t WS_ACT = 704 * MiB;
constexpr size_t WS_YBUF = 848 * MiB;
constexpr size_t WS_LRUH = 976 * MiB;
constexpr size_t WS_LRUA = 992 * MiB;
constexpr size_t WS_H8 = 1008 * MiB;
constexpr size_t WS_END = 1024 * MiB;
constexpr int CW_TMO = 0, CW_CODE = 1;
constexpr int CW_BAR = 4096;
constexpr int CW_CNT = 8192;
constexpr int CW_Q = 8192 + 256;

constexpr int RING_BYTES = 131072;
constexpr int MISC_OFF = RING_BYTES;
constexpr int LDS_BYTES = 147456;
constexpr int NWAVES = 8;

#define RLX_AGENT __ATOMIC_RELAXED, __HIP_MEMORY_SCOPE_AGENT
#define LDS_WAIT() asm volatile("s_waitcnt lgkmcnt(0)" ::: "memory")
#define VM_WAIT() asm volatile("s_waitcnt vmcnt(0)" ::: "memory")

__device__ __forceinline__ unsigned f2bf(float f) { unsigned u = __builtin_bit_cast(unsigned, f); return (u + 0x7fffu + ((u >> 16) & 1u)) >> 16; }
__device__ __forceinline__ unsigned pk2(float lo, float hi) { return f2bf(lo) | (f2bf(hi) << 16); }
__device__ __forceinline__ unsigned cvtpk(float lo, float hi) { typedef __bf16 bf2_t __attribute__((ext_vector_type(2))); f32x2 v = {lo, hi}; bf2_t b = __builtin_convertvector(v, bf2_t); return __builtin_bit_cast(unsigned, b); }
__device__ __forceinline__ unsigned cvt4_fp8(float a, float b, float c, float d) { int w = 0; w = __builtin_amdgcn_cvt_pk_fp8_f32(a, b, w, false); w = __builtin_amdgcn_cvt_pk_fp8_f32(c, d, w, true); return (unsigned)w; }
__device__ __forceinline__ float sat448(float x) { return __builtin_amdgcn_fmed3f(x, -448.0f, 448.0f); }
__device__ __forceinline__ unsigned cvt4_fp8_sat(float a, float b, float c, float d) { return cvt4_fp8(sat448(a), sat448(b), sat448(c), sat448(d)); }
__device__ __forceinline__ float ex2(float x) { return __builtin_amdgcn_exp2f(x); }
__device__ __forceinline__ float fexp(float x) { return __builtin_amdgcn_exp2f(x * 1.4426950408889634f); }
__device__ __forceinline__ float frcp(float x) { return __builtin_amdgcn_rcpf(x); }
__device__ __forceinline__ float bf2f(unsigned short b) { return __builtin_bit_cast(float, ((unsigned)b) << 16); }
__device__ __forceinline__ float bflo(unsigned w) { return __builtin_bit_cast(float, w << 16); }
__device__ __forceinline__ float bfhi(unsigned w) { return __builtin_bit_cast(float, w & 0xffff0000u); }
__device__ __forceinline__ int lane_id() { int l; asm volatile("v_mbcnt_lo_u32_b32 %0, -1, 0\n\tv_mbcnt_hi_u32_b32 %0, -1, %0" : "=v"(l)); return l; }
__device__ __forceinline__ float wave_sum(float v) {
#pragma unroll
    for (int o = 1; o < 64; o <<= 1) v += __shfl_xor(v, o);
    return v;
}

namespace pg8 {
constexpr int BM = 256, BK = 64, HALF = 128, HTB = HALF * BK * 2, STAGE_BYTES = 8 * HTB, NXCD = 8, WGM = 8;
__host__ __device__ __forceinline__ int lds_byte(int r, int c) { const int st = (r >> 4) * 2 + (c >> 5), rr = r & 15, cc = c & 31, ob = rr * 64 + cc * 2; return st * 1024 + (ob ^ (((ob >> 9) & 1) << 5)); }
__host__ __device__ __forceinline__ void stage_rc(int b, int& R, int& C) { const int st = b / 1024, sb = b % 1024, swz = sb ^ (((sb >> 9) & 1) << 5); R = (st >> 1) * 16 + swz / 64; C = (st & 1) * 32 + (swz % 64) / 2; }
__host__ __device__ __forceinline__ int perm32(int rho) { const int n = rho >> 4, i = rho & 15; return 8 * (i >> 2) + 4 * n + (i & 3); }

struct Unit { int pm, pn, e, srow, nv; };

__device__ __forceinline__ unsigned cvt_pk_bf16(float lo, float hi) { unsigned r; asm volatile("v_cvt_pk_bf16_f32 %0, %1, %2" : "=v"(r) : "v"(lo), "v"(hi)); return r; }

struct DenseSched {
    const char* A; const char* Bt; int K; int nM, nN, nwg, G, c;
    __device__ __forceinline__ void init(const void* A_, const void* Bt_, int M, int N, int K_, int G_, int c_) { A = (const char*)A_; Bt = (const char*)Bt_; K = K_; nM = M / BM; nN = N / BM; nwg = nM * nN; G = G_; c = c_; }
    __device__ __forceinline__ bool next(int i, Unit& u) const {
        const long L = (long)i * G + c; if (L >= nwg) return false;
        int wgid = (int)L; { const int q = nwg / NXCD, r = nwg % NXCD, xcd = wgid % NXCD, off = wgid / NXCD; wgid = (xcd < r ? xcd * (q + 1) : r * (q + 1) + (xcd - r) * q) + off; }
        const int nig = WGM * nN, gid = wgid / nig, fm = gid * WGM, gsz = (nM - fm) < WGM ? (nM - fm) : WGM;
        u.pm = fm + ((wgid % nig) % gsz); u.pn = (wgid % nig) / gsz; u.e = 0; u.srow = 0; u.nv = BM; return true;
    }
    __device__ __forceinline__ const char* a_base(const Unit& u) const { return A + (size_t)u.pm * (size_t)BM * K * 2; }
    __device__ __forceinline__ const char* b_base(const Unit& u) const { return Bt + (size_t)u.pn * (size_t)BM * K * 2; }
    __device__ __forceinline__ void a_offs(const Unit&, unsigned (&)[4], const int (&)[2], const int (&)[2]) const {}
};
template <bool GATHER> struct MoeSched {
    const char* A; const char* Bt; int K  , nN, G, c, total, lj_in  ; const LAS int* tab; const i32x2* slot;
    __device__ __forceinline__ bool next(int i, Unit& u) const {
        int blk;
        if ((G % (8 * nN)) == 0) {
            const int BR = G / nN, bpx = BR >> 3, xcd = c & 7, slot = c >> 3;
            blk = i * BR + xcd * bpx + slot / nN; u.pn = slot % nN; if (blk * nN >= total) return false;
        } else { const int L = i * G + c; if (L >= total) return false; blk = L / nN; u.pn = L - blk * nN; }
        u.pm = blk;
        const int lj = lane_id() & 31;
        const unsigned long long bal = __ballot(lj >= 1 && tab[lj] <= blk);
        const int e = __builtin_popcount((unsigned)(bal & 0xffffffffull));
        const int rb = blk - __builtin_amdgcn_readfirstlane(tab[e]); const int cn = __builtin_amdgcn_readfirstlane(tab[33 + e]);
        u.e = e; u.srow = e * CAP + rb * BM; const int rem = cn - rb * BM; u.nv = rem < BM ? rem : BM; return true;
    }
    __device__ __forceinline__ const char* a_base(const Unit& u) const { return GATHER ? A : A + (size_t)u.pm * (size_t)BM * K; }
    __device__ __forceinline__ const char* b_base(const Unit& u) const { return Bt + ((size_t)u.e * nN + u.pn) * (size_t)BM * K; }
    __device__ __forceinline__ void a_offs(const Unit& u, unsigned (&vo)[4], const int (&R)[2], const int (&C)[2]) const {
#pragma unroll
        for (int h = 0; h < 2; ++h)
#pragma unroll
            for (int i = 0; i < 2; ++i) { const int r = h * HALF + R[i]; int ent = 0; if (r < u.nv) ent = slot[u.srow + r].x; vo[h * 2 + i] = (unsigned)(ent >> 2) * (unsigned)K + (unsigned)(C[i] * 2); }
    }
};

struct EpiProj { static constexpr bool PREFETCH = false; static constexpr bool BIAS_LDS = false;
    static constexpr bool PERM = true;
    bf16_t* O; int ldc;
    __device__ __forceinline__ void operator()(const f32x4 (&acc)[2][2][4][2], const Unit& u, int wr, int wc, int fr, int fq) const {
        const int row0 = u.pm * BM + wr * 64 + fr, col0 = u.pn * BM + wc * 32 + 8 * fq;
#pragma unroll
        for (int ai = 0; ai < 2; ++ai)
#pragma unroll
            for (int m = 0; m < 4; ++m) { bf16_t* rowp = O + (size_t)(row0 + ai * HALF + m * 16) * ldc + col0;
#pragma unroll
                for (int bj = 0; bj < 2; ++bj) { const f32x4 v0 = acc[ai][bj][m][0], v1 = acc[ai][bj][m][1];
                    u32x4 w; w.x = cvt_pk_bf16(v0[0], v0[1]); w.y = cvt_pk_bf16(v0[2], v0[3]); w.z = cvt_pk_bf16(v1[0], v1[1]); w.w = cvt_pk_bf16(v1[2], v1[3]);
                    *(u32x4*)(rowp + bj * HALF) = w; } }
    }
};
template <bool IN16> struct EpiResGateT { static constexpr bool PREFETCH = false; static constexpr bool BIAS_LDS = false;
    static constexpr bool PERM = true;
    const float* xin32; const bf16_t* xin16; bf16_t* out; const float* gate; float dbg;
    __device__ __forceinline__ void operator()(const f32x4 (&acc)[2][2][4][2], const Unit& u, int wr, int wc, int fr, int fq) const {
        const int row0 = u.pm * BM + wr * 64 + fr, col0 = u.pn * BM + wc * 32 + 8 * fq; const int b = (u.pm * BM) / SEQ;
        f32x4 gv[2][2];
#pragma unroll
        for (int bj = 0; bj < 2; ++bj)
#pragma unroll
            for (int n = 0; n < 2; ++n) gv[bj][n] = *(const f32x4*)(gate + (size_t)b * 6144 + col0 + bj * HALF + n * 4) * dbg;
        constexpr int MB = IN16 ? 4 : 2;
#pragma unroll
        for (int ai = 0; ai < 2; ++ai)
#pragma unroll
          for (int m0 = 0; m0 < 4; m0 += MB) {
            u32x4 xw[MB][2]; f32x4 xf[MB][2][2];
#pragma unroll
            for (int mm = 0; mm < MB; ++mm) { const size_t off = (size_t)(row0 + ai * HALF + (m0 + mm) * 16) * D + col0;
#pragma unroll
                for (int bj = 0; bj < 2; ++bj) {
                    if constexpr (!IN16) { xf[mm][bj][0] = *(const f32x4*)(xin32 + off + bj * HALF); xf[mm][bj][1] = *(const f32x4*)(xin32 + off + bj * HALF + 4); }
                    else xw[mm][bj] = *(const u32x4*)(xin16 + off + bj * HALF); } }
#pragma unroll
            for (int mm = 0; mm < MB; ++mm) { const int m = m0 + mm; const size_t off = (size_t)(row0 + ai * HALF + m * 16) * D + col0;
#pragma unroll
                for (int bj = 0; bj < 2; ++bj) { f32x4 x0, x1;
                    if constexpr (!IN16) { x0 = xf[mm][bj][0]; x1 = xf[mm][bj][1]; }
                    else { const u32x4 w = xw[mm][bj]; x0 = (f32x4){bflo(w.x), bfhi(w.x), bflo(w.y), bfhi(w.y)}; x1 = (f32x4){bflo(w.z), bfhi(w.z), bflo(w.w), bfhi(w.w)}; }
                    const f32x4 o0 = x0 + gv[bj][0] * acc[ai][bj][m][0], o1 = x1 + gv[bj][1] * acc[ai][bj][m][1];
                    u32x4 ow; ow.x = cvt_pk_bf16(o0[0], o0[1]); ow.y = cvt_pk_bf16(o0[2], o0[3]); ow.z = cvt_pk_bf16(o1[0], o1[1]); ow.w = cvt_pk_bf16(o1[2], o1[3]);
                    *(u32x4*)(out + off + bj * HALF) = ow; } }
            asm volatile("" ::: "memory"); }
    }
};
struct EpiSwiGLU { static constexpr bool PREFETCH = false; static constexpr bool BIAS_LDS = true;
    static constexpr bool PERM = true;
    unsigned char* O; const float* bgu;
    __device__ __forceinline__ const float* bias_src(const Unit& u, int lane) const { return bgu + (size_t)u.e * 2048 + u.pn * HALF + (lane < 32 ? lane * 4 : 1024 + (lane - 32) * 4); }
    __device__ __forceinline__ void operator()(const f32x4 (&acc)[2][2][4][2], const Unit& u, int wr, int wc, int fr, int fq, const LAS float* bl) const {
        const int row0 = u.pm * BM + wr * 64 + fr, jc0 = u.pn * HALF + wc * 32 + 8 * fq;
        f32x4 bg[2], bu[2];
#pragma unroll
        for (int n = 0; n < 2; ++n) { bg[n] = *(const LAS f32x4*)(bl + wc * 32 + 8 * fq + 4 * n); bu[n] = *(const LAS f32x4*)(bl + 128 + wc * 32 + 8 * fq + 4 * n); }
#pragma unroll
        for (int ai = 0; ai < 2; ++ai)
#pragma unroll
            for (int m = 0; m < 4; ++m) { float a[8];
#pragma unroll
                for (int n = 0; n < 2; ++n)
#pragma unroll
                    for (int jp = 0; jp < 2; ++jp) {
                        const f32x2 ag = {acc[ai][0][m][n][2 * jp], acc[ai][0][m][n][2 * jp + 1]}, au = {acc[ai][1][m][n][2 * jp], acc[ai][1][m][n][2 * jp + 1]};
                        const f32x2 bgp = {bg[n][2 * jp], bg[n][2 * jp + 1]}, bup = {bu[n][2 * jp], bu[n][2 * jp + 1]};
                        f32x2 g = ag * 0.03125f + bgp, up = au * 0.03125f + bup;
                        g.x = fminf(g.x, 7.0f); g.y = fminf(g.y, 7.0f); up.x = __builtin_amdgcn_fmed3f(up.x, -7.0f, 7.0f); up.y = __builtin_amdgcn_fmed3f(up.y, -7.0f, 7.0f);
                        const f32x2 z = g * (-1.702f * 1.4426950408889634f);
                        f32x2 d; d.x = __builtin_amdgcn_exp2f(z.x); d.y = __builtin_amdgcn_exp2f(z.y); d = d + 1.0f;
                        f32x2 sg; sg.x = __builtin_amdgcn_rcpf(d.x); sg.y = __builtin_amdgcn_rcpf(d.y);
                        const f32x2 r = (up + 1.0f) * g * sg; a[n * 4 + 2 * jp] = r.x; a[n * 4 + 2 * jp + 1] = r.y; }
                u32x2 w; w.x = cvt4_fp8(a[0], a[1], a[2], a[3]); w.y = cvt4_fp8(a[4], a[5], a[6], a[7]);
                *(u32x2*)(O + (size_t)(row0 + ai * HALF + m * 16) * FF + jc0) = w; }
    }
};
struct EpiDown { static constexpr bool PREFETCH = true; static constexpr bool BIAS_LDS = true;
    static constexpr int PERM = 2;
    unsigned char* Y; const float* bdn; const i32x2* slot;
    __device__ __forceinline__ void pre1(const Unit& u, int wr, int fr, unsigned (&pk)[8]) const {
#pragma unroll
        for (int i = 0; i < 8; ++i) { const int r = (i >> 2) * HALF + wr * 64 + (i & 3) * 16 + fr; i32x2 ent = {0, 0}; if (r < u.nv) ent = slot[u.srow + r];
            const int ex = ent.x, ey = ent.y;
            pk[i] = (cvtpk(0.f, __builtin_bit_cast(float, ey)) & 0xffff0000u) | ((unsigned)ex & 0xffffu); }
    }
    __device__ __forceinline__ const float* bias_src(const Unit& u, int lane) const { return bdn + (size_t)u.e * 1024 + u.pn * BM + lane * 4; }
    __device__ __forceinline__ void operator()(const f32x4 (&acc)[2][2][4][2], const Unit& u, int wr, int wc, int fr, int fq, const unsigned (&pk)[8], const LAS float* bl) const {
        const int col0 = u.pn * BM + wc * 64 + 16 * fq;
        f32x4 bv[2][2];
#pragma unroll
        for (int bj = 0; bj < 2; ++bj)
#pragma unroll
            for (int n = 0; n < 2; ++n) bv[bj][n] = *(const LAS f32x4*)(bl + wc * 64 + 16 * fq + 8 * bj + 4 * n);
#pragma unroll
        for (int ai = 0; ai < 2; ++ai)
#pragma unroll
            for (int m = 0; m < 4; ++m) { const unsigned e = pk[ai * 4 + m];
                if ((e >> 16) != 0u) { const float g = __builtin_bit_cast(float, e & 0xffff0000u) * 16.0f; unsigned char* rowp = Y + (size_t)(e & 0xffffu) * D + col0;
                    u32x4 w;
#pragma unroll
                    for (int bj = 0; bj < 2; ++bj) { const f32x4 v0 = (acc[ai][bj][m][0] * 0.03125f + bv[bj][0]) * g, v1 = (acc[ai][bj][m][1] * 0.03125f + bv[bj][1]) * g;
                        w[2 * bj] = cvt4_fp8_sat(v0[0], v0[1], v0[2], v0[3]); w[2 * bj + 1] = cvt4_fp8_sat(v1[0], v1[1], v1[2], v1[3]); }
                    *(u32x4*)rowp = w; } }
    }
};

template <class Epi, class Sched, bool GATHER, bool F8 = false>
__device__ __forceinline__ void gemm_phase(LAS unsigned char* lds, const int K, const Sched& S, const Epi& E, const int tid_in) {
    int tz = tid_in; asm volatile("" : "+v"(tz));
    const int tid = tz, wid = __builtin_amdgcn_readfirstlane(tid >> 6), lane = tid & 63, wr = wid >> 2, wc = wid & 3, fr = lane & 15, fq = lane >> 4;
    const int RB = F8 ? K : 2 * K;
    int nt = RB / 128; asm volatile("" : "+s"(nt));
    int Rr[2], Cc[2]; unsigned voffB[2], voffC[4], voffN[4];
#pragma unroll
    for (int i = 0; i < 2; ++i) { int R, C; stage_rc(tid * 16 + i * 8192, R, C); Rr[i] = R; Cc[i] = C; const int Rb = (int)Epi::PERM == 2 ? (64 * ((R >> 5) & 3) + 16 * ((R >> 2) & 3) + 4 * ((R >> 4) & 1) + (R & 3)) : Epi::PERM ? ((R & ~31) + perm32(R & 31)) : R;
        voffB[i] = (unsigned)(Rb * RB + C * 2); voffC[i] = (unsigned)(R * RB + C * 2); voffC[2 + i] = (unsigned)((R + HALF) * RB + C * 2); }
#pragma unroll
    for (int i = 0; i < 4; ++i) voffN[i] = voffC[i];
    const size_t kstep = (size_t)(BK * 2);
    const size_t hstep = (size_t)((int)Epi::PERM == 2 ? 8 : HALF) * RB;
    const unsigned ldsw = (unsigned)wid * 1024u;
    unsigned aoff = (unsigned)lds_byte(wr * 64 + fr, fq * (F8 ? 16 : 8)), boff = 65536u + (unsigned)lds_byte(wc * 32 + fr, fq * (F8 ? 16 : 8));
    asm volatile("" : "+v"(aoff), "+v"(boff));
    unsigned aoff1 = aoff, boff1 = boff;
    if constexpr (F8) { aoff += 16u * (unsigned)(fq & 1); boff += 16u * (unsigned)(fq & 1); aoff1 = aoff ^ 16u; boff1 = boff ^ 16u; asm volatile("" : "+v"(aoff), "+v"(boff), "+v"(aoff1), "+v"(boff1)); }
#define PG8_SA(b, h) (((b) * 2 + (h)) * HTB)
#define PG8_SB(b, h) ((4 + (b) * 2 + (h)) * HTB)
#define PG8_SBR(b, h) (((b) * 2 + (h)) * HTB)
#define PG8_STAGE_B(bufoff, gbase) do { _Pragma("unroll") for (int _i = 0; _i < 2; ++_i) \
        __builtin_amdgcn_global_load_lds((const unsigned*)((const char*)(gbase) + voffB[_i]), (LAS unsigned*)(lds + (bufoff) + ldsw + _i * 8192), 16, 0, 0); } while (0)
#define PG8_STAGE_A(bufoff, gbase, o0, o1) do { \
        __builtin_amdgcn_global_load_lds((const unsigned*)((const char*)(gbase) + (o0)), (LAS unsigned*)(lds + (bufoff) + ldsw), 16, 0, 0); \
        __builtin_amdgcn_global_load_lds((const unsigned*)((const char*)(gbase) + (o1)), (LAS unsigned*)(lds + (bufoff) + ldsw + 8192), 16, 0, 0); } while (0)
#define PG8_RD16(off) (*(const LAS u32x4*)(lds + (off)))
#define PG8_MK8(x0, x1) ((i32x8){(int)(x0).x, (int)(x0).y, (int)(x0).z, (int)(x0).w, (int)(x1).x, (int)(x1).y, (int)(x1).z, (int)(x1).w})
#define PG8_LDA(dst, b, h) do { _Pragma("unroll") for (int m = 0; m < 4; ++m) { \
        if constexpr (F8) { const u32x4 _x0 = PG8_RD16(aoff + (PG8_SA(b, h) + m * 2048)), _x1 = PG8_RD16(aoff1 + (PG8_SA(b, h) + m * 2048)); dst##8[m] = PG8_MK8(_x0, _x1); } \
        else { _Pragma("unroll") for (int k = 0; k < 2; ++k) dst[m][k] = *(const LAS bf16x8*)(lds + aoff + (PG8_SA(b, h) + m * 2048 + k * 1024)); } } } while (0)
#define PG8_LDB(dst, b, h) do { _Pragma("unroll") for (int n = 0; n < 2; ++n) { \
        if constexpr (F8) { const u32x4 _x0 = PG8_RD16(boff + (PG8_SBR(b, h) + n * 2048)), _x1 = PG8_RD16(boff1 + (PG8_SBR(b, h) + n * 2048)); dst##8[n] = PG8_MK8(_x0, _x1); } \
        else { _Pragma("unroll") for (int k = 0; k < 2; ++k) dst[n][k] = *(const LAS bf16x8*)(lds + boff + (PG8_SBR(b, h) + n * 2048 + k * 1024)); } } } while (0)
#define PG8_MMA(ai, bj, At, Bt) do { __builtin_amdgcn_s_setprio(1); _Pragma("unroll") for (int m = 0; m < 4; ++m) _Pragma("unroll") for (int n = 0; n < 2; ++n) { \
        if constexpr (F8) asm volatile("v_mfma_scale_f32_16x16x128_f8f6f4 %0, %1, %2, %0, %3, %3 op_sel_hi:[0,0,0]" : "+v"(acc[ai][bj][m][n]) : "v"(Bt##8[n]), "v"(At##8[m]), "v"(f8scale));   \
        else { _Pragma("unroll") for (int k = 0; k < 2; ++k) acc[ai][bj][m][n] = __builtin_amdgcn_mfma_f32_16x16x32_bf16(Bt[n][k], At[m][k], acc[ai][bj][m][n], 0, 0, 0); } } \
        __builtin_amdgcn_s_setprio(0); } while (0)
#define PG8_WAIT_V(n) asm volatile("s_waitcnt vmcnt(" #n ")" ::: "memory")
#define PG8_WAIT_L(n) asm volatile("s_waitcnt lgkmcnt(" #n ")" ::: "memory")
#define PG8_BAR __builtin_amdgcn_s_barrier()
#define PG8_SCHED __builtin_amdgcn_sched_barrier(0)
    Unit cur, nxt; int ui = 0;
    if (!S.next(0, cur)) return;
    f32x4 acc[2][2][4][2];
#pragma unroll
    for (int a = 0; a < 2; ++a)
#pragma unroll
        for (int b = 0; b < 2; ++b)
#pragma unroll
            for (int m = 0; m < 4; ++m)
#pragma unroll
                for (int n = 0; n < 2; ++n) acc[a][b][m][n] = (f32x4){0.f, 0.f, 0.f, 0.f};
    int f8scale = 0x7f7f7f7f; asm volatile("" : "+v"(f8scale));
    bf16x8 At[4][2], B0[2][2], B1[2][2]; i32x8 At8[4], B08[2], B18[2];
    const char* cA = S.a_base(cur); const char* cB = S.b_base(cur);
    if constexpr (GATHER) S.a_offs(cur, voffC, Rr, Cc);
    unsigned epk[8];
    if constexpr (Epi::PREFETCH) E.pre1(cur, wr, fr, epk);
    LAS unsigned char* const bias_lds = lds + MISC_OFF + 8192;
    if constexpr (Epi::BIAS_LDS) { if (wid == 0) __builtin_amdgcn_global_load_lds((const unsigned*)E.bias_src(cur, lane_id()), (LAS unsigned*)bias_lds, 16, 0, 0); }
    PG8_STAGE_B(PG8_SB(0, 0), cB); PG8_STAGE_B(PG8_SB(0, 1), cB + hstep); PG8_STAGE_A(PG8_SA(0, 0), cA, voffC[0], voffC[1]); PG8_STAGE_A(PG8_SA(0, 1), cA, voffC[2], voffC[3]);
    if (wr == 1) PG8_BAR;
    PG8_WAIT_V(2); PG8_BAR;
    PG8_STAGE_B(PG8_SB(1, 0), cB + kstep); PG8_STAGE_A(PG8_SA(1, 0), cA + kstep, voffC[0], voffC[1]); PG8_STAGE_B(PG8_SB(1, 1), cB + hstep + kstep);
    PG8_WAIT_V(6); PG8_BAR;
    for (;;) {
        const bool has_next = S.next(ui + 1, nxt);
        const char* nA = has_next ? S.a_base(nxt) : cA; const char* nB = has_next ? S.b_base(nxt) : cB;
        if constexpr (GATHER) { if (has_next) S.a_offs(nxt, voffN, Rr, Cc); else {
#pragma unroll
            for (int i = 0; i < 4; ++i) voffN[i] = voffC[i]; } }
#pragma unroll 1
        for (int t = 0; t < nt; t += 2) {
            const bool last = (t == nt - 2);
            const char* a1 = cA + (size_t)(t + 1) * kstep;
            const char* a2 = last ? nA : cA + (size_t)(t + 2) * kstep; const char* b2 = last ? nB : cB + (size_t)(t + 2) * kstep;
            const char* a3 = a2 + kstep; const char* b3 = b2 + kstep;
            unsigned o2[4];
#pragma unroll
            for (int i = 0; i < 4; ++i) o2[i] = GATHER ? (last ? voffN[i] : voffC[i]) : voffC[i];
            PG8_LDB(B0, 0, 0); PG8_LDB(B1, 0, 1); PG8_SCHED; PG8_LDA(At, 0, 0); PG8_STAGE_A(PG8_SA(1, 1), a1, voffC[2], voffC[3]);
            PG8_WAIT_V(8); PG8_WAIT_L(0); PG8_BAR; PG8_MMA(0, 0, At, B0); PG8_MMA(0, 1, At, B1); PG8_BAR; PG8_SCHED;
            PG8_LDA(At, 0, 1); PG8_STAGE_B(PG8_SB(0, 0), b2); PG8_STAGE_B(PG8_SB(0, 1), b2 + hstep); PG8_STAGE_A(PG8_SA(0, 0), a2, o2[0], o2[1]);
            PG8_WAIT_V(8); PG8_WAIT_L(0); PG8_BAR; PG8_MMA(1, 0, At, B0); PG8_MMA(1, 1, At, B1); PG8_BAR; PG8_SCHED;
            PG8_LDB(B0, 1, 0); PG8_LDB(B1, 1, 1); PG8_SCHED; PG8_LDA(At, 1, 0); PG8_STAGE_A(PG8_SA(0, 1), a2, o2[2], o2[3]);
            PG8_WAIT_V(8); PG8_WAIT_L(0); PG8_BAR; PG8_MMA(0, 0, At, B0); PG8_MMA(0, 1, At, B1); PG8_BAR; PG8_SCHED;
            PG8_LDA(At, 1, 1); PG8_STAGE_B(PG8_SB(1, 0), b3); PG8_STAGE_B(PG8_SB(1, 1), b3 + hstep); PG8_STAGE_A(PG8_SA(1, 0), a3, o2[0], o2[1]);
            PG8_WAIT_V(8); PG8_WAIT_L(0); PG8_BAR; PG8_MMA(1, 0, At, B0); PG8_MMA(1, 1, At, B1); PG8_BAR; PG8_SCHED;
        }
        if (wr == 0) PG8_BAR;
        if constexpr (F8) asm volatile("s_nop 15\n\ts_nop 15" ::: "memory");
        { const LAS float* bl = (const LAS float*)(bias_lds + (ui & 1) * 1024);
          if constexpr (Epi::PREFETCH && Epi::BIAS_LDS) E(acc, cur, wr, wc, fr, fq, epk, bl); else if constexpr (Epi::BIAS_LDS) E(acc, cur, wr, wc, fr, fq, bl); else if constexpr (Epi::PREFETCH) E(acc, cur, wr, wc, fr, fq, epk); else E(acc, cur, wr, wc, fr, fq); }
        if (!has_next) break;
#pragma unroll
        for (int a = 0; a < 2; ++a)
#pragma unroll
            for (int b = 0; b < 2; ++b)
#pragma unroll
                for (int m = 0; m < 4; ++m)
#pragma unroll
                    for (int n = 0; n < 2; ++n) acc[a][b][m][n] = (f32x4){0.f, 0.f, 0.f, 0.f};
        cur = nxt; cA = nA; cB = nB; ++ui;
        if constexpr (Epi::PREFETCH) E.pre1(cur, wr, fr, epk);
        if constexpr (Epi::BIAS_LDS) { if (wid == 0) __builtin_amdgcn_global_load_lds((const unsigned*)E.bias_src(cur, lane_id()), (LAS unsigned*)(bias_lds + (ui & 1) * 1024), 16, 0, 0); }
#pragma unroll
        for (int i = 0; i < 4; ++i) voffC[i] = voffN[i];
        if (wr == 1) PG8_BAR;
    }
    PG8_WAIT_V(0);
    PG8_BAR;
#undef PG8_SA
#undef PG8_SB
#undef PG8_SBR
#undef PG8_STAGE_A
#undef PG8_STAGE_B
#undef PG8_LDA
#undef PG8_RD16
#undef PG8_MK8
#undef PG8_LDB
#undef PG8_MMA
#undef PG8_WAIT_V
#undef PG8_WAIT_L
#undef PG8_BAR
#undef PG8_SCHED
}
}

#define XB_TMO      128
#define XB_XCNT(j)  (256  + 64 * (j))
#define XB_XSUB(j)  (1280 + 64 * (j))
#define XB_XGEN(j)  (2304 + 64 * (j))
#define XB_TOP      3328
#define XB_TOPGEN   3392
#define XCD_BAR_WORDS 3456
#define XB_SPIN_CAP (1u << 18)
__device__ __forceinline__ unsigned xb_ld(unsigned* p)              { return __hip_atomic_load(p, __ATOMIC_RELAXED, __HIP_MEMORY_SCOPE_AGENT); }
__device__ __forceinline__ unsigned xb_add(unsigned* p, unsigned v) { return __hip_atomic_fetch_add(p, v, __ATOMIC_RELAXED, __HIP_MEMORY_SCOPE_AGENT); }
__device__ __forceinline__ unsigned xb_xcc_id() { return (unsigned)__builtin_amdgcn_s_getreg((3 << 11) | 20) & 0xFu; }
#define XB_SPIN(cond, bar) do { unsigned _sp = 0; while (cond) { __builtin_amdgcn_s_sleep(1); \
    if ((++_sp & 255u) == 0u) { if (xb_ld(&(bar)[XB_TMO])) break; if (_sp > XB_SPIN_CAP) { atomicAdd(&(bar)[XB_TMO], 1u); break; } } } } while (0)
struct XcdBarrier { unsigned* bar; unsigned x; volatile LAS unsigned* st; };
__device__ __forceinline__ XcdBarrier xcd_barrier_post(unsigned* bar, volatile LAS unsigned* st, int tid) {
    XcdBarrier b; b.bar = bar; b.x = xb_xcc_id(); b.st = st;
    if (tid == 0) (void)xb_add(&bar[XB_XCNT(b.x)], 1u);
    return b;
}
__device__ __forceinline__ void xcd_barrier_complete(unsigned* bar, unsigned x, unsigned& nloc, unsigned& nx) {
    const unsigned G = gridDim.x * gridDim.y * gridDim.z;
    unsigned sum, cnt, mine, sp = 0u;
    for (;;) {
        sum = 0u; cnt = 0u; mine = 0u;
#pragma unroll
        for (unsigned j = 0; j < 16; ++j) { const unsigned c = xb_ld(&bar[XB_XCNT(j)]); sum += c; cnt += (c > 0u) ? 1u : 0u; mine = (j == x) ? c : mine; }
        if (sum == G) break;
        __builtin_amdgcn_s_sleep(1);
        if ((++sp & 255u) == 0u) { if (xb_ld(&bar[XB_TMO])) break; if (sp > XB_SPIN_CAP) { atomicAdd(&bar[XB_TMO], 1u); break; } }
    }
    nloc = mine > 0u ? mine : 1u; nx = cnt > 0u ? cnt : 1u;
}
__device__ __forceinline__ void xcd_barrier(const XcdBarrier& b, int tid) {
    asm volatile("s_waitcnt vmcnt(0)" ::: "memory");
    __syncthreads();
    if (tid == 0) {
        unsigned* bar = b.bar;
        __builtin_amdgcn_s_waitcnt(0);
        unsigned nloc = b.st[0], nx = b.st[1];
        if (nloc == 0u) { xcd_barrier_complete(bar, b.x, nloc, nx); b.st[0] = nloc; b.st[1] = nx; }
        const unsigned old = xb_add(&bar[XB_XSUB(b.x)], 1u);
        const unsigned gen = old / nloc;
        if (old + 1u == (gen + 1u) * nloc) {
            __builtin_amdgcn_fence(__ATOMIC_RELEASE, "agent");
            asm volatile("s_waitcnt vmcnt(0)" ::: "memory");
            const unsigned og = xb_add(&bar[XB_TOP], 1u);
            const unsigned tg = og / nx;
            if (og + 1u == (tg + 1u) * nx) xb_add(&bar[XB_TOPGEN], 1u);
            else XB_SPIN(xb_ld(&bar[XB_TOPGEN]) == tg, bar);
            __builtin_amdgcn_fence(__ATOMIC_ACQUIRE, "agent");
            xb_add(&bar[XB_XGEN(b.x)], 1u);
            asm volatile("s_waitcnt vmcnt(0)" ::: "memory");
        } else {
            XB_SPIN(xb_ld(&bar[XB_XGEN(b.x)]) == gen, bar);
            __builtin_amdgcn_fence(__ATOMIC_ACQUIRE, "agent");
            asm volatile("s_waitcnt vmcnt(0)" ::: "memory");
        }
    }
    __syncthreads();
}

#define CAS __attribute__((address_space(4)))
typedef const float* PFC;
struct Frame {
    LAS unsigned char* lds;
    gu32* ctl;
    int tid, lane, wave, vcu, G, bx;
    const CAS PFC* in;
    float* out; unsigned char* ws;
};
#define GIN(i) ((const float*)(const GAS float*)F.in[i])
enum { I_X = 0, I_C, I_ADAW, I_ADAB, I_NMIX, I_WIN, I_RETNW, I_CONVW, I_CONVB, I_WA, I_BA, I_WX, I_BX, I_LAM, I_WOUT, I_NFFN, I_RW, I_RB, I_WGU, I_BGU, I_WDN, I_BDN, I_FNW };

__device__ __forceinline__ void p0_transpose_item(const float* W, int N, int k0, int n0, bf16_t* WTrow0  , int Kd, LAS float* scr, int lane) {
#pragma unroll 8
    for (int i = 0; i < 32; ++i) { const int kk = 2 * i + (lane >> 5); scr[kk * 33 + (lane & 31)] = W[(size_t)(k0 + kk) * N + n0 + (lane & 31)]; }
    LDS_WAIT(); asm volatile("" ::: "memory");
    const int c = lane & 7;
#pragma unroll
    for (int j = 0; j < 4; ++j) { const int n = (lane >> 3) + 8 * j; const LAS float* s = scr + (8 * c) * 33 + n;
        u32x4 o; o.x = pk2(s[0 * 33], s[1 * 33]); o.y = pk2(s[2 * 33], s[3 * 33]); o.z = pk2(s[4 * 33], s[5 * 33]); o.w = pk2(s[6 * 33], s[7 * 33]);
        *(u32x4*)(WTrow0 + (size_t)n * Kd + k0 + 8 * c) = o; }
    LDS_WAIT(); asm volatile("" ::: "memory");
}
__device__ __forceinline__ void p0_transpose_item8(const float* W, int N, int k0, int n0, unsigned char* WTrow0, int Kd, LAS float* scr, int lane) {
#pragma unroll 8
    for (int i = 0; i < 32; ++i) { const int kk = 2 * i + (lane >> 5); scr[kk * 33 + (lane & 31)] = W[(size_t)(k0 + kk) * N + n0 + (lane & 31)] * 32.0f; }
    LDS_WAIT(); asm volatile("" ::: "memory");
    const int c = lane & 7;
#pragma unroll
    for (int j = 0; j < 4; ++j) { const int n = (lane >> 3) + 8 * j; const LAS float* sp = scr + (8 * c) * 33 + n;
        u32x2 o; o.x = cvt4_fp8(sp[0 * 33], sp[1 * 33], sp[2 * 33], sp[3 * 33]); o.y = cvt4_fp8(sp[4 * 33], sp[5 * 33], sp[6 * 33], sp[7 * 33]);
        *(u32x2*)(WTrow0 + (size_t)n * Kd + k0 + 8 * c) = o; }
    LDS_WAIT(); asm volatile("" ::: "memory");
}
__device__ __forceinline__ float silu_f(float x) { return x * frcp(1.0f + fexp(-x)); }

__device__ __forceinline__ void p0_prologue(Frame& F) {
    const int gw = F.vcu * NWAVES + F.wave, NGW = F.G * NWAVES;
    {
        LAS float* cact = (LAS float*)(F.lds);
        LAS float* red = (LAS float*)(F.lds + 32768);
        for (int i = F.tid; i < BATCH * D; i += 512) cact[i] = silu_f(GIN(I_C)[i]);
        __syncthreads();
        float* mod = (float*)(F.ws + WS_MOD);
        for (int u = F.bx; u < DEPTH * 96; u += F.G) {
            const int l = u / 96, n0 = (u % 96) * 64, col = F.tid & 63, kg = F.tid >> 6;
            const float* w = GIN(I_ADAW) + (size_t)l * D * 6144 + n0 + col;
            float a[8];
#pragma unroll
            for (int b = 0; b < 8; ++b) a[b] = 0.f;
#pragma unroll 32
            for (int k = kg * 128; k < kg * 128 + 128; ++k) { const float wv = w[(size_t)k * 6144];
#pragma unroll
                for (int b = 0; b < 8; ++b) a[b] += cact[b * D + k] * wv; }
#pragma unroll
            for (int b = 0; b < 8; ++b) red[(kg * 8 + b) * 64 + col] = a[b];
            __syncthreads();
            { const int b = F.tid >> 6; float s = 0.f;
#pragma unroll
              for (int g = 0; g < 8; ++g) s += red[(g * 8 + b) * 64 + col];
              mod[((size_t)l * BATCH + b) * 6144 + n0 + col] = s + GIN(I_ADAB)[l * 6144 + n0 + col]; }
            __syncthreads();
        }
    }
    {
        float* rc = (float*)(F.ws + WS_ROT); float* rs = rc + SEQ * 32;
        for (int i = gw * 64 + F.lane; i < SEQ * 32; i += NGW * 64) { const int pos = i >> 5, j = i & 31;
            const double inv = pow(10000.0, -(double)j / 32.0), ang = (double)pos * inv; rc[i] = (float)cos(ang); rs[i] = (float)sin(ang); }
    }
    {
        bf16_t* rwt = (bf16_t*)(F.ws + WS_RWT);
        for (int i = gw * 64 + F.lane; i < DEPTH * NE * D; i += NGW * 64) { const int l = i / (NE * D), r = i % (NE * D), e = r / D, k = r % D;
            const float w = GIN(I_RW)[(size_t)l * D * NE + (size_t)k * NE + e]; const unsigned hi = f2bf(w); const float lo = w - __builtin_bit_cast(float, hi << 16);
            rwt[((size_t)l * 2 + 0) * NE * D + r] = (bf16_t)hi; rwt[((size_t)l * 2 + 1) * NE * D + r] = (bf16_t)f2bf(lo); }
    }
}
namespace cv {
constexpr int I_IN = 16 * (INW / 64), I_OUT = 16 * 16, I_GU = 16 * 32, I_DN = 16 * 16;
constexpr int N_IN = DEPTH * I_IN, N_OUT = DEPTH * I_OUT, N_GU = DEPTH * NE * I_GU, N_DN = DEPTH * NE * I_DN, N_PROJ = N_IN + N_OUT;
struct Item { const float* src; unsigned char* dst; int N, f8; };
__device__ __forceinline__ Item decode(Frame& F, int it) { Item t; int r = it;
    bf16_t* win_t = (bf16_t*)(F.ws + WS_WIN); bf16_t* wout_t = (bf16_t*)(F.ws + WS_WOUT); unsigned char* wgu_t = (unsigned char*)(F.ws + WS_WGU); unsigned char* wdn_t = (unsigned char*)(F.ws + WS_WDN);
    if (r < N_IN) { const int l = r / I_IN, q = r % I_IN, kb = q / (INW / 64), nb = q % (INW / 64);
        t.src = GIN(I_WIN) + (size_t)l * D * INW + (size_t)kb * 64 * INW + nb * 64; t.dst = (unsigned char*)(win_t + ((size_t)l * PP + nb * 64) * D + kb * 64); t.N = INW; t.f8 = 0; return t; }
    r -= N_IN;
    if (r < N_OUT) { const int l = r / I_OUT, q = r % I_OUT, kb = q / 16, nb = q % 16;
        t.src = GIN(I_WOUT) + (size_t)l * D * D + (size_t)kb * 64 * D + nb * 64; t.dst = (unsigned char*)(wout_t + ((size_t)l * D + nb * 64) * D + kb * 64); t.N = D; t.f8 = 0; return t; }
    r -= N_OUT;
    if (r < N_GU) { const int le = r / I_GU, q = r % I_GU, kb = q / 32, nb = q % 32, n0 = nb * 64, half = n0 >> 10, j = n0 & 1023;
        const int drow = 256 * (j >> 7) + 128 * half + (j & 127);
        t.src = GIN(I_WGU) + (size_t)le * D * 2048 + (size_t)kb * 64 * 2048 + n0; t.dst = wgu_t + ((size_t)le * 2048 + drow) * D + kb * 64; t.N = 2048; t.f8 = 1; return t; }
    r -= N_GU;
    { const int le = r / I_DN, q = r % I_DN, kb = q / 16, nb = q % 16;
        t.src = GIN(I_WDN) + (size_t)le * FF * D + (size_t)kb * 64 * D + nb * 64; t.dst = wdn_t + ((size_t)le * D + nb * 64) * FF + kb * 64; t.N = D; t.f8 = 1; return t; } }
__device__ __forceinline__ void load(const Item& t, f32x4 (&v)[16], int lane) { const int r4 = lane >> 4, c16 = lane & 15;
#pragma unroll
    for (int i = 0; i < 16; ++i) v[i] = __builtin_nontemporal_load((const f32x4*)(t.src + (size_t)(4 * i + r4) * t.N + 4 * c16)); }
template <int F8C = -1> __device__ __forceinline__ void to_lds(const Item& t, const f32x4 (&v)[16], LAS float* scr, int lane) {
    const int r4 = lane >> 4, c16 = lane & 15; const float sc = (F8C == 1 || t.f8) ? 32.0f : 1.0f;
#pragma unroll
    for (int i = 0; i < 16; ++i) *(LAS f32x4*)(scr + (4 * i + r4) * 64 + 4 * (c16 ^ i)) = v[i] * sc;
    LDS_WAIT(); asm volatile("" ::: "memory"); }
template <int F8C = -1> __device__ __forceinline__ void finish(const Item& t, LAS float* scr, int lane) {
    const int q = lane & 3, a = lane >> 4, n3 = (lane >> 2) & 3;
    const LAS float* base0 = scr + q * 1024 + n3;
    int Y[4];
#pragma unroll
    for (int b = 0; b < 4; ++b) Y[b] = 4 * (a ^ b);
#pragma unroll
    for (int p = 0; p < 4; ++p) { const int n = 16 * p + (lane >> 2); const LAS float* bp = base0 + 16 * (p ^ q); float e[16];
#pragma unroll
        for (int kk = 0; kk < 16; ++kk) e[kk] = bp[kk * 64 + Y[kk >> 2]];
        if (F8C == 1 || t.f8) { u32x4 o; o.x = cvt4_fp8(e[0], e[1], e[2], e[3]); o.y = cvt4_fp8(e[4], e[5], e[6], e[7]); o.z = cvt4_fp8(e[8], e[9], e[10], e[11]); o.w = cvt4_fp8(e[12], e[13], e[14], e[15]);
            *(u32x4*)(t.dst + (size_t)n * D + 16 * q) = o; }
        else { u32x4* dp = (u32x4*)(t.dst + ((size_t)n * D + 16 * q) * 2);
#pragma unroll
            for (int h = 0; h < 2; ++h) { u32x4 o; o.x = cvtpk(e[8 * h], e[8 * h + 1]); o.y = cvtpk(e[8 * h + 2], e[8 * h + 3]); o.z = cvtpk(e[8 * h + 4], e[8 * h + 5]); o.w = cvtpk(e[8 * h + 6], e[8 * h + 7]); dp[h] = o; } } }
    LDS_WAIT(); asm volatile("" ::: "memory"); }
__device__ __forceinline__ void run(Frame& F, int it0, int step, int end) {
    LAS float* scr = (LAS float*)(F.lds + F.wave * 16384);
    int it = it0;
    if (it < end) { Item cur = decode(F, it); f32x4 vc[16]; load(cur, vc, F.lane);
        for (;;) { const int itn = it + step; const bool hn = itn < end; Item nx = cur; f32x4 vn[16];
            if (hn) { nx = decode(F, itn); load(nx, vn, F.lane); }
            to_lds(cur, vc, scr, F.lane); finish(cur, scr, F.lane);
            if (!hn) break;
            cur = nx; it = itn;
#pragma unroll
            for (int i = 0; i < 16; ++i) vc[i] = vn[i]; } }
}
constexpr int BATCH_ITEMS = 32, NB_GU = NE * I_GU / BATCH_ITEMS, NB_DN = NE * I_DN / BATCH_ITEMS, NB_LAYER = NB_GU + NB_DN;
__device__ __forceinline__ void run_batch(Frame& F, int base) {
    LAS float* scr = (LAS float*)(F.lds + F.wave * 16384);
    const int i0 = base + 4 * F.wave;
    f32x4 vA[16], vB[16];
    const Item t0 = decode(F, i0), t1 = decode(F, i0 + 1), t2 = decode(F, i0 + 2), t3 = decode(F, i0 + 3);
#define CV_ARRIVED(V, n) do { asm volatile("s_waitcnt vmcnt(" #n ")" ::: "memory"); _Pragma("unroll") for (int _i = 0; _i < 16; ++_i) asm volatile("" : "+v"(V[_i])); } while (0)
    load(t0, vA, F.lane); load(t1, vB, F.lane);
    CV_ARRIVED(vA, 16); to_lds<1>(t0, vA, scr, F.lane); finish<1>(t0, scr, F.lane); load(t2, vA, F.lane);
    CV_ARRIVED(vB, 16); to_lds<1>(t1, vB, scr, F.lane); finish<1>(t1, scr, F.lane); load(t3, vB, F.lane);
    CV_ARRIVED(vA, 16); to_lds<1>(t2, vA, scr, F.lane); finish<1>(t2, scr, F.lane);
    CV_ARRIVED(vB, 0);  to_lds<1>(t3, vB, scr, F.lane); finish<1>(t3, scr, F.lane);
}
__device__ __forceinline__ void run_half(Frame& F, int base16) {
    LAS float* scr = (LAS float*)(F.lds + F.wave * 16384);
    const int i0 = base16 + 2 * F.wave;
    f32x4 vA[16], vB[16];
    const Item t0 = decode(F, i0), t1 = decode(F, i0 + 1);
    load(t0, vA, F.lane); load(t1, vB, F.lane);
    CV_ARRIVED(vA, 16); to_lds<1>(t0, vA, scr, F.lane); finish<1>(t0, scr, F.lane);
    CV_ARRIVED(vB, 0);  to_lds<1>(t1, vB, scr, F.lane); finish<1>(t1, scr, F.lane);
#undef CV_ARRIVED
}
__device__ __forceinline__ int batch_base(int l, int id) { return id < NB_GU ? N_PROJ + l * (NE * I_GU) + id * BATCH_ITEMS : N_PROJ + N_GU + l * (NE * I_DN) + (id - NB_GU) * BATCH_ITEMS; }
__device__ __forceinline__ int tail_batches(int l) { return l >= 1 ? 160 : 0; }
}
__device__ __forceinline__ void conv_one(Frame& F, int l, bool tail = false) {
    { int _t = (F.wave << 6) | lane_id(); asm volatile("" : "+v"(_t)); F.tid = _t; F.lane = _t & 63; }
    volatile LAS int* sq = (volatile LAS int*)(F.lds + MISC_OFF + 1024);
    unsigned* head = (unsigned*)(F.ctl + CW_Q + 64 * l + (tail ? 40 : 32));
    __syncthreads();
    if (F.tid == 0) *sq = (int)xb_add(head, 1u);
    __syncthreads();
    const int id = __builtin_amdgcn_readfirstlane(*sq);
    __syncthreads();
    const int nbm = cv::NB_LAYER - cv::tail_batches(l);
    if (tail) { if (id < 2 * cv::tail_batches(l)) cv::run_half(F, cv::batch_base(l, nbm + (id >> 1)) + 16 * (id & 1)); }
    else if (id < nbm) cv::run_batch(F, cv::batch_base(l, id));
    __syncthreads();
}
__device__ __forceinline__ void p0_convert(Frame& F) {
    const int gw = F.vcu * NWAVES + F.wave, NGW = F.G * NWAVES;
    bf16_t* win_t = (bf16_t*)(F.ws + WS_WIN);
    for (int i = gw * 64 + F.lane; i < DEPTH * 128 * D / 8; i += NGW * 64) { const int l = i / (128 * D / 8), r = i % (128 * D / 8);
        *(u32x4*)(win_t + ((size_t)l * PP + INW) * D + (size_t)r * 8) = (u32x4){0u, 0u, 0u, 0u}; }
    cv::run(F, gw, NGW, cv::N_PROJ);
    __syncthreads();
}

__device__ __forceinline__ void modnorm_store(const f32x4 (&v)[4], const float* nw, const float* scale, const float* shift, bf16_t* orow, int lane) {
    float s = 0.f;
#pragma unroll
    for (int j = 0; j < 4; ++j) s += (v[j].x * v[j].x + v[j].y * v[j].y) + (v[j].z * v[j].z + v[j].w * v[j].w);
    const float rstd = 1.0f / sqrtf(wave_sum(s) * (1.0f / D) + NORM_EPS);
#pragma unroll
    for (int j = 0; j < 4; ++j) { const int k = 4 * lane + 256 * j; const f32x4 w = *(const f32x4*)(nw + k), sc = *(const f32x4*)(scale + k), sh = *(const f32x4*)(shift + k);
        const f32x4 h = v[j] * rstd * w * (sc + 1.0f) + sh;
        u32x2 o; o.x = pk2(h.x, h.y); o.y = pk2(h.z, h.w); *(u32x2*)(orow + k) = o; }
}
__device__ __forceinline__ void p0b_norm(Frame& F) {
    const int gw = F.vcu * NWAVES + F.wave, NGW = F.G * NWAVES;
    const float* mod = (const float*)(F.ws + WS_MOD); bf16_t* hb = (bf16_t*)(F.ws + WS_H);
    for (int tok = gw; tok < T; tok += NGW) { const int b = tok / SEQ; const float* xr = GIN(I_X) + (size_t)tok * D;
        f32x4 v[4];
#pragma unroll
        for (int j = 0; j < 4; ++j) v[j] = *(const f32x4*)(xr + 4 * F.lane + 256 * j);
        modnorm_store(v, GIN(I_NMIX), mod + (size_t)b * 6144 + 1024, mod + (size_t)b * 6144, hb + (size_t)tok * D, F.lane); }
}

__device__ __forceinline__ float sigmoid_f(float x) { return frcp(1.0f + fexp(-x)); }
__device__ __forceinline__ float gelu_tanh(float x) { const float u = 0.7978845608028654f * (x + 0.044715f * x * x * x); return x * frcp(1.0f + fexp(-2.0f * u)); }
constexpr int LRU_WT = 0, LRU_A = 18432, LRU_LS = 68, LRU_B = LRU_A + LCH * LRU_LS * 4, LRU_SEG = LRU_B + LCH * LRU_LS * 4, LRU_CARRY = LRU_SEG + 4096;
__device__ __forceinline__ void lru_unit(Frame& F, int l, int b, int g, int c4) {
    const int tid = F.tid, lane = F.lane, wave = F.wave;
    LAS unsigned char* lds = F.lds;
    const bf16_t* proj = (const bf16_t*)(F.ws + WS_PROJ);
    float* lrusum = (float*)(F.ws + WS_LRUSUM);
    const int gc0 = l * 384 + g * 64;
    { const float* wa = GIN(I_WA) + ((size_t)l * 6 + g) * 4096; const float* wx = GIN(I_WX) + ((size_t)l * 6 + g) * 4096;
      for (int idx = tid; idx < 8192; idx += 512) { const int gate = idx >> 12, i = (idx >> 6) & 63, j = idx & 63; const float v = (gate ? wx : wa)[i * 64 + j];
          *(LAS unsigned short*)(lds + LRU_WT + (gate * 64 + j) * 144 + i * 2) = (unsigned short)f2bf(v); } }
    float bavq[4], bxvq[4], c8q[4];
#pragma unroll
    for (int nt = 0; nt < 4; ++nt) { const int chq = 16 * nt + (lane & 15); bavq[nt] = GIN(I_BA)[gc0 + chq]; bxvq[nt] = GIN(I_BX)[gc0 + chq]; c8q[nt] = -8.0f * log1pf(__expf(-GIN(I_LAM)[gc0 + chq])); }
    u32x4 xq[2][4];
    { const int pos0 = 4 * c4 * LCH + wave * 16 + (lane & 15);
#pragma unroll
      for (int ks = 0; ks < 2; ++ks)
#pragma unroll
          for (int w = 0; w < 4; ++w) { const int p = pos0 - 3 + w; xq[ks][w] = (u32x4){0u, 0u, 0u, 0u}; if (p >= 0) xq[ks][w] = *(const u32x4*)(proj + (size_t)(b * SEQ + p) * PP + C_LX + g * 64 + 32 * ks + 8 * (lane >> 4)); } }
    __syncthreads();
#pragma unroll 1
  for (int c = 4 * c4; c < 4 * c4 + 4; ++c) {
    const int tt = lane & 15, kg = lane >> 4;
    const int tl = wave * 16 + tt;
    const int pos = c * LCH + tl;
    bf16x8 af[2];
    u32x4 xc[2][4];
#pragma unroll
    for (int ks = 0; ks < 2; ++ks)
#pragma unroll
        for (int w = 0; w < 4; ++w) xc[ks][w] = xq[ks][w];
    if (c + 1 < 4 * c4 + 4) {
#pragma unroll
        for (int ks = 0; ks < 2; ++ks)
#pragma unroll
            for (int w = 0; w < 4; ++w) xq[ks][w] = *(const u32x4*)(proj + (size_t)(b * SEQ + pos + LCH - 3 + w) * PP + C_LX + g * 64 + 32 * ks + 8 * kg); }
#pragma unroll
    for (int ks = 0; ks < 2; ++ks) { const int ch0 = 32 * ks + 8 * kg; float u[8];
        { const f32x4 cb0 = *(const f32x4*)(GIN(I_CONVB) + gc0 + ch0), cb1 = *(const f32x4*)(GIN(I_CONVB) + gc0 + ch0 + 4);
          u[0] = cb0.x; u[1] = cb0.y; u[2] = cb0.z; u[3] = cb0.w; u[4] = cb1.x; u[5] = cb1.y; u[6] = cb1.z; u[7] = cb1.w; }
#pragma unroll
        for (int w = 0; w < 4; ++w) { const int p = pos - 3 + w;
            if (p >= 0) { const u32x4 xv = xc[ks][w];
                const float* cw = GIN(I_CONVW) + (size_t)l * 4 * 384 + w * 384 + g * 64 + ch0; const f32x4 w0 = *(const f32x4*)cw, w1 = *(const f32x4*)(cw + 4);
                u[0] += bflo(xv.x) * w0.x; u[1] += bfhi(xv.x) * w0.y; u[2] += bflo(xv.y) * w0.z; u[3] += bfhi(xv.y) * w0.w;
                u[4] += bflo(xv.z) * w1.x; u[5] += bfhi(xv.z) * w1.y; u[6] += bflo(xv.w) * w1.z; u[7] += bfhi(xv.w) * w1.w; } }
        LAS float* ub = (LAS float*)(lds + LRU_B) + tl * LRU_LS + ch0;
        *(LAS f32x4*)ub = (f32x4){u[0], u[1], u[2], u[3]}; *(LAS f32x4*)(ub + 4) = (f32x4){u[4], u[5], u[6], u[7]};
        u32x4 pk; pk.x = pk2(u[0], u[1]); pk.y = pk2(u[2], u[3]); pk.z = pk2(u[4], u[5]); pk.w = pk2(u[6], u[7]); af[ks] = __builtin_bit_cast(bf16x8, pk); }
    LDS_WAIT(); asm volatile("" ::: "memory");
#pragma unroll
    for (int nt = 0; nt < 4; ++nt) { f32x4 pa = (f32x4){0.f, 0.f, 0.f, 0.f}, px = pa;
#pragma unroll
        for (int ks = 0; ks < 2; ++ks) { const bf16x8 ba = *(const LAS bf16x8*)(lds + LRU_WT + (16 * nt + tt) * 144 + (32 * ks + 8 * kg) * 2);
            const bf16x8 bx = *(const LAS bf16x8*)(lds + LRU_WT + (64 + 16 * nt + tt) * 144 + (32 * ks + 8 * kg) * 2);
            pa = __builtin_amdgcn_mfma_f32_16x16x32_bf16(af[ks], ba, pa, 0, 0, 0); px = __builtin_amdgcn_mfma_f32_16x16x32_bf16(af[ks], bx, px, 0, 0, 0); }
        const int ch = 16 * nt + tt; const float bav = bavq[nt], bxv = bxvq[nt], c8 = c8q[nt];
#pragma unroll
        for (int j = 0; j < 4; ++j) { const int t2 = wave * 16 + 4 * kg + j;
            const float r = sigmoid_f(pa[j] + bav), ii = sigmoid_f(px[j] + bxv), la = c8 * r, a = fexp(la), bc = __builtin_amdgcn_sqrtf(fmaxf(1.0f - a * a, 0.f));
            LAS float* pb = (LAS float*)(lds + LRU_B) + t2 * LRU_LS + ch; const float uv = *pb;
            *((LAS float*)(lds + LRU_A) + t2 * LRU_LS + ch) = a; *pb = bc * ii * uv; } }
    __syncthreads();
    const int ch = tid & 63, seg = tid >> 6;
    const LAS float* Ab = (const LAS float*)(lds + LRU_A) + (seg * 16) * LRU_LS + ch; const LAS float* Bb = (const LAS float*)(lds + LRU_B) + (seg * 16) * LRU_LS + ch;
    float ar[16], br[16];
    { float h = 0.f, A = 1.f;
#pragma unroll
      for (int t = 0; t < 16; ++t) { ar[t] = Ab[t * LRU_LS]; br[t] = Bb[t * LRU_LS]; }
#pragma unroll
      for (int t = 0; t < 16; ++t) { h = ar[t] * h + br[t]; A *= ar[t]; }
      LAS float* sg = (LAS float*)(lds + LRU_SEG); sg[(seg * 2) * 64 + ch] = A; sg[(seg * 2 + 1) * 64 + ch] = h; }
    __syncthreads();
    const LAS float* sg = (const LAS float*)(lds + LRU_SEG);
    if (tid < 64) { float H = 0.f, At = 1.f;
#pragma unroll
        for (int s = 0; s < 8; ++s) { const float a = sg[(s * 2) * 64 + ch]; H = a * H + sg[(s * 2 + 1) * 64 + ch]; At *= a; }
        float* o = lrusum + (((size_t)(b * 6 + g) * NLCH + c) * 2) * 64; o[ch] = At; o[64 + ch] = H; }
    { float h = 0.f, A = 1.f;
#pragma unroll
      for (int s = 0; s < 8; ++s) if (s < seg) { const float a = sg[(s * 2) * 64 + ch]; h = a * h + sg[(s * 2 + 1) * 64 + ch]; A *= a; }
      bf16_t* lh = (bf16_t*)(F.ws + WS_LRUH); bf16_t* la = (bf16_t*)(F.ws + WS_LRUA);
      const size_t row0 = (size_t)b * SEQ + c * LCH + seg * 16;
#pragma unroll
      for (int t = 0; t < 16; ++t) { const float a = ar[t]; h = a * h + br[t]; A *= a; const unsigned w = cvtpk(h, A);
          lh[(row0 + t) * 384 + g * 64 + ch] = (bf16_t)(w & 0xffffu); la[(row0 + t) * 384 + g * 64 + ch] = (bf16_t)(w >> 16); } }
    __syncthreads();
  }
}
__device__ __forceinline__ void lru_fix(Frame& F, int b, int g, int c) {
    const int tid = F.tid, ch = tid & 63, seg = tid >> 6;
    const float* lrusum = (const float*)(F.ws + WS_LRUSUM);
    LAS float* cy = (LAS float*)(F.lds + LRU_CARRY);
    if (tid < 64) { const float* s0 = lrusum + ((size_t)(b * 6 + g) * NLCH) * 128; float sa[NLCH], sh[NLCH];
#pragma unroll
        for (int cc = 0; cc < NLCH; ++cc) { sa[cc] = (cc < c) ? s0[cc * 128 + ch] : 1.0f; sh[cc] = (cc < c) ? s0[cc * 128 + 64 + ch] : 0.0f; }
        float hin = 0.f;
#pragma unroll
        for (int cc = 0; cc < NLCH; ++cc) hin = sa[cc] * hin + sh[cc];
        cy[ch] = hin; }
    const bf16_t* proj = (const bf16_t*)(F.ws + WS_PROJ); const bf16_t* lh = (const bf16_t*)(F.ws + WS_LRUH); const bf16_t* la = (const bf16_t*)(F.ws + WS_LRUA); bf16_t* ymix = (bf16_t*)(F.ws + WS_YMIX);
    const int tl = tid >> 2, c0 = 16 * (tid & 3);
    const size_t row = (size_t)b * SEQ + c * LCH + tl;
    const u32x4 g0 = *(const u32x4*)(proj + row * PP + C_LG + g * 64 + c0), g1 = *(const u32x4*)(proj + row * PP + C_LG + g * 64 + c0 + 8);
    const u32x4 h0 = *(const u32x4*)(lh + row * 384 + g * 64 + c0), h1 = *(const u32x4*)(lh + row * 384 + g * 64 + c0 + 8);
    const u32x4 a0 = *(const u32x4*)(la + row * 384 + g * 64 + c0), a1 = *(const u32x4*)(la + row * 384 + g * 64 + c0 + 8);
    __syncthreads();
    const unsigned gw[8] = {g0.x, g0.y, g0.z, g0.w, g1.x, g1.y, g1.z, g1.w}, hw[8] = {h0.x, h0.y, h0.z, h0.w, h1.x, h1.y, h1.z, h1.w}, aw[8] = {a0.x, a0.y, a0.z, a0.w, a1.x, a1.y, a1.z, a1.w};
    unsigned ow[8];
#pragma unroll
    for (int i = 0; i < 8; ++i) { const float hin0 = cy[c0 + 2 * i], hin1 = cy[c0 + 2 * i + 1];
        const float y0 = gelu_tanh(bflo(gw[i])) * (bflo(hw[i]) + bflo(aw[i]) * hin0), y1 = gelu_tanh(bfhi(gw[i])) * (bfhi(hw[i]) + bfhi(aw[i]) * hin1);
        ow[i] = cvtpk(y0, y1); }
    bf16_t* yp = ymix + row * D + Y_LRU + g * 64 + c0;
    *(u32x4*)yp = (u32x4){ow[0], ow[1], ow[2], ow[3]}; *(u32x4*)(yp + 8) = (u32x4){ow[4], ow[5], ow[6], ow[7]};
    __syncthreads();
}

constexpr int AT_KS = 144;
constexpr int AT_K = 0, AT_V = 2 * 64 * AT_KS;
__device__ __forceinline__ s16x4 vtr(const LAS unsigned char* p) { return __builtin_bit_cast(s16x4, __builtin_amdgcn_ds_read_tr16_b64_v4i16((LAS v4i16_t*)p)); }
template <int MODE>
__device__ __forceinline__ void attn_unit(Frame& F, int l, int b, int h, int qb) {
    const int tid = F.tid, lane = F.lane, wave = F.wave;
    LAS unsigned char* lds = F.lds;
    const bf16_t* proj = (const bf16_t*)(F.ws + WS_PROJ); bf16_t* ymix = (bf16_t*)(F.ws + WS_YMIX);
    const int colQ = (MODE == 0 ? C_MQ : C_RQ) + h * 64, colK = (MODE == 0 ? C_MK : C_RK) + h * 64, colV = (MODE == 0 ? C_MV : C_RV) + h * 64;
    const int ql = lane & 15, g4 = lane >> 4;
    const size_t rowb = (size_t)b * SEQ;
    int qidx[2]; bf16x8 qf[2][2];
#pragma unroll
    for (int mt = 0; mt < 2; ++mt) { qidx[mt] = qb * 256 + wave * 32 + mt * 16 + ql;
#pragma unroll
        for (int ks = 0; ks < 2; ++ks) qf[mt][ks] = *(const bf16x8*)(proj + (rowb + qidx[mt]) * PP + colQ + 32 * ks + 8 * g4); }
    const int own = qb;
    unsigned amask[2] = {0u, 0u};
    if constexpr (MODE == 0) {
        const float* km = (const float*)(F.ws + WS_KMEAN) + ((size_t)(b * 6 + h) * 8) * 64;
#pragma unroll
        for (int mt = 0; mt < 2; ++mt) { float gs[8];
#pragma unroll
            for (int n = 0; n < 8; ++n) { float s = 0.f;
                if (n < own) {
#pragma unroll
                    for (int ks = 0; ks < 2; ++ks) { const f32x4 k0 = *(const f32x4*)(km + n * 64 + 32 * ks + 8 * g4), k1 = *(const f32x4*)(km + n * 64 + 32 * ks + 8 * g4 + 4);
                        const u32x4 qw = __builtin_bit_cast(u32x4, qf[mt][ks]);
                        s += bflo(qw.x) * k0.x + bfhi(qw.x) * k0.y + bflo(qw.y) * k0.z + bfhi(qw.y) * k0.w + bflo(qw.z) * k1.x + bfhi(qw.z) * k1.y + bflo(qw.w) * k1.z + bfhi(qw.w) * k1.w; } }
                s += __shfl_xor(s, 16); s += __shfl_xor(s, 32);
                gs[n] = (n < own) ? s : -INFINITY; }
#pragma unroll
            for (int n = 0; n < 8; ++n) { int cnt = 0;
#pragma unroll
                for (int m = 0; m < 8; ++m) if (m != n) cnt += (gs[m] > gs[n] || (gs[m] == gs[n] && m < n)) ? 1 : 0;
                if (n < own && cnt < 3) amask[mt] |= (1u << n); } }
    }
    const float log2g = (MODE == 1) ? log2f(1.0f - exp2f(-5.0f - (float)h)) : 0.f;
    float dc[4][4];
    if constexpr (MODE == 1) {
#pragma unroll
        for (int t = 0; t < 4; ++t)
#pragma unroll
            for (int j = 0; j < 4; ++j) dc[t][j] = ex2(-(float)(16 * t + 4 * g4 + j) * log2g);
    }
    const int lt = tid & 255, lrow = lt >> 2, lc = lt & 3;
    const bf16_t* gsrc = proj + (rowb + lrow) * PP + (tid < 256 ? colK : colV) + lc * 8;
    const int ldst = (tid < 256 ? AT_K : AT_V) + lrow * AT_KS + lc * 16;
    const int nkt = 4 * qb + 4;
    u32x4 pre0 = *(const u32x4*)(gsrc), pre1 = *(const u32x4*)(gsrc + 32);
    *(LAS u32x4*)(lds + ldst) = pre0; *(LAS u32x4*)(lds + ldst + 64) = pre1;
    __syncthreads();
    f32x4 o[2][4];
#pragma unroll
    for (int mt = 0; mt < 2; ++mt)
#pragma unroll
        for (int dt = 0; dt < 4; ++dt) o[mt][dt] = (f32x4){0.f, 0.f, 0.f, 0.f};
    float mrun[2] = {-1e30f, -1e30f}, lsum[2] = {0.f, 0.f};
    const int li = lane & 15, tq = li >> 2, tp = li & 3;
    auto tile = [&](const int kt, auto diag_c) {
        constexpr bool diag = decltype(diag_c)::value;
        const int buf = kt & 1;
        if (kt + 1 < nkt) { const bf16_t* gp = gsrc + (size_t)(kt + 1) * 64 * PP; pre0 = *(const u32x4*)(gp); pre1 = *(const u32x4*)(gp + 32); }
        f32x4 s[2][4];
        const LAS unsigned char* kb = lds + AT_K + buf * 64 * AT_KS;
#pragma unroll
        for (int t = 0; t < 4; ++t) { s[0][t] = (f32x4){0.f, 0.f, 0.f, 0.f}; s[1][t] = (f32x4){0.f, 0.f, 0.f, 0.f};
#pragma unroll
            for (int ks = 0; ks < 2; ++ks) { const bf16x8 kf = *(const LAS bf16x8*)(kb + (16 * t + ql) * AT_KS + (32 * ks + 8 * g4) * 2);
                s[0][t] = __builtin_amdgcn_mfma_f32_16x16x32_bf16(kf, qf[0][ks], s[0][t], 0, 0, 0);
                s[1][t] = __builtin_amdgcn_mfma_f32_16x16x32_bf16(kf, qf[1][ks], s[1][t], 0, 0, 0); } }
        bf16x8 pf[2][2];
#pragma unroll
        for (int mt = 0; mt < 2; ++mt) {
            float p[4][4];
            if constexpr (MODE == 0) {
                constexpr float SC = 0.125f * 1.4426950408889634f;
                const int kblk = kt >> 2;
                const bool allow = !(kblk < own && ((amask[mt] >> kblk) & 1u) == 0u);
                float mx = -INFINITY;
#pragma unroll
                for (int t = 0; t < 4; ++t)
#pragma unroll
                    for (int j = 0; j < 4; ++j) { float v = s[mt][t][j];
                        if constexpr (diag) { const int key = kt * 64 + 16 * t + 4 * g4 + j; v = (key <= qidx[mt]) ? v : -INFINITY; }
                        p[t][j] = v; mx = fmaxf(mx, v); }
                mx = allow ? mx * SC : -INFINITY;
                mx = fmaxf(mx, __shfl_xor(mx, 16)); mx = fmaxf(mx, __shfl_xor(mx, 32));
                const float mnew = fmaxf(mrun[mt], mx), alpha = ex2(mrun[mt] - mnew); mrun[mt] = mnew;
                const float nb = allow ? -mnew : -INFINITY;
                float ps = 0.f;
#pragma unroll
                for (int t = 0; t < 4; ++t)
#pragma unroll
                    for (int j = 0; j < 4; ++j) { const float e = ex2(fmaf(p[t][j], SC, nb)); p[t][j] = e; ps += e; }
                lsum[mt] = lsum[mt] * alpha + ps;
#pragma unroll
                for (int dt = 0; dt < 4; ++dt) o[mt][dt] = o[mt][dt] * alpha;
            } else {
                const float at = ex2((float)(qidx[mt] - kt * 64) * log2g);
#pragma unroll
                for (int t = 0; t < 4; ++t)
#pragma unroll
                    for (int j = 0; j < 4; ++j) { float v = s[mt][t][j] * (at * dc[t][j]);
                        if constexpr (diag) { const int key = kt * 64 + 16 * t + 4 * g4 + j; v = (key <= qidx[mt]) ? v : 0.f; }
                        p[t][j] = v; }
            }
#pragma unroll
            for (int s2 = 0; s2 < 2; ++s2) { u32x4 w; w.x = cvtpk(p[2 * s2][0], p[2 * s2][1]); w.y = cvtpk(p[2 * s2][2], p[2 * s2][3]); w.z = cvtpk(p[2 * s2 + 1][0], p[2 * s2 + 1][1]); w.w = cvtpk(p[2 * s2 + 1][2], p[2 * s2 + 1][3]);
                pf[mt][s2] = __builtin_bit_cast(bf16x8, w); }
        }
        const LAS unsigned char* vb = lds + AT_V + buf * 64 * AT_KS;
#pragma unroll
        for (int dt = 0; dt < 4; ++dt)
#pragma unroll
            for (int s2 = 0; s2 < 2; ++s2) { const s16x4 v0 = vtr(vb + (32 * s2 + 4 * g4 + tq) * AT_KS + (16 * dt + 4 * tp) * 2), v1 = vtr(vb + (32 * s2 + 16 + 4 * g4 + tq) * AT_KS + (16 * dt + 4 * tp) * 2);
                bf16x8 vf; vf[0] = v0[0]; vf[1] = v0[1]; vf[2] = v0[2]; vf[3] = v0[3]; vf[4] = v1[0]; vf[5] = v1[1]; vf[6] = v1[2]; vf[7] = v1[3];
                o[0][dt] = __builtin_amdgcn_mfma_f32_16x16x32_bf16(vf, pf[0][s2], o[0][dt], 0, 0, 0);
                o[1][dt] = __builtin_amdgcn_mfma_f32_16x16x32_bf16(vf, pf[1][s2], o[1][dt], 0, 0, 0); }
        if (kt + 1 < nkt) { const int nb = (buf ^ 1) * 64 * AT_KS; *(LAS u32x4*)(lds + ldst + nb) = pre0; *(LAS u32x4*)(lds + ldst + nb + 64) = pre1; }
        __syncthreads();
    };
    for (int kt = 0; kt < 4 * qb; ++kt) tile(kt, std::false_type{});
    for (int kt = 4 * qb; kt < nkt; ++kt) tile(kt, std::true_type{});
#pragma unroll
    for (int mt = 0; mt < 2; ++mt) {
        if constexpr (MODE == 0) {
            float ls = lsum[mt]; ls += __shfl_xor(ls, 16); ls += __shfl_xor(ls, 32);
            const float inv = 1.0f / ls;
#pragma unroll
            for (int dt = 0; dt < 4; ++dt) { const f32x4 v = o[mt][dt] * inv; u32x2 w; w.x = cvtpk(v.x, v.y); w.y = cvtpk(v.z, v.w);
                *(u32x2*)(ymix + (rowb + qidx[mt]) * D + Y_MOBA + h * 64 + 16 * dt + 4 * g4) = w; }
        } else {
            float sm = 0.f;
#pragma unroll
            for (int dt = 0; dt < 4; ++dt) sm += (o[mt][dt].x + o[mt][dt].y) + (o[mt][dt].z + o[mt][dt].w);
            sm += __shfl_xor(sm, 16); sm += __shfl_xor(sm, 32);
            const float mu = sm * (1.0f / 64.0f); float vs = 0.f;
#pragma unroll
            for (int dt = 0; dt < 4; ++dt) { const f32x4 dv = o[mt][dt] - mu; vs += (dv.x * dv.x + dv.y * dv.y) + (dv.z * dv.z + dv.w * dv.w); }
            vs += __shfl_xor(vs, 16); vs += __shfl_xor(vs, 32);
            const float rstd = 1.0f / sqrtf(vs * (1.0f / 64.0f) + NORM_EPS);
#pragma unroll
            for (int dt = 0; dt < 4; ++dt) { const int d0 = h * 64 + 16 * dt + 4 * g4;
                const f32x4 nw = *(const f32x4*)(GIN(I_RETNW) + l * 256 + d0);
                const u32x2 gw2 = *(const u32x2*)(proj + (rowb + qidx[mt]) * PP + C_RG + d0);
                const float g0 = bflo(gw2.x), g1 = bfhi(gw2.x), g2 = bflo(gw2.y), g3 = bfhi(gw2.y);
                const f32x4 y = (o[mt][dt] - mu) * rstd * nw;
                u32x2 w; w.x = cvtpk(y.x * silu_f(g0), y.y * silu_f(g1)); w.y = cvtpk(y.z * silu_f(g2), y.w * silu_f(g3));
                *(u32x2*)(ymix + (rowb + qidx[mt]) * D + Y_RET + d0) = w; }
        }
    }
}

__device__ __forceinline__ void p2a(Frame& F, int l, int rep) {
    for (int u = F.bx; u < BATCH * 6 * (NLCH / 4); u += F.G) lru_unit(F, l, u / (6 * (NLCH / 4)), (u / (NLCH / 4)) % 6, u % (NLCH / 4));
    if (rep == 0 && F.bx >= BATCH * 6 * (NLCH / 4)) conv_one(F, l);
    bf16_t* proj = (bf16_t*)(F.ws + WS_PROJ);
    for (int u = (F.G - 1 - F.bx); u < BATCH * 6; u += F.G) { const int b = u / 6, h = u % 6, rg = F.lane >> 3, c8 = F.lane & 7;
        const bf16_t* kp = proj + ((size_t)b * SEQ + F.wave * 256 + rg) * PP + C_MK + h * 64 + c8 * 8;
        float a[8];
#pragma unroll
        for (int i = 0; i < 8; ++i) a[i] = 0.f;
#pragma unroll 4
        for (int it = 0; it < 32; ++it) { const u32x4 v = *(const u32x4*)(kp + (size_t)it * 8 * PP);
            a[0] += bflo(v.x); a[1] += bfhi(v.x); a[2] += bflo(v.y); a[3] += bfhi(v.y); a[4] += bflo(v.z); a[5] += bfhi(v.z); a[6] += bflo(v.w); a[7] += bfhi(v.w); }
#pragma unroll
        for (int i = 0; i < 8; ++i) { a[i] += __shfl_xor(a[i], 8); a[i] += __shfl_xor(a[i], 16); a[i] += __shfl_xor(a[i], 32); }
        if (rg == 0) { float* o = (float*)(F.ws + WS_KMEAN) + ((size_t)(b * 6 + h) * 8 + F.wave) * 64 + c8 * 8;
            *(f32x4*)o = (f32x4){a[0], a[1], a[2], a[3]} * (1.0f / 256.0f); *(f32x4*)(o + 4) = (f32x4){a[4], a[5], a[6], a[7]} * (1.0f / 256.0f); } }
    const int gw = F.vcu * NWAVES + F.wave, NGW = F.G * NWAVES;
    const float* rc = (const float*)(F.ws + WS_ROT); const float* rs = rc + SEQ * 32;
    const int which = F.lane >> 5, hh = (F.lane >> 3) & 3, i0 = (F.lane & 7) * 4;
    if (rep == 0) for (int tok = gw; tok < T; tok += NGW) { const int pos = tok % SEQ;
        bf16_t* p = proj + (size_t)tok * PP + which * 256 + hh * 64 + i0;
        const u32x2 a = *(const u32x2*)p, bb = *(const u32x2*)(p + 32);
        const f32x4 cs = *(const f32x4*)(rc + pos * 32 + i0), sn = *(const f32x4*)(rs + pos * 32 + i0);
        const float x1[4] = {bflo(a.x), bfhi(a.x), bflo(a.y), bfhi(a.y)}, x2[4] = {bflo(bb.x), bfhi(bb.x), bflo(bb.y), bfhi(bb.y)};
        const float sc = which ? 0.125f : 1.0f; float y1[4], y2[4];
#pragma unroll
        for (int i = 0; i < 4; ++i) { y1[i] = (x1[i] * cs[i] - x2[i] * sn[i]) * sc; y2[i] = (x2[i] * cs[i] + x1[i] * sn[i]) * sc; }
        u32x2 o1, o2; o1.x = pk2(y1[0], y1[1]); o1.y = pk2(y1[2], y1[3]); o2.x = pk2(y2[0], y2[1]); o2.y = pk2(y2[2], y2[3]);
        *(u32x2*)p = o1; *(u32x2*)(p + 32) = o2; }
}

__device__ __forceinline__ void p2b(Frame& F, int l, int rep) {
    volatile LAS int* sq = (volatile LAS int*)(F.lds + MISC_OFF + 1024);
    unsigned* head = (unsigned*)(F.ctl + CW_Q + 64 * l + rep);
    constexpr int N_ATT = 8 * 80, N_ALL = N_ATT + BATCH * 6 * NLCH;
    int q = (((F.bx >> 3) & 7) < 3) ? 1 : 0;
#pragma unroll 1
    for (int pass = 0; pass < 2; ++pass, q ^= 1) {
        q = __builtin_amdgcn_readfirstlane(q);
        { int _t = (F.wave << 6) | lane_id(); asm volatile("" : "+v"(_t)); F.tid = _t; F.lane = _t & 63;
          GAS unsigned char* _w = (GAS unsigned char*)F.ws; asm volatile("" : "+s"(_w)); F.ws = (unsigned char*)_w; F.ctl = (gu32*)(F.ws + WS_CTL); }
        if (q == 0) {
            for (;;) {
                if (F.tid == 0) *sq = (int)xb_add(head, 1u);
                __syncthreads();
                const int id = __builtin_amdgcn_readfirstlane(*sq);
                __syncthreads();
                if (id >= N_ALL) break;
                if (id < N_ATT) { const int qi = 7 - id / 80, r = id % 80;
                    if (r < 48) attn_unit<0>(F, l, r / 6, r % 6, qi); else attn_unit<1>(F, l, (r - 48) / 4, (r - 48) % 4, qi); }
                else { const int u = id - N_ATT; lru_fix(F, u / (6 * NLCH), (u / NLCH) % 6, u % NLCH); }
            }
        } else {
            unsigned nxt = 0u; unsigned zoff = 0u; asm volatile("" : "+v"(zoff));
            if (F.tid == 0) nxt = xb_add(head + 32 + zoff, 1u);
            for (;;) {
                if (F.tid == 0) *sq = (int)nxt;
                asm volatile("s_waitcnt lgkmcnt(0)\n\ts_barrier" ::: "memory");
                const int id = __builtin_amdgcn_readfirstlane(*sq);
                asm volatile("s_waitcnt lgkmcnt(0)\n\ts_barrier" ::: "memory");
                if (id >= cv::NB_LAYER - cv::tail_batches(l)) break;
                if (F.tid == 0) nxt = xb_add(head + 32 + zoff, 1u);
                cv::run_batch(F, cv::batch_base(l, id));
            }
            if (cv::tail_batches(l) > 0) for (;;) {
                if (F.tid == 0) *sq = (int)xb_add(head + 40 + zoff, 1u);
                asm volatile("s_waitcnt lgkmcnt(0)\n\ts_barrier" ::: "memory");
                const int id = __builtin_amdgcn_readfirstlane(*sq);
                asm volatile("s_waitcnt lgkmcnt(0)\n\ts_barrier" ::: "memory");
                if (id >= 2 * cv::tail_batches(l)) break;
                cv::run_half(F, cv::batch_base(l, cv::NB_LAYER - cv::tail_batches(l) + (id >> 1)) + 16 * (id & 1));
            }
        }
    }
}

constexpr int P4_SELE = MISC_OFF + 2048, P4_SELG = P4_SELE + 1024, P4_HIST = P4_SELG + 1024, P4_BASE = P4_HIST + 128, P4_RANK = P4_BASE + 128;
constexpr int P4_AS = 2064;
constexpr int P4_AHI = 0, P4_ALO = 16 * P4_AS, P4_PART = 2 * 16 * P4_AS, P4_LOG = P4_PART + 8 * 16 * 32 * 4;
__device__ __forceinline__ void p4_router(Frame& F, int l) {
    LAS unsigned char* lds = F.lds;
    LAS int* selE = (LAS int*)(lds + P4_SELE); LAS float* selG = (LAS float*)(lds + P4_SELG);
    LAS int* hist = (LAS int*)(lds + P4_HIST); LAS int* base = (LAS int*)(lds + P4_BASE); LAS int* lrank = (LAS int*)(lds + P4_RANK);
    const float* mod = (const float*)(F.ws + WS_MOD) + (size_t)l * BATCH * 6144;
    const bf16_t* x1 = (const bf16_t*)(F.ws + WS_X1); unsigned char* hb8 = (unsigned char*)(F.ws + WS_H8);
    i32x2* slot = (i32x2*)(F.ws + WS_SLOT);
    unsigned* cntg = (unsigned*)(F.ctl + CW_CNT + 64 * l);
    const int lane = F.lane, wave = F.wave, tid = F.tid, tt = lane & 15, g4 = lane >> 4;
    bf16x8 bh[2][4], bl[2][4];
    { const bf16_t* rwt = (const bf16_t*)(F.ws + WS_RWT) + (size_t)l * 2 * NE * D;
#pragma unroll
      for (int nt = 0; nt < 2; ++nt)
#pragma unroll
          for (int ks = 0; ks < 4; ++ks) { const size_t o = (size_t)(16 * nt + tt) * D + 128 * wave + 32 * ks + 8 * g4; bh[nt][ks] = *(const bf16x8*)(rwt + o); bl[nt][ks] = *(const bf16x8*)(rwt + (size_t)NE * D + o); } }
    for (int tg = F.bx; tg < T / 64; tg += F.G) {
        if (tid < 32) hist[tid] = 0;
        const int tok0 = tg * 64, b = tok0 / SEQ;
        f32x4 mA[4], mB[4];
#pragma unroll
        for (int j = 0; j < 4; ++j) { const int k = 4 * lane + 256 * j; const f32x4 w = *(const f32x4*)(GIN(I_NFFN) + l * D + k), sc = *(const f32x4*)(mod + (size_t)b * 6144 + 4096 + k);
            mA[j] = w * (sc + 1.0f); mB[j] = *(const f32x4*)(mod + (size_t)b * 6144 + 3072 + k); }
#pragma unroll 1
        for (int grp = 0; grp < 4; ++grp) {
            { f32x4 v[2][4];
#pragma unroll
              for (int q = 0; q < 2; ++q)
#pragma unroll
                  for (int j = 0; j < 4; ++j) { const u32x2 w = *(const u32x2*)(x1 + ((size_t)tok0 + grp * 16 + 2 * wave + q) * D + 4 * lane + 256 * j); v[q][j] = (f32x4){bflo(w.x), bfhi(w.x), bflo(w.y), bfhi(w.y)}; }
#pragma unroll
              for (int q = 0; q < 2; ++q) { const int tl = 2 * wave + q; const size_t tok = (size_t)tok0 + grp * 16 + tl; float sa = 0.f;
#pragma unroll
                for (int j = 0; j < 4; ++j) sa += (v[q][j].x * v[q][j].x + v[q][j].y * v[q][j].y) + (v[q][j].z * v[q][j].z + v[q][j].w * v[q][j].w);
                const float ra = 1.0f / sqrtf(wave_sum(sa) * (1.0f / D) + NORM_EPS);
#pragma unroll
                for (int j = 0; j < 4; ++j) { const int k = 4 * lane + 256 * j;
                    const f32x4 hv = v[q][j] * ra * mA[j] + mB[j];
                    u32x2 hi; hi.x = cvtpk(hv.x, hv.y); hi.y = cvtpk(hv.z, hv.w);
                    const f32x4 lo = hv - (f32x4){bflo(hi.x), bfhi(hi.x), bflo(hi.y), bfhi(hi.y)};
                    u32x2 lw; lw.x = cvtpk(lo.x, lo.y); lw.y = cvtpk(lo.z, lo.w);
                    *(unsigned*)(hb8 + tok * D + k) = cvt4_fp8(hv.x, hv.y, hv.z, hv.w);
                    *(LAS u32x2*)(lds + P4_AHI + tl * P4_AS + k * 2) = hi; *(LAS u32x2*)(lds + P4_ALO + tl * P4_AS + k * 2) = lw; } } }
            __syncthreads();
            { f32x4 acc[2] = {(f32x4){0.f, 0.f, 0.f, 0.f}, (f32x4){0.f, 0.f, 0.f, 0.f}};
#pragma unroll
              for (int ks = 0; ks < 4; ++ks) { const int ao = tt * P4_AS + (128 * wave + 32 * ks + 8 * g4) * 2;
                  const bf16x8 ah = *(const LAS bf16x8*)(lds + P4_AHI + ao), al = *(const LAS bf16x8*)(lds + P4_ALO + ao);
#pragma unroll
                  for (int nt = 0; nt < 2; ++nt) { acc[nt] = __builtin_amdgcn_mfma_f32_16x16x32_bf16(ah, bh[nt][ks], acc[nt], 0, 0, 0);
                      acc[nt] = __builtin_amdgcn_mfma_f32_16x16x32_bf16(ah, bl[nt][ks], acc[nt], 0, 0, 0); acc[nt] = __builtin_amdgcn_mfma_f32_16x16x32_bf16(al, bh[nt][ks], acc[nt], 0, 0, 0); } }
              LAS float* part = (LAS float*)(lds + P4_PART) + wave * 512;
#pragma unroll
              for (int nt = 0; nt < 2; ++nt)
#pragma unroll
                  for (int j = 0; j < 4; ++j) part[(4 * g4 + j) * 32 + 16 * nt + tt] = acc[nt][j]; }
            __syncthreads();
            { const LAS float* part = (const LAS float*)(lds + P4_PART); float sum = 0.f;
#pragma unroll
              for (int w = 0; w < 8; ++w) sum += part[w * 512 + tid];
              const int e = tid & 31; float v = sum + GIN(I_RB)[l * NE + e];
              float tv[4]; int te[4];
#pragma unroll
              for (int k = 0; k < 4; ++k) { float bv = v; int be = e;
#pragma unroll
                  for (int msk = 16; msk >= 1; msk >>= 1) { const float ov = __shfl_xor(bv, msk); const int oe = __shfl_xor(be, msk); const bool take = (ov > bv) || (ov == bv && oe < be); bv = take ? ov : bv; be = take ? oe : be; }
                  tv[k] = bv; te[k] = be; if (e == be) v = -INFINITY; }
              if (e == 0) { const float e1 = fexp(tv[1] - tv[0]), e2 = fexp(tv[2] - tv[0]), e3 = fexp(tv[3] - tv[0]), inv = 1.0f / (1.0f + e1 + e2 + e3);
                  const int s0 = (grp * 16 + (tid >> 5)) * 4; selE[s0] = te[0]; selE[s0 + 1] = te[1]; selE[s0 + 2] = te[2]; selE[s0 + 3] = te[3];
                  selG[s0] = inv; selG[s0 + 1] = e1 * inv; selG[s0 + 2] = e2 * inv; selG[s0 + 3] = e3 * inv; } }
        }
        __syncthreads();
        if (tid < 256) lrank[tid] = __hip_atomic_fetch_add(&hist[selE[tid]], 1, __ATOMIC_RELAXED, __HIP_MEMORY_SCOPE_WORKGROUP);
        __syncthreads();
        if (tid < 32) base[tid] = (int)xb_add(cntg + tid, (unsigned)hist[tid]);
        __syncthreads();
        if (tid < 256) { const int e = selE[tid], rank = base[e] + lrank[tid]; i32x2 ent; ent.x = (tok0 + (tid >> 2)) * 4 + (tid & 3); ent.y = __builtin_bit_cast(int, selG[tid]); slot[(size_t)e * CAP + rank] = ent; }
        __syncthreads();
    }
}
__device__ __forceinline__ int moe_table(Frame& F, int l) {
    LAS int* tab = (LAS int*)(F.lds + MISC_OFF + 1536);
    if (F.tid < 32) {
        const int e = F.tid; const int cn = (int)__hip_atomic_load((unsigned*)(F.ctl + CW_CNT + 64 * l + e), RLX_AGENT); const int nb = (cn + 255) >> 8;
        int inc = nb;
#pragma unroll
        for (int d = 1; d < 32; d <<= 1) { const int o = __shfl_up(inc, d); if (e >= d) inc += o; }
        tab[e] = inc - nb; tab[33 + e] = cn; if (e == 31) tab[32] = inc; }
    __syncthreads();
    return __builtin_amdgcn_readfirstlane(tab[32]);
}

__device__ __forceinline__ void p7_combine(Frame& F, int l) {
    const int gw = F.vcu * NWAVES + F.wave, NGW = F.G * NWAVES, lane = F.lane;
    const float* mod = (const float*)(F.ws + WS_MOD);
    const bf16_t* x1 = (const bf16_t*)(F.ws + WS_X1); bf16_t* x2 = (bf16_t*)(F.ws + WS_X2); const unsigned char* yb = (const unsigned char*)(F.ws + WS_YBUF); bf16_t* hb = (bf16_t*)(F.ws + WS_H);
    constexpr int TPI = 4;
    auto loadraw = [&](int t2, unsigned (&yw)[TPI][4][4], u32x2 (&xw)[TPI][4]) {
#pragma unroll
        for (int q = 0; q < TPI; ++q) { const size_t tok = (size_t)TPI * t2 + q;
#pragma unroll
            for (int j = 0; j < 4; ++j) { const int k = 4 * lane + 256 * j;
#pragma unroll
                for (int kk = 0; kk < 4; ++kk) yw[q][j][kk] = *(const unsigned*)(yb + (tok * 4 + kk) * D + k);
                xw[q][j] = *(const u32x2*)(x1 + tok * D + k); } } };
    auto process = [&](int t2, const unsigned (&yw)[TPI][4][4], const u32x2 (&xw)[TPI][4]) { const int b = (TPI * t2) / SEQ;
        f32x4 v[TPI][4];
#pragma unroll
        for (int q = 0; q < TPI; ++q)
#pragma unroll
            for (int j = 0; j < 4; ++j) { const int k = 4 * lane + 256 * j; f32x4 s = (f32x4){0.f, 0.f, 0.f, 0.f};
#pragma unroll
                for (int kk = 0; kk < 4; ++kk) { const unsigned w = yw[q][j][kk]; const f32x2 lo = __builtin_amdgcn_cvt_pk_f32_fp8((int)w, false), hi = __builtin_amdgcn_cvt_pk_f32_fp8((int)w, true); s += (f32x4){lo.x, lo.y, hi.x, hi.y}; }
                s = s * 0.0625f;
                const f32x4 g2 = *(const f32x4*)(mod + ((size_t)l * BATCH + b) * 6144 + 5120 + k);
                v[q][j] = (f32x4){bflo(xw[q][j].x), bfhi(xw[q][j].x), bflo(xw[q][j].y), bfhi(xw[q][j].y)} + g2 * s * (l == 0 ? DBG_MOE0 : DBG_MOE1); }
#pragma unroll
        for (int q = 0; q < TPI; ++q) { const size_t tok = (size_t)TPI * t2 + q;
            if (l + 1 < DEPTH) {
#pragma unroll
                for (int j = 0; j < 4; ++j) { u32x2 ow; ow.x = cvtpk(v[q][j].x, v[q][j].y); ow.y = cvtpk(v[q][j].z, v[q][j].w); *(u32x2*)(x2 + tok * D + 4 * lane + 256 * j) = ow; }
                const float* m1 = mod + ((size_t)(l + 1) * BATCH + b) * 6144;
                modnorm_store(v[q], GIN(I_NMIX) + (l + 1) * D, m1 + 1024, m1, hb + tok * D, lane);
            } else {
                float ss = 0.f;
#pragma unroll
                for (int j = 0; j < 4; ++j) ss += (v[q][j].x * v[q][j].x + v[q][j].y * v[q][j].y) + (v[q][j].z * v[q][j].z + v[q][j].w * v[q][j].w);
                const float rstd = 1.0f / sqrtf(wave_sum(ss) * (1.0f / D) + NORM_EPS);
#pragma unroll
                for (int j = 0; j < 4; ++j) { const int k = 4 * lane + 256 * j; *(f32x4*)(F.out + tok * D + k) = v[q][j] * rstd * *(const f32x4*)(GIN(I_FNW) + k); }
            } } };
    int t2 = gw;
    if (t2 < T / TPI) { unsigned ya[TPI][4][4]; u32x2 xa[TPI][4]; loadraw(t2, ya, xa);
        for (;;) { const int t2n = t2 + NGW; const bool hn = t2n < T / TPI; unsigned ybn[TPI][4][4]; u32x2 xbn[TPI][4];
            if (hn) loadraw(t2n, ybn, xbn);
            process(t2, ya, xa);
            if (!hn) break;
            t2 = t2n;
#pragma unroll
            for (int q = 0; q < TPI; ++q)
#pragma unroll
                for (int j = 0; j < 4; ++j) { xa[q][j] = xbn[q][j];
#pragma unroll
                    for (int kk = 0; kk < 4; ++kk) ya[q][j][kk] = ybn[q][j][kk]; } } }
}

constexpr int N_PHASES = 2 + 8 * DEPTH;
struct Args { const float* in[23]; float* out; unsigned char* ws; int ph_lo, ph_hi; };
__global__ void __launch_bounds__(NWAVES * 64, 2) fwd_kernel(Args args) {
    extern __shared__ __attribute__((aligned(16))) unsigned char lds_raw[];
    Frame F;
    F.lds = (LAS unsigned char*)lds_raw;
    F.tid = threadIdx.x; F.lane = F.tid & 63; F.wave = __builtin_amdgcn_readfirstlane(F.tid >> 6);
    const int wv0 = F.wave;
    F.bx = blockIdx.x; F.G = gridDim.x; { const int bx = blockIdx.x; F.vcu = (F.G % 8 == 0) ? (bx % 8) * (F.G / 8) + bx / 8 : bx; }
    F.ws = (unsigned char*)(GAS unsigned char*)args.ws; F.ctl = (gu32*)(F.ws + WS_CTL); F.out = (float*)(GAS float*)args.out;
    F.in = (const CAS PFC*)__builtin_amdgcn_kernarg_segment_ptr();
    volatile LAS unsigned* MISC = (volatile LAS unsigned*)(F.lds + MISC_OFF);
    for (int u = F.tid; u < 256; u += NWAVES * 64) MISC[u] = 0u;
    __syncthreads();
    if (MK_N_LAUNCHES == 1) (void)xcd_barrier_post((unsigned*)(F.ctl + CW_BAR), MISC + 8, F.tid);
    const int lo = (MK_N_LAUNCHES == 1) ? 0 : args.ph_lo, hi = (MK_N_LAUNCHES == 1) ? N_PHASES : args.ph_hi;
#ifndef PH_MASK
#define PH_MASK 0xffff
#endif
#define PHEN(j) (((PH_MASK) >> (j)) & 1)
#define IN(k) (lo <= (k) && (k) < hi)
#define REFRESH() do { int _t = (wv0 << 6) | lane_id(); asm volatile("" : "+v"(_t)); F.tid = _t; F.lane = _t & 63; F.wave = __builtin_amdgcn_readfirstlane(_t >> 6); \
        GAS unsigned char* _w = (GAS unsigned char*)args.ws; asm volatile("" : "+s"(_w)); F.ws = (unsigned char*)_w; F.ctl = (gu32*)(F.ws + WS_CTL);     { const CAS PFC* _p = (const CAS PFC*)__builtin_amdgcn_kernarg_segment_ptr(); asm volatile("" : "+s"(_p)); F.in = _p; }     int _b = blockIdx.x; asm volatile("" : "+s"(_b)); F.bx = _b; } while (0)
#define GRID_BAR(k) do { if (MK_N_LAUNCHES == 1) { XcdBarrier _b; _b.bar = (unsigned*)(F.ctl + CW_BAR); _b.x = xb_xcc_id(); _b.st = (volatile LAS unsigned*)(F.lds + MISC_OFF) + 8; xcd_barrier(_b, (wv0 << 6) | lane_id()); } } while (0)

    if (PHEN(0) && IN(0)) { asm volatile("; PHASE_MARK 0");
#pragma unroll 1
        for (int rep = 0; rep < NREP(0); ++rep) { p0_prologue(F); if (F.bx >= DEPTH * 96) conv_one(F, 0); GRID_BAR(0); } }
    if (PHEN(1) && IN(1)) { asm volatile("; PHASE_MARK 1");
#pragma unroll 1
        for (int rep = 0; rep < NREP(1); ++rep) { p0b_norm(F); p0_convert(F); GRID_BAR(1); } }
#pragma unroll 1
    for (int l = 0; l < DEPTH; ++l) {
        const int pb = 2 + 8 * l;
        const float* mod = (const float*)(F.ws + WS_MOD) + (size_t)l * BATCH * 6144;
        if (PHEN(2) && IN(pb + 0)) { asm volatile("; PHASE_MARK 2");
#pragma unroll 1
          for (int rep = 0; rep < NREP(2); ++rep) { REFRESH();
            pg8::DenseSched S; S.init(F.ws + WS_H, F.ws + WS_WIN + (size_t)l * PP * D * 2, T, PP, D, F.G, F.bx);
            pg8::EpiProj E{(bf16_t*)(F.ws + WS_PROJ), PP};
            pg8::gemm_phase<pg8::EpiProj, pg8::DenseSched, false>(F.lds, D, S, E, F.tid);
            GRID_BAR(pb + 0); }
        }
        if (PHEN(3) && IN(pb + 1)) { asm volatile("; PHASE_MARK 3");
#pragma unroll 1
          for (int rep = 0; rep < NREP(3); ++rep) { REFRESH(); p2a(F, l, rep); GRID_BAR(pb + 1); } }
        if (PHEN(4) && IN(pb + 2)) { asm volatile("; PHASE_MARK 4");
#pragma unroll 1
          for (int rep = 0; rep < NREP(4); ++rep) { REFRESH(); p2b(F, l, rep); GRID_BAR(pb + 2); } }
        if (PHEN(5) && IN(pb + 3)) { asm volatile("; PHASE_MARK 5");
#pragma unroll 1
          for (int rep = 0; rep < NREP(5); ++rep) { REFRESH();
            pg8::DenseSched S; S.init(F.ws + WS_YMIX, F.ws + WS_WOUT + (size_t)l * D * D * 2, T, D, D, F.G, F.bx);
            if (l == 0) { pg8::EpiResGateT<false> E{GIN(I_X), (const bf16_t*)nullptr, (bf16_t*)(F.ws + WS_X1), mod + 2048, DBG_MIX0};
                pg8::gemm_phase<pg8::EpiResGateT<false>, pg8::DenseSched, false>(F.lds, D, S, E, F.tid); }
            else { pg8::EpiResGateT<true> E{(const float*)nullptr, (const bf16_t*)(F.ws + WS_X2), (bf16_t*)(F.ws + WS_X1), mod + 2048, DBG_MIX1};
                pg8::gemm_phase<pg8::EpiResGateT<true>, pg8::DenseSched, false>(F.lds, D, S, E, F.tid); }
            GRID_BAR(pb + 3); }
        }
        if (PHEN(6) && IN(pb + 4)) { asm volatile("; PHASE_MARK 6"); REFRESH(); p4_router(F, l); GRID_BAR(pb + 4); }
        if (PHEN(7) && IN(pb + 5)) { asm volatile("; PHASE_MARK 7");
#pragma unroll 1
          for (int rep = 0; rep < NREP(7); ++rep) {
            REFRESH(); const int nblk = moe_table(F, l);
            pg8::MoeSched<true> S; S.A = (const char*)(F.ws + WS_H8); S.Bt = (const char*)(F.ws + WS_WGU + (size_t)l * NE * 2048 * D); S.K = D; S.nN = 8; S.G = F.G; S.c = F.bx; S.total = nblk * 8; S.lj_in = F.lane & 31;
            S.tab = (const LAS int*)(F.lds + MISC_OFF + 1536); S.slot = (const i32x2*)(F.ws + WS_SLOT);
            pg8::EpiSwiGLU E{(unsigned char*)(F.ws + WS_ACT), GIN(I_BGU) + (size_t)l * NE * 2048};
            pg8::gemm_phase<pg8::EpiSwiGLU, pg8::MoeSched<true>, true, true>(F.lds, D, S, E, F.tid);
            if (l + 1 < DEPTH && rep == 0 && (F.G % 64) == 0) {
                const int BR = F.G / 8, off = (F.bx & 7) * (BR >> 3) + (F.bx >> 3) / 8;
                if ((nblk > off ? (nblk - off + BR - 1) / BR : 0) < (nblk + BR - 1) / BR) conv_one(F, l + 1, true); }
            GRID_BAR(pb + 5); }
        }
        if (PHEN(8) && IN(pb + 6)) { asm volatile("; PHASE_MARK 8");
#pragma unroll 1
          for (int rep = 0; rep < NREP(8); ++rep) {
            REFRESH(); const int nblk = moe_table(F, l);
            pg8::MoeSched<false> S; S.A = (const char*)(F.ws + WS_ACT); S.Bt = (const char*)(F.ws + WS_WDN + (size_t)l * NE * D * FF); S.K = FF; S.nN = 4; S.G = F.G; S.c = F.bx; S.total = nblk * 4; S.lj_in = F.lane & 31;
            S.tab = (const LAS int*)(F.lds + MISC_OFF + 1536); S.slot = (const i32x2*)(F.ws + WS_SLOT);
            pg8::EpiDown E{(unsigned char*)(F.ws + WS_YBUF), GIN(I_BDN) + (size_t)l * NE * D, (const i32x2*)(F.ws + WS_SLOT)};
            pg8::gemm_phase<pg8::EpiDown, pg8::MoeSched<false>, false, true>(F.lds, FF, S, E, F.tid);
            if (l + 1 < DEPTH && rep == 0 && (F.G % 64) == 0) {
                const int BR = F.G / 4, off = (F.bx & 7) * (BR >> 3) + (F.bx >> 3) / 4;
                if ((nblk > off ? (nblk - off + BR - 1) / BR : 0) < (nblk + BR - 1) / BR) conv_one(F, l + 1, true); }
            GRID_BAR(pb + 6); }
        }
        if (PHEN(9) && IN(pb + 7)) { asm volatile("; PHASE_MARK 9");
#pragma unroll 1
          for (int rep = 0; rep < NREP(9); ++rep) { REFRESH(); p7_combine(F, l); if (l + 1 < DEPTH || rep + 1 < NREP(9)) GRID_BAR(pb + 7); } }
    }
#undef IN
#undef GRID_BAR
}

extern "C" void kernel_launch(void* const* d_in, const int* in_sizes, int n_in, void* d_out, int out_size, void* d_ws, size_t ws_size, hipStream_t stream) {
    static int grid = 0;
    if (grid == 0) {
        if (n_in != 23 || out_size != T * D || ws_size < WS_END) { fprintf(stderr, "kernel_launch: unexpected shapes (n_in %d, out %d, ws %zu)\n", n_in, out_size, ws_size); grid = -1; return; }
        int dev = 0, cus = 0, per_cu = 0;
        if (hipGetDevice(&dev) != hipSuccess || hipDeviceGetAttribute(&cus, hipDeviceAttributeMultiprocessorCount, dev) != hipSuccess) { grid = -1; return; }
        if (hipFuncSetAttribute((const void*)fwd_kernel, hipFuncAttributeMaxDynamicSharedMemorySize, LDS_BYTES) != hipSuccess) { fprintf(stderr, "kernel_launch: hipFuncSetAttribute failed\n"); grid = -1; return; }
        if (hipOccupancyMaxActiveBlocksPerMultiprocessor(&per_cu, (const void*)fwd_kernel, NWAVES * 64, LDS_BYTES) != hipSuccess || per_cu < 1) { fprintf(stderr, "kernel_launch: occupancy query says %d\n", per_cu); }
        (void)hipGetLastError();
        grid = cus;
    }
    if (grid < 0) return;
    (void)hipMemsetAsync((char*)d_ws + WS_CTL, 0, CTL_ZERO_BYTES, stream);
    Args a{};
    for (int i = 0; i < 23; ++i) a.in[i] = (const float*)d_in[i];
    a.out = (float*)d_out; a.ws = (unsigned char*)d_ws;
    if (MK_N_LAUNCHES == 1) { a.ph_lo = 0; a.ph_hi = N_PHASES; hipLaunchKernelGGL(fwd_kernel, dim3(grid), dim3(NWAVES * 64), LDS_BYTES, stream, a); }
    else for (int p = 0; p < N_PHASES; ++p) { a.ph_lo = p; a.ph_hi = p + 1; hipLaunchKernelGGL(fwd_kernel, dim3(grid), dim3(NWAVES * 64), LDS_BYTES, stream, a); }
}
```

```cpp
#include <hip/hip_runtime.h>
#include <cstdio>
#include <cstdint>
#include <cmath>
#include <type_traits>

#ifndef MK_N_LAUNCHES
#define MK_N_LAUNCHES 1
#endif

#ifndef DBG_REP_PHASE
#define DBG_REP_PHASE -1
#endif
#ifndef DBG_REP_N
#define DBG_REP_N 2
#endif
#define NREP(j) ((DBG_REP_PHASE) == (j) ? (DBG_REP_N) : 1)
#ifndef DBG_MIX0
#define DBG_MIX0 1.0f
#endif
#ifndef DBG_MIX1
#define DBG_MIX1 1.0f
#endif
#ifndef DBG_MOE0
#define DBG_MOE0 1.0f
#endif
#ifndef DBG_MOE1
#define DBG_MOE1 1.0f
#endif
#define GAS __attribute__((address_space(1)))
#define LAS __attribute__((address_space(3)))
typedef unsigned short bf16_t;
typedef short bf16x8 __attribute__((ext_vector_type(8)));
typedef short s16x4 __attribute__((ext_vector_type(4)));
typedef short v4i16_t __attribute__((ext_vector_type(4)));
typedef float f32x4 __attribute__((ext_vector_type(4)));
typedef float f32x2 __attribute__((ext_vector_type(2)));
typedef unsigned u32x4 __attribute__((ext_vector_type(4)));
typedef unsigned u32x2 __attribute__((ext_vector_type(2)));
typedef int i32x2 __attribute__((ext_vector_type(2)));
typedef int i32x8 __attribute__((ext_vector_type(8)));
typedef GAS unsigned gu32;

constexpr int D = 1024, BATCH = 8, SEQ = 2048, T = BATCH * SEQ, DEPTH = 2;
constexpr int INW = 2944, PP = 3072;
constexpr int C_RQ = 0, C_RK = 256, C_RV = 512, C_RG = 768, C_MQ = 1024, C_MK = 1408, C_MV = 1792, C_LX = 2176, C_LG = 2560;
constexpr int Y_RET = 0, Y_MOBA = 256, Y_LRU = 640;
constexpr int NE = 32, FF = 1024, CAP = 16384;
constexpr int LCH = 128, NLCH = SEQ / LCH;
constexpr float NORM_EPS = 1e-6f;

constexpr size_t MiB = 1u << 20;
constexpr size_t WS_CTL = 0, CTL_ZERO_BYTES = 1 * MiB;
constexpr size_t WS_MOD = 1 * MiB;
constexpr size_t WS_ROT = 2 * MiB;
constexpr size_t WS_LRUSUM = 3 * MiB;
constexpr size_t WS_KMEAN = 4 * MiB;
constexpr size_t WS_SLOT = 5 * MiB;
constexpr size_t WS_GATE = 9 * MiB;
constexpr size_t WS_WIN = 10 * MiB;
constexpr size_t WS_WOUT = 22 * MiB;
constexpr size_t WS_RWT = 26 * MiB;
constexpr size_t WS_WGU = 32 * MiB;
constexpr size_t WS_WDN = 288 * MiB;
constexpr size_t WS_H = 416 * MiB;
constexpr size_t WS_PROJ = 448 * MiB;
constexpr size_t WS_YMIX = 544 * MiB;
constexpr size_t WS_X1 = 576 * MiB;
constexpr size_t WS_X2 = 640 * MiB;
constexpr size_t WS_ACT = 704 * MiB;
constexpr size_t WS_YBUF = 848 * MiB;
constexpr size_t WS_LRUH = 976 * MiB;
constexpr size_t WS_LRUA = 992 * MiB;
constexpr size_t WS_H8 = 1008 * MiB;
constexpr size_t WS_END = 1024 * MiB;
constexpr int CW_TMO = 0, CW_CODE = 1;
constexpr int CW_BAR = 4096;
constexpr int CW_CNT = 8192;
constexpr int CW_Q = 8192 + 256;

constexpr int RING_BYTES = 131072;
constexpr int MISC_OFF = RING_BYTES;
constexpr int LDS_BYTES = 147456;
constexpr int NWAVES = 8;

#define RLX_AGENT __ATOMIC_RELAXED, __HIP_MEMORY_SCOPE_AGENT
#define LDS_WAIT() asm volatile("s_waitcnt lgkmcnt(0)" ::: "memory")
#define VM_WAIT() asm volatile("s_waitcnt vmcnt(0)" ::: "memory")

__device__ __forceinline__ unsigned f2bf(float f) { unsigned u = __builtin_bit_cast(unsigned, f); return (u + 0x7fffu + ((u >> 16) & 1u)) >> 16; }
__device__ __forceinline__ unsigned pk2(float lo, float hi) { return f2bf(lo) | (f2bf(hi) << 16); }
__device__ __forceinline__ unsigned cvtpk(float lo, float hi) { typedef __bf16 bf2_t __attribute__((ext_vector_type(2))); f32x2 v = {lo, hi}; bf2_t b = __builtin_convertvector(v, bf2_t); return __builtin_bit_cast(unsigned, b); }
__device__ __forceinline__ unsigned cvt4_fp8(float a, float b, float c, float d) { int w = 0; w = __builtin_amdgcn_cvt_pk_fp8_f32(a, b, w, false); w = __builtin_amdgcn_cvt_pk_fp8_f32(c, d, w, true); return (unsigned)w; }
__device__ __forceinline__ float sat448(float x) { return __builtin_amdgcn_fmed3f(x, -448.0f, 448.0f); }
__device__ __forceinline__ unsigned cvt4_fp8_sat(float a, float b, float c, float d) { return cvt4_fp8(sat448(a), sat448(b), sat448(c), sat448(d)); }
__device__ __forceinline__ float ex2(float x) { return __builtin_amdgcn_exp2f(x); }
__device__ __forceinline__ float fexp(float x) { return __builtin_amdgcn_exp2f(x * 1.4426950408889634f); }
__device__ __forceinline__ float frcp(float x) { return __builtin_amdgcn_rcpf(x); }
__device__ __forceinline__ float bf2f(unsigned short b) { return __builtin_bit_cast(float, ((unsigned)b) << 16); }
__device__ __forceinline__ float bflo(unsigned w) { return __builtin_bit_cast(float, w << 16); }
__device__ __forceinline__ float bfhi(unsigned w) { return __builtin_bit_cast(float, w & 0xffff0000u); }
__device__ __forceinline__ int lane_id() { int l; asm volatile("v_mbcnt_lo_u32_b32 %0, -1, 0\n\tv_mbcnt_hi_u32_b32 %0, -1, %0" : "=v"(l)); return l; }
__device__ __forceinline__ float wave_sum(float v) {
#pragma unroll
    for (int o = 1; o < 64; o <<= 1) v += __shfl_xor(v, o);
    return v;
}

namespace pg8 {
constexpr int BM = 256, BK = 64, HALF = 128, HTB = HALF * BK * 2, STAGE_BYTES = 8 * HTB, NXCD = 8, WGM = 8;
__host__ __device__ __forceinline__ int lds_byte(int r, int c) { const int st = (r >> 4) * 2 + (c >> 5), rr = r & 15, cc = c & 31, ob = rr * 64 + cc * 2; return st * 1024 + (ob ^ (((ob >> 9) & 1) << 5)); }
__host__ __device__ __forceinline__ void stage_rc(int b, int& R, int& C) { const int st = b / 1024, sb = b % 1024, swz = sb ^ (((sb >> 9) & 1) << 5); R = (st >> 1) * 16 + swz / 64; C = (st & 1) * 32 + (swz % 64) / 2; }
__host__ __device__ __forceinline__ int perm32(int rho) { const int n = rho >> 4, i = rho & 15; return 8 * (i >> 2) + 4 * n + (i & 3); }

struct Unit { int pm, pn, e, srow, nv; };

__device__ __forceinline__ unsigned cvt_pk_bf16(float lo, float hi) { unsigned r; asm volatile("v_cvt_pk_bf16_f32 %0, %1, %2" : "=v"(r) : "v"(lo), "v"(hi)); return r; }

struct DenseSched {
    const char* A; const char* Bt; int K; int nM, nN, nwg, G, c;
    __device__ __forceinline__ void init(const void* A_, const void* Bt_, int M, int N, int K_, int G_, int c_) { A = (const char*)A_; Bt = (const char*)Bt_; K = K_; nM = M / BM; nN = N / BM; nwg = nM * nN; G = G_; c = c_; }
    __device__ __forceinline__ bool next(int i, Unit& u) const {
        const long L = (long)i * G + c; if (L >= nwg) return false;
        int wgid = (int)L; { const int q = nwg / NXCD, r = nwg % NXCD, xcd = wgid % NXCD, off = wgid / NXCD; wgid = (xcd < r ? xcd * (q + 1) : r * (q + 1) + (xcd - r) * q) + off; }
        const int nig = WGM * nN, gid = wgid / nig, fm = gid * WGM, gsz = (nM - fm) < WGM ? (nM - fm) : WGM;
        u.pm = fm + ((wgid % nig) % gsz); u.pn = (wgid % nig) / gsz; u.e = 0; u.srow = 0; u.nv = BM; return true;
    }
    __device__ __forceinline__ const char* a_base(const Unit& u) const { return A + (size_t)u.pm * (size_t)BM * K * 2; }
    __device__ __forceinline__ const char* b_base(const Unit& u) const { return Bt + (size_t)u.pn * (size_t)BM * K * 2; }
    __device__ __forceinline__ void a_offs(const Unit&, unsigned (&)[4], const int (&)[2], const int (&)[2]) const {}
};
template <bool GATHER> struct MoeSched {
    const char* A; const char* Bt; int K  , nN, G, c, total, lj_in  ; const LAS int* tab; const i32x2* slot;
    __device__ __forceinline__ bool next(int i, Unit& u) const {
        int blk;
        if ((G % (8 * nN)) == 0) {
            const int BR = G / nN, bpx = BR >> 3, xcd = c & 7, slot = c >> 3;
            blk = i * BR + xcd * bpx + slot / nN; u.pn = slot % nN; if (blk * nN >= total) return false;
        } else { const int L = i * G + c; if (L >= total) return false; blk = L / nN; u.pn = L - blk * nN; }
        u.pm = blk;
        const int lj = lane_id() & 31;
        const unsigned long long bal = __ballot(lj >= 1 && tab[lj] <= blk);
        const int e = __builtin_popcount((unsigned)(bal & 0xffffffffull));
        const int rb = blk - __builtin_amdgcn_readfirstlane(tab[e]); const int cn = __builtin_amdgcn_readfirstlane(tab[33 + e]);
        u.e = e; u.srow = e * CAP + rb * BM; const int rem = cn - rb * BM; u.nv = rem < BM ? rem : BM; return true;
    }
    __device__ __forceinline__ const char* a_base(const Unit& u) const { return GATHER ? A : A + (size_t)u.pm * (size_t)BM * K; }
    __device__ __forceinline__ const char* b_base(const Unit& u) const { return Bt + ((size_t)u.e * nN + u.pn) * (size_t)BM * K; }
    __device__ __forceinline__ void a_offs(const Unit& u, unsigned (&vo)[4], const int (&R)[2], const int (&C)[2]) const {
#pragma unroll
        for (int h = 0; h < 2; ++h)
#pragma unroll
            for (int i = 0; i < 2; ++i) { const int r = h * HALF + R[i]; int ent = 0; if (r < u.nv) ent = slot[u.srow + r].x; vo[h * 2 + i] = (unsigned)(ent >> 2) * (unsigned)K + (unsigned)(C[i] * 2); }
    }
};

struct EpiProj { static constexpr bool PREFETCH = false; static constexpr bool BIAS_LDS = false;
    static constexpr int PERM = 4;
    bf16_t* O; int ldc; const float* rot;
    __device__ __forceinline__ void operator()(const f32x4 (&acc)[2][2][4][2], const Unit& u, int wr, int wc, int fr, int fq) const {
        const int row0 = u.pm * BM + wr * 64 + fr, col0 = u.pn * BM + wc * 64 + 8 * fq;
        const bool rotary = u.pn < 2;
        const float sc = u.pn == 1 ? 0.125f : 1.0f;
#pragma unroll
        for (int ai = 0; ai < 2; ++ai)
#pragma unroll
            for (int m = 0; m < 4; ++m) { const int row = row0 + ai * HALF + m * 16; bf16_t* rowp = O + (size_t)row * ldc + col0;
                f32x4 lo[2] = {acc[ai][0][m][0], acc[ai][0][m][1]}, hi[2] = {acc[ai][1][m][0], acc[ai][1][m][1]};
                if (rotary) { const float* cp = rot + (size_t)(row % SEQ) * 32 + 8 * fq;
#pragma unroll
                    for (int n = 0; n < 2; ++n) { const f32x4 c = *(const f32x4*)(cp + 4 * n), sn = *(const f32x4*)(cp + SEQ * 32 + 4 * n);
                        const f32x4 y1 = (lo[n] * c - hi[n] * sn) * sc, y2 = (hi[n] * c + lo[n] * sn) * sc; lo[n] = y1; hi[n] = y2; } }
                u32x4 w0, w1;
                w0.x = cvt_pk_bf16(lo[0][0], lo[0][1]); w0.y = cvt_pk_bf16(lo[0][2], lo[0][3]); w0.z = cvt_pk_bf16(lo[1][0], lo[1][1]); w0.w = cvt_pk_bf16(lo[1][2], lo[1][3]);
                w1.x = cvt_pk_bf16(hi[0][0], hi[0][1]); w1.y = cvt_pk_bf16(hi[0][2], hi[0][3]); w1.z = cvt_pk_bf16(hi[1][0], hi[1][1]); w1.w = cvt_pk_bf16(hi[1][2], hi[1][3]);
                *(u32x4*)rowp = w0; *(u32x4*)(rowp + 32) = w1; }
    }
};
template <bool IN16> struct EpiResGateT { static constexpr bool PREFETCH = false; static constexpr bool BIAS_LDS = false;
    static constexpr bool PERM = true;
    const float* xin32; const bf16_t* xin16; bf16_t* out; const float* gate; float dbg;
    __device__ __forceinline__ void operator()(const f32x4 (&acc)[2][2][4][2], const Unit& u, int wr, int wc, int fr, int fq) const {
        const int row0 = u.pm * BM + wr * 64 + fr, col0 = u.pn * BM + wc * 32 + 8 * fq; const int b = (u.pm * BM) / SEQ;
        f32x4 gv[2][2];
#pragma unroll
        for (int bj = 0; bj < 2; ++bj)
#pragma unroll
            for (int n = 0; n < 2; ++n) gv[bj][n] = *(const f32x4*)(gate + (size_t)b * 6144 + col0 + bj * HALF + n * 4) * dbg;
        constexpr int MB = IN16 ? 4 : 2;
#pragma unroll
        for (int ai = 0; ai < 2; ++ai)
#pragma unroll
          for (int m0 = 0; m0 < 4; m0 += MB) {
            u32x4 xw[MB][2]; f32x4 xf[MB][2][2];
#pragma unroll
            for (int mm = 0; mm < MB; ++mm) { const size_t off = (size_t)(row0 + ai * HALF + (m0 + mm) * 16) * D + col0;
#pragma unroll
                for (int bj = 0; bj < 2; ++bj) {
                    if constexpr (!IN16) { xf[mm][bj][0] = *(const f32x4*)(xin32 + off + bj * HALF); xf[mm][bj][1] = *(const f32x4*)(xin32 + off + bj * HALF + 4); }
                    else xw[mm][bj] = *(const u32x4*)(xin16 + off + bj * HALF); } }
#pragma unroll
            for (int mm = 0; mm < MB; ++mm) { const int m = m0 + mm; const size_t off = (size_t)(row0 + ai * HALF + m * 16) * D + col0;
#pragma unroll
                for (int bj = 0; bj < 2; ++bj) { f32x4 x0, x1;
                    if constexpr (!IN16) { x0 = xf[mm][bj][0]; x1 = xf[mm][bj][1]; }
                    else { const u32x4 w = xw[mm][bj]; x0 = (f32x4){bflo(w.x), bfhi(w.x), bflo(w.y), bfhi(w.y)}; x1 = (f32x4){bflo(w.z), bfhi(w.z), bflo(w.w), bfhi(w.w)}; }
                    const f32x4 o0 = x0 + gv[bj][0] * acc[ai][bj][m][0], o1 = x1 + gv[bj][1] * acc[ai][bj][m][1];
                    u32x4 ow; ow.x = cvt_pk_bf16(o0[0], o0[1]); ow.y = cvt_pk_bf16(o0[2], o0[3]); ow.z = cvt_pk_bf16(o1[0], o1[1]); ow.w = cvt_pk_bf16(o1[2], o1[3]);
                    *(u32x4*)(out + off + bj * HALF) = ow; } }
            asm volatile("" ::: "memory"); }
    }
};
struct EpiSwiGLU { static constexpr bool PREFETCH = false; static constexpr bool BIAS_LDS = true;
    static constexpr bool PERM = true;
    unsigned char* O; const float* bgu;
    __device__ __forceinline__ const float* bias_src(const Unit& u, int lane) const { return bgu + (size_t)u.e * 2048 + u.pn * HALF + (lane < 32 ? lane * 4 : 1024 + (lane - 32) * 4); }
    __device__ __forceinline__ void operator()(const f32x4 (&acc)[2][2][4][2], const Unit& u, int wr, int wc, int fr, int fq, const LAS float* bl) const {
        const int row0 = u.pm * BM + wr * 64 + fr, jc0 = u.pn * HALF + wc * 32 + 8 * fq;
        f32x4 bg[2], bu[2];
#pragma unroll
        for (int n = 0; n < 2; ++n) { bg[n] = *(const LAS f32x4*)(bl + wc * 32 + 8 * fq + 4 * n); bu[n] = *(const LAS f32x4*)(bl + 128 + wc * 32 + 8 * fq + 4 * n); }
#pragma unroll
        for (int ai = 0; ai < 2; ++ai)
#pragma unroll
            for (int m = 0; m < 4; ++m) { float a[8];
#pragma unroll
                for (int n = 0; n < 2; ++n)
#pragma unroll
                    for (int jp = 0; jp < 2; ++jp) {
                        const f32x2 ag = {acc[ai][0][m][n][2 * jp], acc[ai][0][m][n][2 * jp + 1]}, au = {acc[ai][1][m][n][2 * jp], acc[ai][1][m][n][2 * jp + 1]};
                        const f32x2 bgp = {bg[n][2 * jp], bg[n][2 * jp + 1]}, bup = {bu[n][2 * jp], bu[n][2 * jp + 1]};
                        f32x2 g = ag * 0.03125f + bgp, up = au * 0.03125f + bup;
                        g.x = fminf(g.x, 7.0f); g.y = fminf(g.y, 7.0f); up.x = __builtin_amdgcn_fmed3f(up.x, -7.0f, 7.0f); up.y = __builtin_amdgcn_fmed3f(up.y, -7.0f, 7.0f);
                        const f32x2 z = g * (-1.702f * 1.4426950408889634f);
                        f32x2 d; d.x = __builtin_amdgcn_exp2f(z.x); d.y = __builtin_amdgcn_exp2f(z.y); d = d + 1.0f;
                        f32x2 sg; sg.x = __builtin_amdgcn_rcpf(d.x); sg.y = __builtin_amdgcn_rcpf(d.y);
                        const f32x2 r = (up + 1.0f) * g * sg; a[n * 4 + 2 * jp] = r.x; a[n * 4 + 2 * jp + 1] = r.y; }
                u32x2 w; w.x = cvt4_fp8(a[0], a[1], a[2], a[3]); w.y = cvt4_fp8(a[4], a[5], a[6], a[7]);
                *(u32x2*)(O + (size_t)(row0 + ai * HALF + m * 16) * FF + jc0) = w; }
    }
};
struct EpiDown { static constexpr bool PREFETCH = true; static constexpr bool BIAS_LDS = true;
    static constexpr int PERM = 2;
    unsigned char* Y; const float* bdn; const i32x2* slot;
    __device__ __forceinline__ void pre1(const Unit& u, int wr, int fr, unsigned (&pk)[8]) const {
#pragma unroll
        for (int i = 0; i < 8; ++i) { const int r = (i >> 2) * HALF + wr * 64 + (i & 3) * 16 + fr; i32x2 ent = {0, 0}; if (r < u.nv) ent = slot[u.srow + r];
            const int ex = ent.x, ey = ent.y;
            pk[i] = (cvtpk(0.f, __builtin_bit_cast(float, ey)) & 0xffff0000u) | ((unsigned)ex & 0xffffu); }
    }
    __device__ __forceinline__ const float* bias_src(const Unit& u, int lane) const { return bdn + (size_t)u.e * 1024 + u.pn * BM + lane * 4; }
    __device__ __forceinline__ void operator()(const f32x4 (&acc)[2][2][4][2], const Unit& u, int wr, int wc, int fr, int fq, const unsigned (&pk)[8], const LAS float* bl) const {
        const int col0 = u.pn * BM + wc * 64 + 16 * fq;
        f32x4 bv[2][2];
#pragma unroll
        for (int bj = 0; bj < 2; ++bj)
#pragma unroll
            for (int n = 0; n < 2; ++n) bv[bj][n] = *(const LAS f32x4*)(bl + wc * 64 + 16 * fq + 8 * bj + 4 * n);
#pragma unroll
        for (int ai = 0; ai < 2; ++ai)
#pragma unroll
            for (int m = 0; m < 4; ++m) { const unsigned e = pk[ai * 4 + m];
                if ((e >> 16) != 0u) { const float g = __builtin_bit_cast(float, e & 0xffff0000u) * 16.0f; unsigned char* rowp = Y + (size_t)(e & 0xffffu) * D + col0;
                    u32x4 w;
#pragma unroll
                    for (int bj = 0; bj < 2; ++bj) { const f32x4 v0 = (acc[ai][bj][m][0] * 0.03125f + bv[bj][0]) * g, v1 = (acc[ai][bj][m][1] * 0.03125f + bv[bj][1]) * g;
                        w[2 * bj] = cvt4_fp8_sat(v0[0], v0[1], v0[2], v0[3]); w[2 * bj + 1] = cvt4_fp8_sat(v1[0], v1[1], v1[2], v1[3]); }
                    *(u32x4*)rowp = w; } }
    }
};

template <class Epi, class Sched, bool GATHER, bool F8 = false>
__device__ __forceinline__ void gemm_phase(LAS unsigned char* lds, const int K, const Sched& S, const Epi& E, const int tid_in) {
    int tz = tid_in; asm volatile("" : "+v"(tz));
    const int tid = tz, wid = __builtin_amdgcn_readfirstlane(tid >> 6), lane = tid & 63, wr = wid >> 2, wc = wid & 3, fr = lane & 15, fq = lane >> 4;
    const int RB = F8 ? K : 2 * K;
    int nt = RB / 128; asm volatile("" : "+s"(nt));
    int Rr[2], Cc[2]; unsigned voffB[2], voffC[4], voffN[4];
#pragma unroll
    for (int i = 0; i < 2; ++i) { int R, C; stage_rc(tid * 16 + i * 8192, R, C); Rr[i] = R; Cc[i] = C; const int Rb = (int)Epi::PERM == 4 ? (64 * ((R >> 5) & 3) + 8 * ((R >> 2) & 3) + 4 * ((R >> 4) & 1) + (R & 3))   : (int)Epi::PERM == 2 ? (64 * ((R >> 5) & 3) + 16 * ((R >> 2) & 3) + 4 * ((R >> 4) & 1) + (R & 3)) : Epi::PERM ? ((R & ~31) + perm32(R & 31)) : R;
        voffB[i] = (unsigned)(Rb * RB + C * 2); voffC[i] = (unsigned)(R * RB + C * 2); voffC[2 + i] = (unsigned)((R + HALF) * RB + C * 2); }
#pragma unroll
    for (int i = 0; i < 4; ++i) voffN[i] = voffC[i];
    const size_t kstep = (size_t)(BK * 2);
    const size_t hstep = (size_t)((int)Epi::PERM == 2 ? 8 : (int)Epi::PERM == 4 ? 32 : HALF) * RB;
    const unsigned ldsw = (unsigned)wid * 1024u;
    unsigned aoff = (unsigned)lds_byte(wr * 64 + fr, fq * (F8 ? 16 : 8)), boff = 65536u + (unsigned)lds_byte(wc * 32 + fr, fq * (F8 ? 16 : 8));
    asm volatile("" : "+v"(aoff), "+v"(boff));
    unsigned aoff1 = aoff, boff1 = boff;
    if constexpr (F8) { aoff += 16u * (unsigned)(fq & 1); boff += 16u * (unsigned)(fq & 1); aoff1 = aoff ^ 16u; boff1 = boff ^ 16u; asm volatile("" : "+v"(aoff), "+v"(boff), "+v"(aoff1), "+v"(boff1)); }
#define PG8_SA(b, h) (((b) * 2 + (h)) * HTB)
#define PG8_SB(b, h) ((4 + (b) * 2 + (h)) * HTB)
#define PG8_SBR(b, h) (((b) * 2 + (h)) * HTB)
#define PG8_STAGE_B(bufoff, gbase) do { _Pragma("unroll") for (int _i = 0; _i < 2; ++_i) \
        __builtin_amdgcn_global_load_lds((const unsigned*)((const char*)(gbase) + voffB[_i]), (LAS unsigned*)(lds + (bufoff) + ldsw + _i * 8192), 16, 0, 0); } while (0)
#define PG8_STAGE_A(bufoff, gbase, o0, o1) do { \
        __builtin_amdgcn_global_load_lds((const unsigned*)((const char*)(gbase) + (o0)), (LAS unsigned*)(lds + (bufoff) + ldsw), 16, 0, 0); \
        __builtin_amdgcn_global_load_lds((const unsigned*)((const char*)(gbase) + (o1)), (LAS unsigned*)(lds + (bufoff) + ldsw + 8192), 16, 0, 0); } while (0)
#define PG8_RD16(off) (*(const LAS u32x4*)(lds + (off)))
#define PG8_MK8(x0, x1) ((i32x8){(int)(x0).x, (int)(x0).y, (int)(x0).z, (int)(x0).w, (int)(x1).x, (int)(x1).y, (int)(x1).z, (int)(x1).w})
#define PG8_LDA(dst, b, h) do { _Pragma("unroll") for (int m = 0; m < 4; ++m) { \
        if constexpr (F8) { const u32x4 _x0 = PG8_RD16(aoff + (PG8_SA(b, h) + m * 2048)), _x1 = PG8_RD16(aoff1 + (PG8_SA(b, h) + m * 2048)); dst##8[m] = PG8_MK8(_x0, _x1); } \
        else { _Pragma("unroll") for (int k = 0; k < 2; ++k) dst[m][k] = *(const LAS bf16x8*)(lds + aoff + (PG8_SA(b, h) + m * 2048 + k * 1024)); } } } while (0)
#define PG8_LDB(dst, b, h) do { _Pragma("unroll") for (int n = 0; n < 2; ++n) { \
        if constexpr (F8) { const u32x4 _x0 = PG8_RD16(boff + (PG8_SBR(b, h) + n * 2048)), _x1 = PG8_RD16(boff1 + (PG8_SBR(b, h) + n * 2048)); dst##8[n] = PG8_MK8(_x0, _x1); } \
        else { _Pragma("unroll") for (int k = 0; k < 2; ++k) dst[n][k] = *(const LAS bf16x8*)(lds + boff + (PG8_SBR(b, h) + n * 2048 + k * 1024)); } } } while (0)
#define PG8_MMA(ai, bj, At, Bt) do { __builtin_amdgcn_s_setprio(1); _Pragma("unroll") for (int m = 0; m < 4; ++m) _Pragma("unroll") for (int n = 0; n < 2; ++n) { \
        if constexpr (F8) asm volatile("v_mfma_scale_f32_16x16x128_f8f6f4 %0, %1, %2, %0, %3, %3 op_sel_hi:[0,0,0]" : "+v"(acc[ai][bj][m][n]) : "v"(Bt##8[n]), "v"(At##8[m]), "v"(f8scale));   \
        else { _Pragma("unroll") for (int k = 0; k < 2; ++k) acc[ai][bj][m][n] = __builtin_amdgcn_mfma_f32_16x16x32_bf16(Bt[n][k], At[m][k], acc[ai][bj][m][n], 0, 0, 0); } } \
        __builtin_amdgcn_s_setprio(0); } while (0)
#define PG8_WAIT_V(n) asm volatile("s_waitcnt vmcnt(" #n ")" ::: "memory")
#define PG8_WAIT_L(n) asm volatile("s_waitcnt lgkmcnt(" #n ")" ::: "memory")
#define PG8_BAR __builtin_amdgcn_s_barrier()
#define PG8_SCHED __builtin_amdgcn_sched_barrier(0)
    Unit cur, nxt; int ui = 0;
    if (!S.next(0, cur)) return;
    f32x4 acc[2][2][4][2];
#pragma unroll
    for (int a = 0; a < 2; ++a)
#pragma unroll
        for (int b = 0; b < 2; ++b)
#pragma unroll
            for (int m = 0; m < 4; ++m)
#pragma unroll
                for (int n = 0; n < 2; ++n) acc[a][b][m][n] = (f32x4){0.f, 0.f, 0.f, 0.f};
    int f8scale = 0x7f7f7f7f; asm volatile("" : "+v"(f8scale));
    bf16x8 At[4][2], B0[2][2], B1[2][2]; i32x8 At8[4], B08[2], B18[2];
    const char* cA = S.a_base(cur); const char* cB = S.b_base(cur);
    if constexpr (GATHER) S.a_offs(cur, voffC, Rr, Cc);
    unsigned epk[8];
    if constexpr (Epi::PREFETCH) E.pre1(cur, wr, fr, epk);
    LAS unsigned char* const bias_lds = lds + MISC_OFF + 8192;
    if constexpr (Epi::BIAS_LDS) { if (wid == 0) __builtin_amdgcn_global_load_lds((const unsigned*)E.bias_src(cur, lane_id()), (LAS unsigned*)bias_lds, 16, 0, 0); }
    PG8_STAGE_B(PG8_SB(0, 0), cB); PG8_STAGE_B(PG8_SB(0, 1), cB + hstep); PG8_STAGE_A(PG8_SA(0, 0), cA, voffC[0], voffC[1]); PG8_STAGE_A(PG8_SA(0, 1), cA, voffC[2], voffC[3]);
    if (wr == 1) PG8_BAR;
    PG8_WAIT_V(2); PG8_BAR;
    PG8_STAGE_B(PG8_SB(1, 0), cB + kstep); PG8_STAGE_A(PG8_SA(1, 0), cA + kstep, voffC[0], voffC[1]); PG8_STAGE_B(PG8_SB(1, 1), cB + hstep + kstep);
    PG8_WAIT_V(6); PG8_BAR;
    for (;;) {
        const bool has_next = S.next(ui + 1, nxt);
        const char* nA = has_next ? S.a_base(nxt) : cA; const char* nB = has_next ? S.b_base(nxt) : cB;
        if constexpr (GATHER) { if (has_next) S.a_offs(nxt, voffN, Rr, Cc); else {
#pragma unroll
            for (int i = 0; i < 4; ++i) voffN[i] = voffC[i]; } }
#pragma unroll 1
        for (int t = 0; t < nt; t += 2) {
            const bool last = (t == nt - 2);
            const char* a1 = cA + (size_t)(t + 1) * kstep;
            const char* a2 = last ? nA : cA + (size_t)(t + 2) * kstep; const char* b2 = last ? nB : cB + (size_t)(t + 2) * kstep;
            const char* a3 = a2 + kstep; const char* b3 = b2 + kstep;
            unsigned o2[4];
#pragma unroll
            for (int i = 0; i < 4; ++i) o2[i] = GATHER ? (last ? voffN[i] : voffC[i]) : voffC[i];
            PG8_LDB(B0, 0, 0); PG8_LDB(B1, 0, 1); PG8_SCHED; PG8_LDA(At, 0, 0); PG8_STAGE_A(PG8_SA(1, 1), a1, voffC[2], voffC[3]);
            PG8_WAIT_V(8); PG8_WAIT_L(0); PG8_BAR; PG8_MMA(0, 0, At, B0); PG8_MMA(0, 1, At, B1); PG8_BAR; PG8_SCHED;
            PG8_LDA(At, 0, 1); PG8_STAGE_B(PG8_SB(0, 0), b2); PG8_STAGE_B(PG8_SB(0, 1), b2 + hstep); PG8_STAGE_A(PG8_SA(0, 0), a2, o2[0], o2[1]);
            PG8_WAIT_V(8); PG8_WAIT_L(0); PG8_BAR; PG8_MMA(1, 0, At, B0); PG8_MMA(1, 1, At, B1); PG8_BAR; PG8_SCHED;
            PG8_LDB(B0, 1, 0); PG8_LDB(B1, 1, 1); PG8_SCHED; PG8_LDA(At, 1, 0); PG8_STAGE_A(PG8_SA(0, 1), a2, o2[2], o2[3]);
            PG8_WAIT_V(8); PG8_WAIT_L(0); PG8_BAR; PG8_MMA(0, 0, At, B0); PG8_MMA(0, 1, At, B1); PG8_BAR; PG8_SCHED;
            PG8_LDA(At, 1, 1); PG8_STAGE_B(PG8_SB(1, 0), b3); PG8_STAGE_B(PG8_SB(1, 1), b3 + hstep); PG8_STAGE_A(PG8_SA(1, 0), a3, o2[0], o2[1]);
            PG8_WAIT_V(8); PG8_WAIT_L(0); PG8_BAR; PG8_MMA(1, 0, At, B0); PG8_MMA(1, 1, At, B1); PG8_BAR; PG8_SCHED;
        }
        if (wr == 0) PG8_BAR;
        if constexpr (F8) asm volatile("s_nop 15\n\ts_nop 15" ::: "memory");
        { const LAS float* bl = (const LAS float*)(bias_lds + (ui & 1) * 1024);
          if constexpr (Epi::PREFETCH && Epi::BIAS_LDS) E(acc, cur, wr, wc, fr, fq, epk, bl); else if constexpr (Epi::BIAS_LDS) E(acc, cur, wr, wc, fr, fq, bl); else if constexpr (Epi::PREFETCH) E(acc, cur, wr, wc, fr, fq, epk); else E(acc, cur, wr, wc, fr, fq); }
        if (!has_next) break;
#pragma unroll
        for (int a = 0; a < 2; ++a)
#pragma unroll
            for (int b = 0; b < 2; ++b)
#pragma unroll
                for (int m = 0; m < 4; ++m)
#pragma unroll
                    for (int n = 0; n < 2; ++n) acc[a][b][m][n] = (f32x4){0.f, 0.f, 0.f, 0.f};
        cur = nxt; cA = nA; cB = nB; ++ui;
        if constexpr (Epi::PREFETCH) E.pre1(cur, wr, fr, epk);
        if constexpr (Epi::BIAS_LDS) { if (wid == 0) __builtin_amdgcn_global_load_lds((const unsigned*)E.bias_src(cur, lane_id()), (LAS unsigned*)(bias_lds + (ui & 1) * 1024), 16, 0, 0); }
#pragma unroll
        for (int i = 0; i < 4; ++i) voffC[i] = voffN[i];
        if (wr == 1) PG8_BAR;
    }
    PG8_WAIT_V(0);
    PG8_BAR;
#undef PG8_SA
#undef PG8_SB
#undef PG8_SBR
#undef PG8_STAGE_A
#undef PG8_STAGE_B
#undef PG8_LDA
#undef PG8_RD16
#undef PG8_MK8
#undef PG8_LDB
#undef PG8_MMA
#undef PG8_WAIT_V
#undef PG8_WAIT_L
#undef PG8_BAR
#undef PG8_SCHED
}
}

#define XB_TMO      128
#define XB_XCNT(j)  (256  + 64 * (j))
#define XB_XSUB(j)  (1280 + 64 * (j))
#define XB_XGEN(j)  (2304 + 64 * (j))
#define XB_TOP      3328
#define XB_TOPGEN   3392
#define XCD_BAR_WORDS 3456
#define XB_SPIN_CAP (1u << 18)
__device__ __forceinline__ unsigned xb_ld(unsigned* p)              { return __hip_atomic_load(p, __ATOMIC_RELAXED, __HIP_MEMORY_SCOPE_AGENT); }
__device__ __forceinline__ unsigned xb_add(unsigned* p, unsigned v) { return __hip_atomic_fetch_add(p, v, __ATOMIC_RELAXED, __HIP_MEMORY_SCOPE_AGENT); }
__device__ __forceinline__ unsigned xb_xcc_id() { return (unsigned)__builtin_amdgcn_s_getreg((3 << 11) | 20) & 0xFu; }
#define XB_SPIN(cond, bar) do { unsigned _sp = 0; while (cond) { __builtin_amdgcn_s_sleep(1); \
    if ((++_sp & 255u) == 0u) { if (xb_ld(&(bar)[XB_TMO])) break; if (_sp > XB_SPIN_CAP) { atomicAdd(&(bar)[XB_TMO], 1u); break; } } } } while (0)
struct XcdBarrier { unsigned* bar; unsigned x; volatile LAS unsigned* st; };
__device__ __forceinline__ XcdBarrier xcd_barrier_post(unsigned* bar, volatile LAS unsigned* st, int tid) {
    XcdBarrier b; b.bar = bar; b.x = xb_xcc_id(); b.st = st;
    if (tid == 0) (void)xb_add(&bar[XB_XCNT(b.x)], 1u);
    return b;
}
__device__ __forceinline__ void xcd_barrier_complete(unsigned* bar, unsigned x, unsigned& nloc, unsigned& nx) {
    const unsigned G = gridDim.x * gridDim.y * gridDim.z;
    unsigned sum, cnt, mine, sp = 0u;
    for (;;) {
        sum = 0u; cnt = 0u; mine = 0u;
#pragma unroll
        for (unsigned j = 0; j < 16; ++j) { const unsigned c = xb_ld(&bar[XB_XCNT(j)]); sum += c; cnt += (c > 0u) ? 1u : 0u; mine = (j == x) ? c : mine; }
        if (sum == G) break;
        __builtin_amdgcn_s_sleep(1);
        if ((++sp & 255u) == 0u) { if (xb_ld(&bar[XB_TMO])) break; if (sp > XB_SPIN_CAP) { atomicAdd(&bar[XB_TMO], 1u); break; } }
    }
    nloc = mine > 0u ? mine : 1u; nx = cnt > 0u ? cnt : 1u;
}
__device__ __forceinline__ void xcd_barrier(const XcdBarrier& b, int tid) {
    asm volatile("s_waitcnt vmcnt(0)" ::: "memory");
    __syncthreads();
    if (tid == 0) {
        unsigned* bar = b.bar;
        __builtin_amdgcn_s_waitcnt(0);
        unsigned nloc = b.st[0], nx = b.st[1];
        if (nloc == 0u) { xcd_barrier_complete(bar, b.x, nloc, nx); b.st[0] = nloc; b.st[1] = nx; }
        const unsigned old = xb_add(&bar[XB_XSUB(b.x)], 1u);
        const unsigned gen = old / nloc;
        if (old + 1u == (gen + 1u) * nloc) {
            __builtin_amdgcn_fence(__ATOMIC_RELEASE, "agent");
            asm volatile("s_waitcnt vmcnt(0)" ::: "memory");
            const unsigned og = xb_add(&bar[XB_TOP], 1u);
            const unsigned tg = og / nx;
            if (og + 1u == (tg + 1u) * nx) xb_add(&bar[XB_TOPGEN], 1u);
            else XB_SPIN(xb_ld(&bar[XB_TOPGEN]) == tg, bar);
            __builtin_amdgcn_fence(__ATOMIC_ACQUIRE, "agent");
            xb_add(&bar[XB_XGEN(b.x)], 1u);
            asm volatile("s_waitcnt vmcnt(0)" ::: "memory");
        } else {
            XB_SPIN(xb_ld(&bar[XB_XGEN(b.x)]) == gen, bar);
            __builtin_amdgcn_fence(__ATOMIC_ACQUIRE, "agent");
            asm volatile("s_waitcnt vmcnt(0)" ::: "memory");
        }
    }
    __syncthreads();
}

#define CAS __attribute__((address_space(4)))
typedef const float* PFC;
struct Frame {
    LAS unsigned char* lds;
    gu32* ctl;
    int tid, lane, wave, vcu, G, bx;
    const CAS PFC* in;
    float* out; unsigned char* ws;
};
#define GIN(i) ((const float*)(const GAS float*)F.in[i])
enum { I_X = 0, I_C, I_ADAW, I_ADAB, I_NMIX, I_WIN, I_RETNW, I_CONVW, I_CONVB, I_WA, I_BA, I_WX, I_BX, I_LAM, I_WOUT, I_NFFN, I_RW, I_RB, I_WGU, I_BGU, I_WDN, I_BDN, I_FNW };

__device__ __forceinline__ void p0_transpose_item(const float* W, int N, int k0, int n0, bf16_t* WTrow0  , int Kd, LAS float* scr, int lane) {
#pragma unroll 8
    for (int i = 0; i < 32; ++i) { const int kk = 2 * i + (lane >> 5); scr[kk * 33 + (lane & 31)] = W[(size_t)(k0 + kk) * N + n0 + (lane & 31)]; }
    LDS_WAIT(); asm volatile("" ::: "memory");
    const int c = lane & 7;
#pragma unroll
    for (int j = 0; j < 4; ++j) { const int n = (lane >> 3) + 8 * j; const LAS float* s = scr + (8 * c) * 33 + n;
        u32x4 o; o.x = pk2(s[0 * 33], s[1 * 33]); o.y = pk2(s[2 * 33], s[3 * 33]); o.z = pk2(s[4 * 33], s[5 * 33]); o.w = pk2(s[6 * 33], s[7 * 33]);
        *(u32x4*)(WTrow0 + (size_t)n * Kd + k0 + 8 * c) = o; }
    LDS_WAIT(); asm volatile("" ::: "memory");
}
__device__ __forceinline__ void p0_transpose_item8(const float* W, int N, int k0, int n0, unsigned char* WTrow0, int Kd, LAS float* scr, int lane) {
#pragma unroll 8
    for (int i = 0; i < 32; ++i) { const int kk = 2 * i + (lane >> 5); scr[kk * 33 + (lane & 31)] = W[(size_t)(k0 + kk) * N + n0 + (lane & 31)] * 32.0f; }
    LDS_WAIT(); asm volatile("" ::: "memory");
    const int c = lane & 7;
#pragma unroll
    for (int j = 0; j < 4; ++j) { const int n = (lane >> 3) + 8 * j; const LAS float* sp = scr + (8 * c) * 33 + n;
        u32x2 o; o.x = cvt4_fp8(sp[0 * 33], sp[1 * 33], sp[2 * 33], sp[3 * 33]); o.y = cvt4_fp8(sp[4 * 33], sp[5 * 33], sp[6 * 33], sp[7 * 33]);
        *(u32x2*)(WTrow0 + (size_t)n * Kd + k0 + 8 * c) = o; }
    LDS_WAIT(); asm volatile("" ::: "memory");
}
__device__ __forceinline__ float silu_f(float x) { return x * frcp(1.0f + fexp(-x)); }

__device__ __forceinline__ void p0_prologue(Frame& F) {
    const int gw = F.vcu * NWAVES + F.wave, NGW = F.G * NWAVES;
    {
        LAS float* cact = (LAS float*)(F.lds);
        LAS float* red = (LAS float*)(F.lds + 32768);
        { float cv[BATCH * D / 512];
#pragma unroll
          for (int it = 0; it < BATCH * D / 512; ++it) cv[it] = GIN(I_C)[F.tid + it * 512];
#pragma unroll
          for (int it = 0; it < BATCH * D / 512; ++it) cact[F.tid + it * 512] = silu_f(cv[it]); }
        __syncthreads();
        float* mod = (float*)(F.ws + WS_MOD);
        for (int u = F.bx; u < DEPTH * 96; u += F.G) {
            const int l = u / 96, n0 = (u % 96) * 64, c4 = F.tid & 15, kg = F.tid >> 4;
            const float* w = GIN(I_ADAW) + (size_t)l * D * 6144 + n0 + 4 * c4;
            f32x4 a[8];
#pragma unroll
            for (int b = 0; b < 8; ++b) a[b] = (f32x4){0.f, 0.f, 0.f, 0.f};
#pragma unroll 8
            for (int k = kg * 32; k < kg * 32 + 32; ++k) { const f32x4 wv = *(const f32x4*)(w + (size_t)k * 6144);
#pragma unroll
                for (int b = 0; b < 8; ++b) a[b] += wv * cact[b * D + k]; }
#pragma unroll
            for (int b = 0; b < 8; ++b) *(LAS f32x4*)(red + (kg * 8 + b) * 64 + 4 * c4) = a[b];
            __syncthreads();
            { const int b = F.tid >> 6, col = F.tid & 63; float s = 0.f;
#pragma unroll
              for (int g = 0; g < 32; ++g) s += red[(g * 8 + b) * 64 + col];
              mod[((size_t)l * BATCH + b) * 6144 + n0 + col] = s + GIN(I_ADAB)[l * 6144 + n0 + col]; }
            __syncthreads();
        }
    }
    {
        float* rc = (float*)(F.ws + WS_ROT); float* rs = rc + SEQ * 32;
        for (int i = gw * 64 + F.lane; i < SEQ * 32; i += NGW * 64) { const int pos = i >> 5, j = i & 31;
            const double inv = pow(10000.0, -(double)j / 32.0), ang = (double)pos * inv; rc[i] = (float)cos(ang); rs[i] = (float)sin(ang); }
    }
    {
        bf16_t* rwt = (bf16_t*)(F.ws + WS_RWT);
        for (int i = gw * 64 + F.lane; i < DEPTH * NE * D; i += NGW * 64) { const int l = i / (NE * D), r = i % (NE * D), e = r / D, k = r % D;
            const float w = GIN(I_RW)[(size_t)l * D * NE + (size_t)k * NE + e]; const unsigned hi = f2bf(w); const float lo = w - __builtin_bit_cast(float, hi << 16);
            rwt[((size_t)l * 2 + 0) * NE * D + r] = (bf16_t)hi; rwt[((size_t)l * 2 + 1) * NE * D + r] = (bf16_t)f2bf(lo); }
    }
}
namespace cv {
constexpr int I_IN = 16 * (INW / 64), I_OUT = 16 * 16, I_GU = 16 * 32, I_DN = 16 * 16;
constexpr int N_IN = DEPTH * I_IN, N_OUT = DEPTH * I_OUT, N_GU = DEPTH * NE * I_GU, N_DN = DEPTH * NE * I_DN, N_PROJ = N_IN + N_OUT;
struct Item { const float* src; unsigned char* dst; int N, f8; };
__device__ __forceinline__ Item decode(Frame& F, int it) { Item t; int r = it;
    bf16_t* win_t = (bf16_t*)(F.ws + WS_WIN); bf16_t* wout_t = (bf16_t*)(F.ws + WS_WOUT); unsigned char* wgu_t = (unsigned char*)(F.ws + WS_WGU); unsigned char* wdn_t = (unsigned char*)(F.ws + WS_WDN);
    if (r < N_IN) { const int l = r / I_IN, q = r % I_IN, kb = q / (INW / 64), nb = q % (INW / 64);
        t.src = GIN(I_WIN) + (size_t)l * D * INW + (size_t)kb * 64 * INW + nb * 64; t.dst = (unsigned char*)(win_t + ((size_t)l * PP + nb * 64) * D + kb * 64); t.N = INW; t.f8 = 0; return t; }
    r -= N_IN;
    if (r < N_OUT) { const int l = r / I_OUT, q = r % I_OUT, kb = q / 16, nb = q % 16;
        t.src = GIN(I_WOUT) + (size_t)l * D * D + (size_t)kb * 64 * D + nb * 64; t.dst = (unsigned char*)(wout_t + ((size_t)l * D + nb * 64) * D + kb * 64); t.N = D; t.f8 = 0; return t; }
    r -= N_OUT;
    if (r < N_GU) { const int le = r / I_GU, q = r % I_GU, kb = q / 32, nb = q % 32, n0 = nb * 64, half = n0 >> 10, j = n0 & 1023;
        const int drow = 256 * (j >> 7) + 128 * half + (j & 127);
        t.src = GIN(I_WGU) + (size_t)le * D * 2048 + (size_t)kb * 64 * 2048 + n0; t.dst = wgu_t + ((size_t)le * 2048 + drow) * D + kb * 64; t.N = 2048; t.f8 = 1; return t; }
    r -= N_GU;
    { const int le = r / I_DN, q = r % I_DN, kb = q / 16, nb = q % 16;
        t.src = GIN(I_WDN) + (size_t)le * FF * D + (size_t)kb * 64 * D + nb * 64; t.dst = wdn_t + ((size_t)le * D + nb * 64) * FF + kb * 64; t.N = D; t.f8 = 1; return t; } }
__device__ __forceinline__ void load(const Item& t, f32x4 (&v)[16], int lane) { const int r4 = lane >> 4, c16 = lane & 15;
#pragma unroll
    for (int i = 0; i < 16; ++i) v[i] = __builtin_nontemporal_load((const f32x4*)(t.src + (size_t)(4 * i + r4) * t.N + 4 * c16)); }
template <int F8C = -1> __device__ __forceinline__ void to_lds(const Item& t, const f32x4 (&v)[16], LAS float* scr, int lane) {
    const int r4 = lane >> 4, c16 = lane & 15; const float sc = (F8C == 1 || t.f8) ? 32.0f : 1.0f;
#pragma unroll
    for (int i = 0; i < 16; ++i) *(LAS f32x4*)(scr + (4 * i + r4) * 64 + 4 * (c16 ^ i)) = v[i] * sc;
    LDS_WAIT(); asm volatile("" ::: "memory"); }
template <int F8C = -1> __device__ __forceinline__ void finish(const Item& t, LAS float* scr, int lane) {
    const int q = lane & 3, a = lane >> 4, n3 = (lane >> 2) & 3;
    const LAS float* base0 = scr + q * 1024 + n3;
    int Y[4];
#pragma unroll
    for (int b = 0; b < 4; ++b) Y[b] = 4 * (a ^ b);
#pragma unroll
    for (int p = 0; p < 4; ++p) { const int n = 16 * p + (lane >> 2); const LAS float* bp = base0 + 16 * (p ^ q); float e[16];
#pragma unroll
        for (int kk = 0; kk < 16; ++kk) e[kk] = bp[kk * 64 + Y[kk >> 2]];
        if (F8C == 1 || t.f8) { u32x4 o; o.x = cvt4_fp8(e[0], e[1], e[2], e[3]); o.y = cvt4_fp8(e[4], e[5], e[6], e[7]); o.z = cvt4_fp8(e[8], e[9], e[10], e[11]); o.w = cvt4_fp8(e[12], e[13], e[14], e[15]);
            *(u32x4*)(t.dst + (size_t)n * D + 16 * q) = o; }
        else { u32x4* dp = (u32x4*)(t.dst + ((size_t)n * D + 16 * q) * 2);
#pragma unroll
            for (int h = 0; h < 2; ++h) { u32x4 o; o.x = cvtpk(e[8 * h], e[8 * h + 1]); o.y = cvtpk(e[8 * h + 2], e[8 * h + 3]); o.z = cvtpk(e[8 * h + 4], e[8 * h + 5]); o.w = cvtpk(e[8 * h + 6], e[8 * h + 7]); dp[h] = o; } } }
    LDS_WAIT(); asm volatile("" ::: "memory"); }
__device__ __forceinline__ void run(Frame& F, int it0, int step, int end) {
    LAS float* scr = (LAS float*)(F.lds + F.wave * 16384);
    int it = it0;
    if (it < end) { Item cur = decode(F, it); f32x4 vc[16]; load(cur, vc, F.lane);
        for (;;) { const int itn = it + step; const bool hn = itn < end; Item nx = cur; f32x4 vn[16];
            if (hn) { nx = decode(F, itn); load(nx, vn, F.lane); }
            to_lds(cur, vc, scr, F.lane); finish(cur, scr, F.lane);
            if (!hn) break;
            cur = nx; it = itn;
#pragma unroll
            for (int i = 0; i < 16; ++i) vc[i] = vn[i]; } }
}
constexpr int BATCH_ITEMS = 32, NB_GU = NE * I_GU / BATCH_ITEMS, NB_DN = NE * I_DN / BATCH_ITEMS, NB_LAYER = NB_GU + NB_DN;
__device__ __forceinline__ void run_batch(Frame& F, int base) {
    LAS float* scr = (LAS float*)(F.lds + F.wave * 16384);
    const int i0 = base + 4 * F.wave;
    f32x4 vA[16], vB[16];
    const Item t0 = decode(F, i0), t1 = decode(F, i0 + 1), t2 = decode(F, i0 + 2), t3 = decode(F, i0 + 3);
#define CV_ARRIVED(V, n) do { asm volatile("s_waitcnt vmcnt(" #n ")" ::: "memory"); _Pragma("unroll") for (int _i = 0; _i < 16; ++_i) asm volatile("" : "+v"(V[_i])); } while (0)
    load(t0, vA, F.lane); load(t1, vB, F.lane);
    CV_ARRIVED(vA, 16); to_lds<1>(t0, vA, scr, F.lane); finish<1>(t0, scr, F.lane); load(t2, vA, F.lane);
    CV_ARRIVED(vB, 16); to_lds<1>(t1, vB, scr, F.lane); finish<1>(t1, scr, F.lane); load(t3, vB, F.lane);
    CV_ARRIVED(vA, 16); to_lds<1>(t2, vA, scr, F.lane); finish<1>(t2, scr, F.lane);
    CV_ARRIVED(vB, 0);  to_lds<1>(t3, vB, scr, F.lane); finish<1>(t3, scr, F.lane);
}
__device__ __forceinline__ void run_half(Frame& F, int base16) {
    LAS float* scr = (LAS float*)(F.lds + F.wave * 16384);
    const int i0 = base16 + 2 * F.wave;
    f32x4 vA[16], vB[16];
    const Item t0 = decode(F, i0), t1 = decode(F, i0 + 1);
    load(t0, vA, F.lane); load(t1, vB, F.lane);
    CV_ARRIVED(vA, 16); to_lds<1>(t0, vA, scr, F.lane); finish<1>(t0, scr, F.lane);
    CV_ARRIVED(vB, 0);  to_lds<1>(t1, vB, scr, F.lane); finish<1>(t1, scr, F.lane);
#undef CV_ARRIVED
}
__device__ __forceinline__ int batch_base(int l, int id) { return id < NB_GU ? N_PROJ + l * (NE * I_GU) + id * BATCH_ITEMS : N_PROJ + N_GU + l * (NE * I_DN) + (id - NB_GU) * BATCH_ITEMS; }
__device__ __forceinline__ int tail_batches(int l) { return l >= 1 ? 160 : 32; }
}
__device__ __forceinline__ void conv_one(Frame& F, int l, bool tail = false) {
    { int _t = (F.wave << 6) | lane_id(); asm volatile("" : "+v"(_t)); F.tid = _t; F.lane = _t & 63; }
    volatile LAS int* sq = (volatile LAS int*)(F.lds + MISC_OFF + 1024);
    unsigned* head = (unsigned*)(F.ctl + CW_Q + 64 * l + (tail ? 40 : 32));
    __syncthreads();
    if (F.tid == 0) *sq = (int)xb_add(head, 1u);
    __syncthreads();
    const int id = __builtin_amdgcn_readfirstlane(*sq);
    __syncthreads();
    const int nbm = cv::NB_LAYER - cv::tail_batches(l);
    if (tail) { if (id < 2 * cv::tail_batches(l)) cv::run_half(F, cv::batch_base(l, nbm + (id >> 1)) + 16 * (id & 1)); }
    else if (id < nbm) cv::run_batch(F, cv::batch_base(l, id));
    __syncthreads();
}
__device__ __forceinline__ void p0_convert(Frame& F) {
    const int gw = F.vcu * NWAVES + F.wave, NGW = F.G * NWAVES;
    bf16_t* win_t = (bf16_t*)(F.ws + WS_WIN);
    for (int i = gw * 64 + F.lane; i < DEPTH * 128 * D / 8; i += NGW * 64) { const int l = i / (128 * D / 8), r = i % (128 * D / 8);
        *(u32x4*)(win_t + ((size_t)l * PP + INW) * D + (size_t)r * 8) = (u32x4){0u, 0u, 0u, 0u}; }
    cv::run(F, gw, NGW, cv::N_PROJ);
    __syncthreads();
}

__device__ __forceinline__ void modnorm_store(const f32x4 (&v)[4], const float* nw, const float* scale, const float* shift, bf16_t* orow, int lane) {
    float s = 0.f;
#pragma unroll
    for (int j = 0; j < 4; ++j) s += (v[j].x * v[j].x + v[j].y * v[j].y) + (v[j].z * v[j].z + v[j].w * v[j].w);
    const float rstd = 1.0f / sqrtf(wave_sum(s) * (1.0f / D) + NORM_EPS);
#pragma unroll
    for (int j = 0; j < 4; ++j) { const int k = 4 * lane + 256 * j; const f32x4 w = *(const f32x4*)(nw + k), sc = *(const f32x4*)(scale + k), sh = *(const f32x4*)(shift + k);
        const f32x4 h = v[j] * rstd * w * (sc + 1.0f) + sh;
        u32x2 o; o.x = pk2(h.x, h.y); o.y = pk2(h.z, h.w); *(u32x2*)(orow + k) = o; }
}
__device__ __forceinline__ void p0b_norm(Frame& F) {
    const int gw = F.vcu * NWAVES + F.wave, NGW = F.G * NWAVES;
    const float* mod = (const float*)(F.ws + WS_MOD); bf16_t* hb = (bf16_t*)(F.ws + WS_H);
    for (int tok = gw; tok < T; tok += NGW) { const int b = tok / SEQ; const float* xr = GIN(I_X) + (size_t)tok * D;
        f32x4 v[4];
#pragma unroll
        for (int j = 0; j < 4; ++j) v[j] = *(const f32x4*)(xr + 4 * F.lane + 256 * j);
        modnorm_store(v, GIN(I_NMIX), mod + (size_t)b * 6144 + 1024, mod + (size_t)b * 6144, hb + (size_t)tok * D, F.lane); }
}

__device__ __forceinline__ float sigmoid_f(float x) { return frcp(1.0f + fexp(-x)); }
__device__ __forceinline__ float gelu_tanh(float x) { const float u = 0.7978845608028654f * (x + 0.044715f * x * x * x); return x * frcp(1.0f + fexp(-2.0f * u)); }
constexpr int LRU_WT = 0, LRU_A = 18432, LRU_LS = 68, LRU_B = LRU_A + LCH * LRU_LS * 4, LRU_SEG = LRU_B + LCH * LRU_LS * 4, LRU_CARRY = LRU_SEG + 4096;
__device__ __forceinline__ void lru_unit(Frame& F, int l, int b, int g, int c4) {
    const int tid = F.tid, lane = F.lane, wave = F.wave;
    LAS unsigned char* lds = F.lds;
    const bf16_t* proj = (const bf16_t*)(F.ws + WS_PROJ);
    float* lrusum = (float*)(F.ws + WS_LRUSUM);
    const int gc0 = l * 384 + g * 64;
    { const float* wa = GIN(I_WA) + ((size_t)l * 6 + g) * 4096; const float* wx = GIN(I_WX) + ((size_t)l * 6 + g) * 4096;
      float wv[16];
#pragma unroll
      for (int it = 0; it < 16; ++it) { const int idx = tid + it * 512, gate = idx >> 12, i = (idx >> 6) & 63, j = idx & 63; wv[it] = (gate ? wx : wa)[i * 64 + j]; }
#pragma unroll
      for (int it = 0; it < 16; ++it) { const int idx = tid + it * 512, gate = idx >> 12, i = (idx >> 6) & 63, j = idx & 63;
          *(LAS unsigned short*)(lds + LRU_WT + (gate * 64 + j) * 144 + i * 2) = (unsigned short)f2bf(wv[it]); } }
    float bavq[4], bxvq[4], c8q[4];
#pragma unroll
    for (int nt = 0; nt < 4; ++nt) { const int chq = 16 * nt + (lane & 15); bavq[nt] = GIN(I_BA)[gc0 + chq]; bxvq[nt] = GIN(I_BX)[gc0 + chq]; c8q[nt] = -8.0f * log1pf(__expf(-GIN(I_LAM)[gc0 + chq])); }
    u32x4 xq[2][4];
    { const int pos0 = 4 * c4 * LCH + wave * 16 + (lane & 15);
#pragma unroll
      for (int ks = 0; ks < 2; ++ks)
#pragma unroll
          for (int w = 0; w < 4; ++w) { const int p = pos0 - 3 + w; xq[ks][w] = (u32x4){0u, 0u, 0u, 0u}; if (p >= 0) xq[ks][w] = *(const u32x4*)(proj + (size_t)(b * SEQ + p) * PP + C_LX + g * 64 + 32 * ks + 8 * (lane >> 4)); } }
    __syncthreads();
#pragma unroll 1
  for (int c = 4 * c4; c < 4 * c4 + 4; ++c) {
    const int tt = lane & 15, kg = lane >> 4;
    const int tl = wave * 16 + tt;
    const int pos = c * LCH + tl;
    bf16x8 af[2];
    u32x4 xc[2][4];
#pragma unroll
    for (int ks = 0; ks < 2; ++ks)
#pragma unroll
        for (int w = 0; w < 4; ++w) xc[ks][w] = xq[ks][w];
    if (c + 1 < 4 * c4 + 4) {
#pragma unroll
        for (int ks = 0; ks < 2; ++ks)
#pragma unroll
            for (int w = 0; w < 4; ++w) xq[ks][w] = *(const u32x4*)(proj + (size_t)(b * SEQ + pos + LCH - 3 + w) * PP + C_LX + g * 64 + 32 * ks + 8 * kg); }
#pragma unroll
    for (int ks = 0; ks < 2; ++ks) { const int ch0 = 32 * ks + 8 * kg; float u[8];
        { const f32x4 cb0 = *(const f32x4*)(GIN(I_CONVB) + gc0 + ch0), cb1 = *(const f32x4*)(GIN(I_CONVB) + gc0 + ch0 + 4);
          u[0] = cb0.x; u[1] = cb0.y; u[2] = cb0.z; u[3] = cb0.w; u[4] = cb1.x; u[5] = cb1.y; u[6] = cb1.z; u[7] = cb1.w; }
#pragma unroll
        for (int w = 0; w < 4; ++w) { const int p = pos - 3 + w;
            if (p >= 0) { const u32x4 xv = xc[ks][w];
                const float* cw = GIN(I_CONVW) + (size_t)l * 4 * 384 + w * 384 + g * 64 + ch0; const f32x4 w0 = *(const f32x4*)cw, w1 = *(const f32x4*)(cw + 4);
                u[0] += bflo(xv.x) * w0.x; u[1] += bfhi(xv.x) * w0.y; u[2] += bflo(xv.y) * w0.z; u[3] += bfhi(xv.y) * w0.w;
                u[4] += bflo(xv.z) * w1.x; u[5] += bfhi(xv.z) * w1.y; u[6] += bflo(xv.w) * w1.z; u[7] += bfhi(xv.w) * w1.w; } }
        LAS float* ub = (LAS float*)(lds + LRU_B) + tl * LRU_LS + ch0;
        *(LAS f32x4*)ub = (f32x4){u[0], u[1], u[2], u[3]}; *(LAS f32x4*)(ub + 4) = (f32x4){u[4], u[5], u[6], u[7]};
        u32x4 pk; pk.x = pk2(u[0], u[1]); pk.y = pk2(u[2], u[3]); pk.z = pk2(u[4], u[5]); pk.w = pk2(u[6], u[7]); af[ks] = __builtin_bit_cast(bf16x8, pk); }
    LDS_WAIT(); asm volatile("" ::: "memory");
#pragma unroll
    for (int nt = 0; nt < 4; ++nt) { f32x4 pa = (f32x4){0.f, 0.f, 0.f, 0.f}, px = pa;
#pragma unroll
        for (int ks = 0; ks < 2; ++ks) { const bf16x8 ba = *(const LAS bf16x8*)(lds + LRU_WT + (16 * nt + tt) * 144 + (32 * ks + 8 * kg) * 2);
            const bf16x8 bx = *(const LAS bf16x8*)(lds + LRU_WT + (64 + 16 * nt + tt) * 144 + (32 * ks + 8 * kg) * 2);
            pa = __builtin_amdgcn_mfma_f32_16x16x32_bf16(af[ks], ba, pa, 0, 0, 0); px = __builtin_amdgcn_mfma_f32_16x16x32_bf16(af[ks], bx, px, 0, 0, 0); }
        const int ch = 16 * nt + tt; const float bav = bavq[nt], bxv = bxvq[nt], c8 = c8q[nt];
#pragma unroll
        for (int j = 0; j < 4; ++j) { const int t2 = wave * 16 + 4 * kg + j;
            const float r = sigmoid_f(pa[j] + bav), ii = sigmoid_f(px[j] + bxv), la = c8 * r, a = fexp(la), bc = __builtin_amdgcn_sqrtf(fmaxf(1.0f - a * a, 0.f));
            LAS float* pb = (LAS float*)(lds + LRU_B) + t2 * LRU_LS + ch; const float uv = *pb;
            *((LAS float*)(lds + LRU_A) + t2 * LRU_LS + ch) = a; *pb = bc * ii * uv; } }
    __syncthreads();
    const int ch = tid & 63, seg = tid >> 6;
    const LAS float* Ab = (const LAS float*)(lds + LRU_A) + (seg * 16) * LRU_LS + ch; const LAS float* Bb = (const LAS float*)(lds + LRU_B) + (seg * 16) * LRU_LS + ch;
    float ar[16], br[16];
    { float h = 0.f, A = 1.f;
#pragma unroll
      for (int t = 0; t < 16; ++t) { ar[t] = Ab[t * LRU_LS]; br[t] = Bb[t * LRU_LS]; }
#pragma unroll
      for (int t = 0; t < 16; ++t) { h = ar[t] * h + br[t]; A *= ar[t]; }
      LAS float* sg = (LAS float*)(lds + LRU_SEG); sg[(seg * 2) * 64 + ch] = A; sg[(seg * 2 + 1) * 64 + ch] = h; }
    __syncthreads();
    const LAS float* sg = (const LAS float*)(lds + LRU_SEG);
    if (tid < 64) { float H = 0.f, At = 1.f;
#pragma unroll
        for (int s = 0; s < 8; ++s) { const float a = sg[(s * 2) * 64 + ch]; H = a * H + sg[(s * 2 + 1) * 64 + ch]; At *= a; }
        float* o = lrusum + (((size_t)(b * 6 + g) * NLCH + c) * 2) * 64; o[ch] = At; o[64 + ch] = H; }
    { float h = 0.f, A = 1.f;
#pragma unroll
      for (int s = 0; s < 8; ++s) if (s < seg) { const float a = sg[(s * 2) * 64 + ch]; h = a * h + sg[(s * 2 + 1) * 64 + ch]; A *= a; }
      bf16_t* lh = (bf16_t*)(F.ws + WS_LRUH); bf16_t* la = (bf16_t*)(F.ws + WS_LRUA);
      const size_t row0 = (size_t)b * SEQ + c * LCH + seg * 16;
#pragma unroll
      for (int t = 0; t < 16; ++t) { const float a = ar[t]; h = a * h + br[t]; A *= a; const unsigned w = cvtpk(h, A);
          lh[(row0 + t) * 384 + g * 64 + ch] = (bf16_t)(w & 0xffffu); la[(row0 + t) * 384 + g * 64 + ch] = (bf16_t)(w >> 16); } }
    __syncthreads();
  }
}
__device__ __forceinline__ void lru_fix(Frame& F, int b, int g, int c) {
    const int tid = F.tid, ch = tid & 63, seg = tid >> 6;
    const float* lrusum = (const float*)(F.ws + WS_LRUSUM);
    LAS float* cy = (LAS float*)(F.lds + LRU_CARRY);
    if (tid < 64) { const float* s0 = lrusum + ((size_t)(b * 6 + g) * NLCH) * 128; float sa[NLCH], sh[NLCH];
#pragma unroll
        for (int cc = 0; cc < NLCH; ++cc) { sa[cc] = (cc < c) ? s0[cc * 128 + ch] : 1.0f; sh[cc] = (cc < c) ? s0[cc * 128 + 64 + ch] : 0.0f; }
        float hin = 0.f;
#pragma unroll
        for (int cc = 0; cc < NLCH; ++cc) hin = sa[cc] * hin + sh[cc];
        cy[ch] = hin; }
    const bf16_t* proj = (const bf16_t*)(F.ws + WS_PROJ); const bf16_t* lh = (const bf16_t*)(F.ws + WS_LRUH); const bf16_t* la = (const bf16_t*)(F.ws + WS_LRUA); bf16_t* ymix = (bf16_t*)(F.ws + WS_YMIX);
    const int tl = tid >> 2, c0 = 16 * (tid & 3);
    const size_t row = (size_t)b * SEQ + c * LCH + tl;
    const u32x4 g0 = *(const u32x4*)(proj + row * PP + C_LG + g * 64 + c0), g1 = *(const u32x4*)(proj + row * PP + C_LG + g * 64 + c0 + 8);
    const u32x4 h0 = *(const u32x4*)(lh + row * 384 + g * 64 + c0), h1 = *(const u32x4*)(lh + row * 384 + g * 64 + c0 + 8);
    const u32x4 a0 = *(const u32x4*)(la + row * 384 + g * 64 + c0), a1 = *(const u32x4*)(la + row * 384 + g * 64 + c0 + 8);
    __syncthreads();
    const unsigned gw[8] = {g0.x, g0.y, g0.z, g0.w, g1.x, g1.y, g1.z, g1.w}, hw[8] = {h0.x, h0.y, h0.z, h0.w, h1.x, h1.y, h1.z, h1.w}, aw[8] = {a0.x, a0.y, a0.z, a0.w, a1.x, a1.y, a1.z, a1.w};
    unsigned ow[8];
#pragma unroll
    for (int i = 0; i < 8; ++i) { const float hin0 = cy[c0 + 2 * i], hin1 = cy[c0 + 2 * i + 1];
        const float y0 = gelu_tanh(bflo(gw[i])) * (bflo(hw[i]) + bflo(aw[i]) * hin0), y1 = gelu_tanh(bfhi(gw[i])) * (bfhi(hw[i]) + bfhi(aw[i]) * hin1);
        ow[i] = cvtpk(y0, y1); }
    bf16_t* yp = ymix + row * D + Y_LRU + g * 64 + c0;
    *(u32x4*)yp = (u32x4){ow[0], ow[1], ow[2], ow[3]}; *(u32x4*)(yp + 8) = (u32x4){ow[4], ow[5], ow[6], ow[7]};
    __syncthreads();
}

constexpr int AT_KS = 144;
constexpr int AT_K = 0, AT_V = 2 * 64 * AT_KS;
__device__ __forceinline__ s16x4 vtr(const LAS unsigned char* p) { return __builtin_bit_cast(s16x4, __builtin_amdgcn_ds_read_tr16_b64_v4i16((LAS v4i16_t*)p)); }
template <int MODE>
__device__ __forceinline__ void attn_unit(Frame& F, int l, int b, int h, int qb) {
    const int tid = F.tid, lane = F.lane, wave = F.wave;
    LAS unsigned char* lds = F.lds;
    const bf16_t* proj = (const bf16_t*)(F.ws + WS_PROJ); bf16_t* ymix = (bf16_t*)(F.ws + WS_YMIX);
    const int colQ = (MODE == 0 ? C_MQ : C_RQ) + h * 64, colK = (MODE == 0 ? C_MK : C_RK) + h * 64, colV = (MODE == 0 ? C_MV : C_RV) + h * 64;
    const int ql = lane & 15, g4 = lane >> 4;
    const size_t rowb = (size_t)b * SEQ;
    int qidx[2]; bf16x8 qf[2][2];
#pragma unroll
    for (int mt = 0; mt < 2; ++mt) { qidx[mt] = qb * 256 + wave * 32 + mt * 16 + ql;
#pragma unroll
        for (int ks = 0; ks < 2; ++ks) qf[mt][ks] = *(const bf16x8*)(proj + (rowb + qidx[mt]) * PP + colQ + 32 * ks + 8 * g4); }
    const int own = qb;
    unsigned amask[2] = {0u, 0u};
    if constexpr (MODE == 0) {
        const float* km = (const float*)(F.ws + WS_KMEAN) + ((size_t)(b * 6 + h) * 8) * 64;
#pragma unroll
        for (int mt = 0; mt < 2; ++mt) { float gs[8];
#pragma unroll
            for (int n = 0; n < 8; ++n) { float s = 0.f;
                if (n < own) {
#pragma unroll
                    for (int ks = 0; ks < 2; ++ks) { const f32x4 k0 = *(const f32x4*)(km + n * 64 + 32 * ks + 8 * g4), k1 = *(const f32x4*)(km + n * 64 + 32 * ks + 8 * g4 + 4);
                        const u32x4 qw = __builtin_bit_cast(u32x4, qf[mt][ks]);
                        s += bflo(qw.x) * k0.x + bfhi(qw.x) * k0.y + bflo(qw.y) * k0.z + bfhi(qw.y) * k0.w + bflo(qw.z) * k1.x + bfhi(qw.z) * k1.y + bflo(qw.w) * k1.z + bfhi(qw.w) * k1.w; } }
                s += __shfl_xor(s, 16); s += __shfl_xor(s, 32);
                gs[n] = (n < own) ? s : -INFINITY; }
#pragma unroll
            for (int n = 0; n < 8; ++n) { int cnt = 0;
#pragma unroll
                for (int m = 0; m < 8; ++m) if (m != n) cnt += (gs[m] > gs[n] || (gs[m] == gs[n] && m < n)) ? 1 : 0;
                if (n < own && cnt < 3) amask[mt] |= (1u << n); } }
    }
    const float log2g = (MODE == 1) ? log2f(1.0f - exp2f(-5.0f - (float)h)) : 0.f;
    float dc[4][4];
    if constexpr (MODE == 1) {
#pragma unroll
        for (int t = 0; t < 4; ++t)
#pragma unroll
            for (int j = 0; j < 4; ++j) dc[t][j] = ex2(-(float)(16 * t + 4 * g4 + j) * log2g);
    }
    const int lt = tid & 255, lrow = lt >> 2, lc = lt & 3;
    const bf16_t* gsrc = proj + (rowb + lrow) * PP + (tid < 256 ? colK : colV) + lc * 8;
    const int ldst = (tid < 256 ? AT_K : AT_V) + lrow * AT_KS + lc * 16;
    const int nkt = 4 * qb + 4;
    u32x4 pre0 = *(const u32x4*)(gsrc), pre1 = *(const u32x4*)(gsrc + 32);
    *(LAS u32x4*)(lds + ldst) = pre0; *(LAS u32x4*)(lds + ldst + 64) = pre1;
    __syncthreads();
    f32x4 o[2][4];
#pragma unroll
    for (int mt = 0; mt < 2; ++mt)
#pragma unroll
        for (int dt = 0; dt < 4; ++dt) o[mt][dt] = (f32x4){0.f, 0.f, 0.f, 0.f};
    float mrun[2] = {-1e30f, -1e30f}, lsum[2] = {0.f, 0.f};
    const int li = lane & 15, tq = li >> 2, tp = li & 3;
    auto tile = [&](const int kt, auto diag_c) {
        constexpr bool diag = decltype(diag_c)::value;
        const int buf = kt & 1;
        if (kt + 1 < nkt) { const bf16_t* gp = gsrc + (size_t)(kt + 1) * 64 * PP; pre0 = *(const u32x4*)(gp); pre1 = *(const u32x4*)(gp + 32); }
        f32x4 s[2][4];
        const LAS unsigned char* kb = lds + AT_K + buf * 64 * AT_KS;
#pragma unroll
        for (int t = 0; t < 4; ++t) { s[0][t] = (f32x4){0.f, 0.f, 0.f, 0.f}; s[1][t] = (f32x4){0.f, 0.f, 0.f, 0.f};
#pragma unroll
            for (int ks = 0; ks < 2; ++ks) { const bf16x8 kf = *(const LAS bf16x8*)(kb + (16 * t + ql) * AT_KS + (32 * ks + 8 * g4) * 2);
                s[0][t] = __builtin_amdgcn_mfma_f32_16x16x32_bf16(kf, qf[0][ks], s[0][t], 0, 0, 0);
                s[1][t] = __builtin_amdgcn_mfma_f32_16x16x32_bf16(kf, qf[1][ks], s[1][t], 0, 0, 0); } }
        bf16x8 pf[2][2];
#pragma unroll
        for (int mt = 0; mt < 2; ++mt) {
            float p[4][4];
            if constexpr (MODE == 0) {
                constexpr float SC = 0.125f * 1.4426950408889634f;
                const int kblk = kt >> 2;
                const bool allow = !(kblk < own && ((amask[mt] >> kblk) & 1u) == 0u);
                float mx = -INFINITY;
#pragma unroll
                for (int t = 0; t < 4; ++t)
#pragma unroll
                    for (int j = 0; j < 4; ++j) { float v = s[mt][t][j];
                        if constexpr (diag) { const int key = kt * 64 + 16 * t + 4 * g4 + j; v = (key <= qidx[mt]) ? v : -INFINITY; }
                        p[t][j] = v; mx = fmaxf(mx, v); }
                mx = allow ? mx * SC : -INFINITY;
                mx = fmaxf(mx, __shfl_xor(mx, 16)); mx = fmaxf(mx, __shfl_xor(mx, 32));
                const float mnew = fmaxf(mrun[mt], mx), alpha = ex2(mrun[mt] - mnew); mrun[mt] = mnew;
                const float nb = allow ? -mnew : -INFINITY;
                float ps = 0.f;
#pragma unroll
                for (int t = 0; t < 4; ++t)
#pragma unroll
                    for (int j = 0; j < 4; ++j) { const float e = ex2(fmaf(p[t][j], SC, nb)); p[t][j] = e; ps += e; }
                lsum[mt] = lsum[mt] * alpha + ps;
#pragma unroll
                for (int dt = 0; dt < 4; ++dt) o[mt][dt] = o[mt][dt] * alpha;
            } else {
                const float at = ex2((float)(qidx[mt] - kt * 64) * log2g);
#pragma unroll
                for (int t = 0; t < 4; ++t)
#pragma unroll
                    for (int j = 0; j < 4; ++j) { float v = s[mt][t][j] * (at * dc[t][j]);
                        if constexpr (diag) { const int key = kt * 64 + 16 * t + 4 * g4 + j; v = (key <= qidx[mt]) ? v : 0.f; }
                        p[t][j] = v; }
            }
#pragma unroll
            for (int s2 = 0; s2 < 2; ++s2) { u32x4 w; w.x = cvtpk(p[2 * s2][0], p[2 * s2][1]); w.y = cvtpk(p[2 * s2][2], p[2 * s2][3]); w.z = cvtpk(p[2 * s2 + 1][0], p[2 * s2 + 1][1]); w.w = cvtpk(p[2 * s2 + 1][2], p[2 * s2 + 1][3]);
                pf[mt][s2] = __builtin_bit_cast(bf16x8, w); }
        }
        const LAS unsigned char* vb = lds + AT_V + buf * 64 * AT_KS;
#pragma unroll
        for (int dt = 0; dt < 4; ++dt)
#pragma unroll
            for (int s2 = 0; s2 < 2; ++s2) { const s16x4 v0 = vtr(vb + (32 * s2 + 4 * g4 + tq) * AT_KS + (16 * dt + 4 * tp) * 2), v1 = vtr(vb + (32 * s2 + 16 + 4 * g4 + tq) * AT_KS + (16 * dt + 4 * tp) * 2);
                bf16x8 vf; vf[0] = v0[0]; vf[1] = v0[1]; vf[2] = v0[2]; vf[3] = v0[3]; vf[4] = v1[0]; vf[5] = v1[1]; vf[6] = v1[2]; vf[7] = v1[3];
                o[0][dt] = __builtin_amdgcn_mfma_f32_16x16x32_bf16(vf, pf[0][s2], o[0][dt], 0, 0, 0);
                o[1][dt] = __builtin_amdgcn_mfma_f32_16x16x32_bf16(vf, pf[1][s2], o[1][dt], 0, 0, 0); }
        if (kt + 1 < nkt) { const int nb = (buf ^ 1) * 64 * AT_KS; *(LAS u32x4*)(lds + ldst + nb) = pre0; *(LAS u32x4*)(lds + ldst + nb + 64) = pre1; }
        __syncthreads();
    };
    for (int kt = 0; kt < 4 * qb; ++kt) tile(kt, std::false_type{});
    for (int kt = 4 * qb; kt < nkt; ++kt) tile(kt, std::true_type{});
#pragma unroll
    for (int mt = 0; mt < 2; ++mt) {
        if constexpr (MODE == 0) {
            float ls = lsum[mt]; ls += __shfl_xor(ls, 16); ls += __shfl_xor(ls, 32);
            const float inv = 1.0f / ls;
#pragma unroll
            for (int dt = 0; dt < 4; ++dt) { const f32x4 v = o[mt][dt] * inv; u32x2 w; w.x = cvtpk(v.x, v.y); w.y = cvtpk(v.z, v.w);
                *(u32x2*)(ymix + (rowb + qidx[mt]) * D + Y_MOBA + h * 64 + 16 * dt + 4 * g4) = w; }
        } else {
            float sm = 0.f;
#pragma unroll
            for (int dt = 0; dt < 4; ++dt) sm += (o[mt][dt].x + o[mt][dt].y) + (o[mt][dt].z + o[mt][dt].w);
            sm += __shfl_xor(sm, 16); sm += __shfl_xor(sm, 32);
            const float mu = sm * (1.0f / 64.0f); float vs = 0.f;
#pragma unroll
            for (int dt = 0; dt < 4; ++dt) { const f32x4 dv = o[mt][dt] - mu; vs += (dv.x * dv.x + dv.y * dv.y) + (dv.z * dv.z + dv.w * dv.w); }
            vs += __shfl_xor(vs, 16); vs += __shfl_xor(vs, 32);
            const float rstd = 1.0f / sqrtf(vs * (1.0f / 64.0f) + NORM_EPS);
#pragma unroll
            for (int dt = 0; dt < 4; ++dt) { const int d0 = h * 64 + 16 * dt + 4 * g4;
                const f32x4 nw = *(const f32x4*)(GIN(I_RETNW) + l * 256 + d0);
                const u32x2 gw2 = *(const u32x2*)(proj + (rowb + qidx[mt]) * PP + C_RG + d0);
                const float g0 = bflo(gw2.x), g1 = bfhi(gw2.x), g2 = bflo(gw2.y), g3 = bfhi(gw2.y);
                const f32x4 y = (o[mt][dt] - mu) * rstd * nw;
                u32x2 w; w.x = cvtpk(y.x * silu_f(g0), y.y * silu_f(g1)); w.y = cvtpk(y.z * silu_f(g2), y.w * silu_f(g3));
                *(u32x2*)(ymix + (rowb + qidx[mt]) * D + Y_RET + d0) = w; }
        }
    }
}

__device__ __forceinline__ void p2a(Frame& F, int l, int rep) {
    for (int u = F.bx; u < BATCH * 6 * (NLCH / 4); u += F.G) lru_unit(F, l, u / (6 * (NLCH / 4)), (u / (NLCH / 4)) % 6, u % (NLCH / 4));
    if (rep == 0 && F.bx >= BATCH * 6 * (NLCH / 4)) conv_one(F, l);
    bf16_t* proj = (bf16_t*)(F.ws + WS_PROJ);
    for (int u = (F.G - 1 - F.bx); u < BATCH * 6; u += F.G) { const int b = u / 6, h = u % 6, rg = F.lane >> 3, c8 = F.lane & 7;
        const bf16_t* kp = proj + ((size_t)b * SEQ + F.wave * 256 + rg) * PP + C_MK + h * 64 + c8 * 8;
        float a[8];
#pragma unroll
        for (int i = 0; i < 8; ++i) a[i] = 0.f;
#pragma unroll 4
        for (int it = 0; it < 32; ++it) { const u32x4 v = *(const u32x4*)(kp + (size_t)it * 8 * PP);
            a[0] += bflo(v.x); a[1] += bfhi(v.x); a[2] += bflo(v.y); a[3] += bfhi(v.y); a[4] += bflo(v.z); a[5] += bfhi(v.z); a[6] += bflo(v.w); a[7] += bfhi(v.w); }
#pragma unroll
        for (int i = 0; i < 8; ++i) { a[i] += __shfl_xor(a[i], 8); a[i] += __shfl_xor(a[i], 16); a[i] += __shfl_xor(a[i], 32); }
        if (rg == 0) { float* o = (float*)(F.ws + WS_KMEAN) + ((size_t)(b * 6 + h) * 8 + F.wave) * 64 + c8 * 8;
            *(f32x4*)o = (f32x4){a[0], a[1], a[2], a[3]} * (1.0f / 256.0f); *(f32x4*)(o + 4) = (f32x4){a[4], a[5], a[6], a[7]} * (1.0f / 256.0f); } }
}

__device__ __forceinline__ void p2b(Frame& F, int l, int rep) {
    volatile LAS int* sq = (volatile LAS int*)(F.lds + MISC_OFF + 1024);
    unsigned* head = (unsigned*)(F.ctl + CW_Q + 64 * l + rep);
    constexpr int N_ATT = 8 * 80, N_ALL = N_ATT + BATCH * 6 * NLCH;
    int q = (((F.bx >> 3) & 7) < 3) ? 1 : 0;
#pragma unroll 1
    for (int pass = 0; pass < 2; ++pass, q ^= 1) {
        q = __builtin_amdgcn_readfirstlane(q);
        { int _t = (F.wave << 6) | lane_id(); asm volatile("" : "+v"(_t)); F.tid = _t; F.lane = _t & 63;
          GAS unsigned char* _w = (GAS unsigned char*)F.ws; asm volatile("" : "+s"(_w)); F.ws = (unsigned char*)_w; F.ctl = (gu32*)(F.ws + WS_CTL); }
        if (q == 0) {
            for (;;) {
                if (F.tid == 0) *sq = (int)xb_add(head, 1u);
                __syncthreads();
                const int id = __builtin_amdgcn_readfirstlane(*sq);
                __syncthreads();
                if (id >= N_ALL) break;
                if (id < N_ATT) { const int qi = 7 - id / 80, r = id % 80;
                    if (r < 48) attn_unit<0>(F, l, r / 6, r % 6, qi); else attn_unit<1>(F, l, (r - 48) / 4, (r - 48) % 4, qi); }
                else { const int u = id - N_ATT; lru_fix(F, u / (6 * NLCH), (u / NLCH) % 6, u % NLCH); }
            }
        } else {
            unsigned nxt = 0u; unsigned zoff = 0u; asm volatile("" : "+v"(zoff));
            if (F.tid == 0) nxt = xb_add(head + 32 + zoff, 1u);
            for (;;) {
                if (F.tid == 0) *sq = (int)nxt;
                asm volatile("s_waitcnt lgkmcnt(0)\n\ts_barrier" ::: "memory");
                const int id = __builtin_amdgcn_readfirstlane(*sq);
                asm volatile("s_waitcnt lgkmcnt(0)\n\ts_barrier" ::: "memory");
                if (id >= cv::NB_LAYER - cv::tail_batches(l)) break;
                if (F.tid == 0) nxt = xb_add(head + 32 + zoff, 1u);
                cv::run_batch(F, cv::batch_base(l, id));
            }
            if (cv::tail_batches(l) > 0) for (;;) {
                if (F.tid == 0) *sq = (int)xb_add(head + 40 + zoff, 1u);
                asm volatile("s_waitcnt lgkmcnt(0)\n\ts_barrier" ::: "memory");
                const int id = __builtin_amdgcn_readfirstlane(*sq);
                asm volatile("s_waitcnt lgkmcnt(0)\n\ts_barrier" ::: "memory");
                if (id >= 2 * cv::tail_batches(l)) break;
                cv::run_half(F, cv::batch_base(l, cv::NB_LAYER - cv::tail_batches(l) + (id >> 1)) + 16 * (id & 1));
            }
        }
    }
}

constexpr int P4_SELE = MISC_OFF + 2048, P4_SELG = P4_SELE + 1024, P4_HIST = P4_SELG + 1024, P4_BASE = P4_HIST + 128, P4_RANK = P4_BASE + 128;
constexpr int P4_AS = 2064;
constexpr int P4_AHI = 0, P4_ALO = 16 * P4_AS, P4_PART = 2 * 16 * P4_AS, P4_LOG = P4_PART + 8 * 16 * 32 * 4;
__device__ __forceinline__ void p4_router(Frame& F, int l) {
    LAS unsigned char* lds = F.lds;
    LAS int* selE = (LAS int*)(lds + P4_SELE); LAS float* selG = (LAS float*)(lds + P4_SELG);
    LAS int* hist = (LAS int*)(lds + P4_HIST); LAS int* base = (LAS int*)(lds + P4_BASE); LAS int* lrank = (LAS int*)(lds + P4_RANK);
    const float* mod = (const float*)(F.ws + WS_MOD) + (size_t)l * BATCH * 6144;
    const bf16_t* x1 = (const bf16_t*)(F.ws + WS_X1); unsigned char* hb8 = (unsigned char*)(F.ws + WS_H8);
    i32x2* slot = (i32x2*)(F.ws + WS_SLOT);
    unsigned* cntg = (unsigned*)(F.ctl + CW_CNT + 64 * l);
    const int lane = F.lane, wave = F.wave, tid = F.tid, tt = lane & 15, g4 = lane >> 4;
    bf16x8 bh[2][4], bl[2][4];
    { const bf16_t* rwt = (const bf16_t*)(F.ws + WS_RWT) + (size_t)l * 2 * NE * D;
#pragma unroll
      for (int nt = 0; nt < 2; ++nt)
#pragma unroll
          for (int ks = 0; ks < 4; ++ks) { const size_t o = (size_t)(16 * nt + tt) * D + 128 * wave + 32 * ks + 8 * g4; bh[nt][ks] = *(const bf16x8*)(rwt + o); bl[nt][ks] = *(const bf16x8*)(rwt + (size_t)NE * D + o); } }
    const float rbias = GIN(I_RB)[l * NE + (tid & 31)];
    for (int tg = F.bx; tg < T / 64; tg += F.G) {
        if (tid < 32) hist[tid] = 0;
        const int tok0 = tg * 64, b = tok0 / SEQ;
        f32x4 mA[4], mB[4];
#pragma unroll
        for (int j = 0; j < 4; ++j) { const int k = 4 * lane + 256 * j; const f32x4 w = *(const f32x4*)(GIN(I_NFFN) + l * D + k), sc = *(const f32x4*)(mod + (size_t)b * 6144 + 4096 + k);
            mA[j] = w * (sc + 1.0f); mB[j] = *(const f32x4*)(mod + (size_t)b * 6144 + 3072 + k); }
#pragma unroll 1
        for (int grp = 0; grp < 4; ++grp) {
            { f32x4 v[2][4];
#pragma unroll
              for (int q = 0; q < 2; ++q)
#pragma unroll
                  for (int j = 0; j < 4; ++j) { const u32x2 w = *(const u32x2*)(x1 + ((size_t)tok0 + grp * 16 + 2 * wave + q) * D + 4 * lane + 256 * j); v[q][j] = (f32x4){bflo(w.x), bfhi(w.x), bflo(w.y), bfhi(w.y)}; }
#pragma unroll
              for (int q = 0; q < 2; ++q) { const int tl = 2 * wave + q; const size_t tok = (size_t)tok0 + grp * 16 + tl; float sa = 0.f;
#pragma unroll
                for (int j = 0; j < 4; ++j) sa += (v[q][j].x * v[q][j].x + v[q][j].y * v[q][j].y) + (v[q][j].z * v[q][j].z + v[q][j].w * v[q][j].w);
                const float ra = 1.0f / sqrtf(wave_sum(sa) * (1.0f / D) + NORM_EPS);
#pragma unroll
                for (int j = 0; j < 4; ++j) { const int k = 4 * lane + 256 * j;
                    const f32x4 hv = v[q][j] * ra * mA[j] + mB[j];
                    u32x2 hi; hi.x = cvtpk(hv.x, hv.y); hi.y = cvtpk(hv.z, hv.w);
                    const f32x4 lo = hv - (f32x4){bflo(hi.x), bfhi(hi.x), bflo(hi.y), bfhi(hi.y)};
                    u32x2 lw; lw.x = cvtpk(lo.x, lo.y); lw.y = cvtpk(lo.z, lo.w);
                    *(unsigned*)(hb8 + tok * D + k) = cvt4_fp8(hv.x, hv.y, hv.z, hv.w);
                    *(LAS u32x2*)(lds + P4_AHI + tl * P4_AS + k * 2) = hi; *(LAS u32x2*)(lds + P4_ALO + tl * P4_AS + k * 2) = lw; } } }
            __syncthreads();
            { f32x4 acc[2] = {(f32x4){0.f, 0.f, 0.f, 0.f}, (f32x4){0.f, 0.f, 0.f, 0.f}};
#pragma unroll
              for (int ks = 0; ks < 4; ++ks) { const int ao = tt * P4_AS + (128 * wave + 32 * ks + 8 * g4) * 2;
                  const bf16x8 ah = *(const LAS bf16x8*)(lds + P4_AHI + ao), al = *(const LAS bf16x8*)(lds + P4_ALO + ao);
#pragma unroll
                  for (int nt = 0; nt < 2; ++nt) { acc[nt] = __builtin_amdgcn_mfma_f32_16x16x32_bf16(ah, bh[nt][ks], acc[nt], 0, 0, 0);
                      acc[nt] = __builtin_amdgcn_mfma_f32_16x16x32_bf16(ah, bl[nt][ks], acc[nt], 0, 0, 0); acc[nt] = __builtin_amdgcn_mfma_f32_16x16x32_bf16(al, bh[nt][ks], acc[nt], 0, 0, 0); } }
              LAS float* part = (LAS float*)(lds + P4_PART) + wave * 512;
#pragma unroll
              for (int nt = 0; nt < 2; ++nt)
#pragma unroll
                  for (int j = 0; j < 4; ++j) part[(4 * g4 + j) * 32 + 16 * nt + tt] = acc[nt][j]; }
            __syncthreads();
            { const LAS float* part = (const LAS float*)(lds + P4_PART); float sum = 0.f;
#pragma unroll
              for (int w = 0; w < 8; ++w) sum += part[w * 512 + tid];
              const int e = tid & 31; float v = sum + rbias;
              float tv[4]; int te[4];
#pragma unroll
              for (int k = 0; k < 4; ++k) { float bv = v; int be = e;
#pragma unroll
#define P4_STEP(OV, OE) do { const float ov = (OV); const int oe = (OE); const bool take = (ov > bv) || (ov == bv && oe < be); bv = take ? ov : bv; be = take ? oe : be; } while (0)
#define P4_DPP(x, ctrl) __builtin_amdgcn_update_dpp(0, (x), (ctrl), 0xf, 0xf, false)
                  P4_STEP(__builtin_bit_cast(float, P4_DPP(__builtin_bit_cast(int, bv), 0xB1)), P4_DPP(be, 0xB1));
                  P4_STEP(__builtin_bit_cast(float, P4_DPP(__builtin_bit_cast(int, bv), 0x4E)), P4_DPP(be, 0x4E));
                  P4_STEP(__builtin_bit_cast(float, P4_DPP(__builtin_bit_cast(int, bv), 0x141)), P4_DPP(be, 0x141));
                  P4_STEP(__builtin_bit_cast(float, P4_DPP(__builtin_bit_cast(int, bv), 0x140)), P4_DPP(be, 0x140));
                  P4_STEP(__builtin_bit_cast(float, __builtin_amdgcn_ds_swizzle(__builtin_bit_cast(int, bv), 0x401F)), __builtin_amdgcn_ds_swizzle(be, 0x401F));
#undef P4_STEP
#undef P4_DPP
                  tv[k] = bv; te[k] = be; if (e == be) v = -INFINITY; }
              if (e == 0) { const float e1 = fexp(tv[1] - tv[0]), e2 = fexp(tv[2] - tv[0]), e3 = fexp(tv[3] - tv[0]), inv = 1.0f / (1.0f + e1 + e2 + e3);
                  const int s0 = (grp * 16 + (tid >> 5)) * 4; selE[s0] = te[0]; selE[s0 + 1] = te[1]; selE[s0 + 2] = te[2]; selE[s0 + 3] = te[3];
                  selG[s0] = inv; selG[s0 + 1] = e1 * inv; selG[s0 + 2] = e2 * inv; selG[s0 + 3] = e3 * inv; } }
        }
        __syncthreads();
        if (tid < 256) lrank[tid] = __hip_atomic_fetch_add(&hist[selE[tid]], 1, __ATOMIC_RELAXED, __HIP_MEMORY_SCOPE_WORKGROUP);
        __syncthreads();
        if (tid < 32) base[tid] = (int)xb_add(cntg + tid, (unsigned)hist[tid]);
        __syncthreads();
        if (tid < 256) { const int e = selE[tid], rank = base[e] + lrank[tid]; i32x2 ent; ent.x = (tok0 + (tid >> 2)) * 4 + (tid & 3); ent.y = __builtin_bit_cast(int, selG[tid]); slot[(size_t)e * CAP + rank] = ent; }
        __syncthreads();
    }
}
__device__ __forceinline__ int moe_table(Frame& F, int l) {
    LAS int* tab = (LAS int*)(F.lds + MISC_OFF + 1536);
    if (F.tid < 32) {
        const int e = F.tid; const int cn = (int)__hip_atomic_load((unsigned*)(F.ctl + CW_CNT + 64 * l + e), RLX_AGENT); const int nb = (cn + 255) >> 8;
        int inc = nb;
#pragma unroll
        for (int d = 1; d < 32; d <<= 1) { const int o = __shfl_up(inc, d); if (e >= d) inc += o; }
        tab[e] = inc - nb; tab[33 + e] = cn; if (e == 31) tab[32] = inc; }
    __syncthreads();
    return __builtin_amdgcn_readfirstlane(tab[32]);
}

__device__ __forceinline__ void p7_combine(Frame& F, int l) {
    const int gw = F.vcu * NWAVES + F.wave, NGW = F.G * NWAVES, lane = F.lane;
    const float* mod = (const float*)(F.ws + WS_MOD);
    const bf16_t* x1 = (const bf16_t*)(F.ws + WS_X1); bf16_t* x2 = (bf16_t*)(F.ws + WS_X2); const unsigned char* yb = (const unsigned char*)(F.ws + WS_YBUF); bf16_t* hb = (bf16_t*)(F.ws + WS_H);
    constexpr int TPI = 4;
    auto loadraw = [&](int t2, unsigned (&yw)[TPI][4][4], u32x2 (&xw)[TPI][4]) {
#pragma unroll
        for (int q = 0; q < TPI; ++q) { const size_t tok = (size_t)TPI * t2 + q;
#pragma unroll
            for (int j = 0; j < 4; ++j) { const int k = 4 * lane + 256 * j;
#pragma unroll
                for (int kk = 0; kk < 4; ++kk) yw[q][j][kk] = *(const unsigned*)(yb + (tok * 4 + kk) * D + k);
                xw[q][j] = *(const u32x2*)(x1 + tok * D + k); } } };
    auto process = [&](int t2, const unsigned (&yw)[TPI][4][4], const u32x2 (&xw)[TPI][4]) { const int b = (TPI * t2) / SEQ;
        f32x4 v[TPI][4];
#pragma unroll
        for (int q = 0; q < TPI; ++q)
#pragma unroll
            for (int j = 0; j < 4; ++j) { const int k = 4 * lane + 256 * j; f32x4 s = (f32x4){0.f, 0.f, 0.f, 0.f};
#pragma unroll
                for (int kk = 0; kk < 4; ++kk) { const unsigned w = yw[q][j][kk]; const f32x2 lo = __builtin_amdgcn_cvt_pk_f32_fp8((int)w, false), hi = __builtin_amdgcn_cvt_pk_f32_fp8((int)w, true); s += (f32x4){lo.x, lo.y, hi.x, hi.y}; }
                s = s * 0.0625f;
                const f32x4 g2 = *(const f32x4*)(mod + ((size_t)l * BATCH + b) * 6144 + 5120 + k);
                v[q][j] = (f32x4){bflo(xw[q][j].x), bfhi(xw[q][j].x), bflo(xw[q][j].y), bfhi(xw[q][j].y)} + g2 * s * (l == 0 ? DBG_MOE0 : DBG_MOE1); }
#pragma unroll
        for (int q = 0; q < TPI; ++q) { const size_t tok = (size_t)TPI * t2 + q;
            if (l + 1 < DEPTH) {
#pragma unroll
                for (int j = 0; j < 4; ++j) { u32x2 ow; ow.x = cvtpk(v[q][j].x, v[q][j].y); ow.y = cvtpk(v[q][j].z, v[q][j].w); *(u32x2*)(x2 + tok * D + 4 * lane + 256 * j) = ow; }
                const float* m1 = mod + ((size_t)(l + 1) * BATCH + b) * 6144;
                modnorm_store(v[q], GIN(I_NMIX) + (l + 1) * D, m1 + 1024, m1, hb + tok * D, lane);
            } else {
                float ss = 0.f;
#pragma unroll
                for (int j = 0; j < 4; ++j) ss += (v[q][j].x * v[q][j].x + v[q][j].y * v[q][j].y) + (v[q][j].z * v[q][j].z + v[q][j].w * v[q][j].w);
                const float rstd = 1.0f / sqrtf(wave_sum(ss) * (1.0f / D) + NORM_EPS);
#pragma unroll
                for (int j = 0; j < 4; ++j) { const int k = 4 * lane + 256 * j; *(f32x4*)(F.out + tok * D + k) = v[q][j] * rstd * *(const f32x4*)(GIN(I_FNW) + k); }
            } } };
    int t2 = gw;
    if (t2 < T / TPI) { unsigned ya[TPI][4][4]; u32x2 xa[TPI][4]; loadraw(t2, ya, xa);
        for (;;) { const int t2n = t2 + NGW; const bool hn = t2n < T / TPI; unsigned ybn[TPI][4][4]; u32x2 xbn[TPI][4];
            if (hn) loadraw(t2n, ybn, xbn);
            process(t2, ya, xa);
            if (!hn) break;
            t2 = t2n;
#pragma unroll
            for (int q = 0; q < TPI; ++q)
#pragma unroll
                for (int j = 0; j < 4; ++j) { xa[q][j] = xbn[q][j];
#pragma unroll
                    for (int kk = 0; kk < 4; ++kk) ya[q][j][kk] = ybn[q][j][kk]; } } }
}

constexpr int N_PHASES = 2 + 8 * DEPTH;
struct Args { const float* in[23]; float* out; unsigned char* ws; int ph_lo, ph_hi; };
__global__ void __launch_bounds__(NWAVES * 64, 2) fwd_kernel(Args args) {
    extern __shared__ __attribute__((aligned(16))) unsigned char lds_raw[];
    Frame F;
    F.lds = (LAS unsigned char*)lds_raw;
    F.tid = threadIdx.x; F.lane = F.tid & 63; F.wave = __builtin_amdgcn_readfirstlane(F.tid >> 6);
    const int wv0 = F.wave;
    F.bx = blockIdx.x; F.G = gridDim.x; { const int bx = blockIdx.x; F.vcu = (F.G % 8 == 0) ? (bx % 8) * (F.G / 8) + bx / 8 : bx; }
    F.ws = (unsigned char*)(GAS unsigned char*)args.ws; F.ctl = (gu32*)(F.ws + WS_CTL); F.out = (float*)(GAS float*)args.out;
    F.in = (const CAS PFC*)__builtin_amdgcn_kernarg_segment_ptr();
    volatile LAS unsigned* MISC = (volatile LAS unsigned*)(F.lds + MISC_OFF);
    for (int u = F.tid; u < 256; u += NWAVES * 64) MISC[u] = 0u;
    __syncthreads();
    if (MK_N_LAUNCHES == 1) (void)xcd_barrier_post((unsigned*)(F.ctl + CW_BAR), MISC + 8, F.tid);
    const int lo = (MK_N_LAUNCHES == 1) ? 0 : args.ph_lo, hi = (MK_N_LAUNCHES == 1) ? N_PHASES : args.ph_hi;
#ifndef PH_MASK
#define PH_MASK 0xffff
#endif
#define PHEN(j) (((PH_MASK) >> (j)) & 1)
#define IN(k) (lo <= (k) && (k) < hi)
#define REFRESH() do { int _t = (wv0 << 6) | lane_id(); asm volatile("" : "+v"(_t)); F.tid = _t; F.lane = _t & 63; F.wave = __builtin_amdgcn_readfirstlane(_t >> 6); \
        GAS unsigned char* _w = (GAS unsigned char*)args.ws; asm volatile("" : "+s"(_w)); F.ws = (unsigned char*)_w; F.ctl = (gu32*)(F.ws + WS_CTL);     { const CAS PFC* _p = (const CAS PFC*)__builtin_amdgcn_kernarg_segment_ptr(); asm volatile("" : "+s"(_p)); F.in = _p; }     int _b = blockIdx.x; asm volatile("" : "+s"(_b)); F.bx = _b; } while (0)
#define GRID_BAR(k) do { if (MK_N_LAUNCHES == 1) { XcdBarrier _b; _b.bar = (unsigned*)(F.ctl + CW_BAR); _b.x = xb_xcc_id(); _b.st = (volatile LAS unsigned*)(F.lds + MISC_OFF) + 8; xcd_barrier(_b, (wv0 << 6) | lane_id()); } } while (0)

    if (PHEN(0) && IN(0)) { asm volatile("; PHASE_MARK 0");
#pragma unroll 1
        for (int rep = 0; rep < NREP(0); ++rep) { p0_prologue(F); if (F.bx >= DEPTH * 96) conv_one(F, 0, true); GRID_BAR(0); } }
    if (PHEN(1) && IN(1)) { asm volatile("; PHASE_MARK 1");
#pragma unroll 1
        for (int rep = 0; rep < NREP(1); ++rep) { p0b_norm(F); p0_convert(F); GRID_BAR(1); } }
#pragma unroll 1
    for (int l = 0; l < DEPTH; ++l) {
        const int pb = 2 + 8 * l;
        const float* mod = (const float*)(F.ws + WS_MOD) + (size_t)l * BATCH * 6144;
        if (PHEN(2) && IN(pb + 0)) { asm volatile("; PHASE_MARK 2");
#pragma unroll 1
          for (int rep = 0; rep < NREP(2); ++rep) { REFRESH();
            pg8::DenseSched S; S.init(F.ws + WS_H, F.ws + WS_WIN + (size_t)l * PP * D * 2, T, PP, D, F.G, F.bx);
            pg8::EpiProj E{(bf16_t*)(F.ws + WS_PROJ), PP, (const float*)(F.ws + WS_ROT)};
            pg8::gemm_phase<pg8::EpiProj, pg8::DenseSched, false>(F.lds, D, S, E, F.tid);
            GRID_BAR(pb + 0); }
        }
        if (PHEN(3) && IN(pb + 1)) { asm volatile("; PHASE_MARK 3");
#pragma unroll 1
          for (int rep = 0; rep < NREP(3); ++rep) { REFRESH(); p2a(F, l, rep); GRID_BAR(pb + 1); } }
        if (PHEN(4) && IN(pb + 2)) { asm volatile("; PHASE_MARK 4");
#pragma unroll 1
          for (int rep = 0; rep < NREP(4); ++rep) { REFRESH(); p2b(F, l, rep); GRID_BAR(pb + 2); } }
        if (PHEN(5) && IN(pb + 3)) { asm volatile("; PHASE_MARK 5");
#pragma unroll 1
          for (int rep = 0; rep < NREP(5); ++rep) { REFRESH();
            pg8::DenseSched S; S.init(F.ws + WS_YMIX, F.ws + WS_WOUT + (size_t)l * D * D * 2, T, D, D, F.G, F.bx);
            if (l == 0) { pg8::EpiResGateT<false> E{GIN(I_X), (const bf16_t*)nullptr, (bf16_t*)(F.ws + WS_X1), mod + 2048, DBG_MIX0};
                pg8::gemm_phase<pg8::EpiResGateT<false>, pg8::DenseSched, false>(F.lds, D, S, E, F.tid); }
            else { pg8::EpiResGateT<true> E{(const float*)nullptr, (const bf16_t*)(F.ws + WS_X2), (bf16_t*)(F.ws + WS_X1), mod + 2048, DBG_MIX1};
                pg8::gemm_phase<pg8::EpiResGateT<true>, pg8::DenseSched, false>(F.lds, D, S, E, F.tid); }
            GRID_BAR(pb + 3); }
        }
        if (PHEN(6) && IN(pb + 4)) { asm volatile("; PHASE_MARK 6"); REFRESH(); p4_router(F, l); GRID_BAR(pb + 4); }
        if (PHEN(7) && IN(pb + 5)) { asm volatile("; PHASE_MARK 7");
#pragma unroll 1
          for (int rep = 0; rep < NREP(7); ++rep) {
            REFRESH(); const int nblk = moe_table(F, l);
            pg8::MoeSched<true> S; S.A = (const char*)(F.ws + WS_H8); S.Bt = (const char*)(F.ws + WS_WGU + (size_t)l * NE * 2048 * D); S.K = D; S.nN = 8; S.G = F.G; S.c = F.bx; S.total = nblk * 8; S.lj_in = F.lane & 31;
            S.tab = (const LAS int*)(F.lds + MISC_OFF + 1536); S.slot = (const i32x2*)(F.ws + WS_SLOT);
            pg8::EpiSwiGLU E{(unsigned char*)(F.ws + WS_ACT), GIN(I_BGU) + (size_t)l * NE * 2048};
            pg8::gemm_phase<pg8::EpiSwiGLU, pg8::MoeSched<true>, true, true>(F.lds, D, S, E, F.tid);
            if (l + 1 < DEPTH && rep == 0 && (F.G % 64) == 0) {
                const int BR = F.G / 8, off = (F.bx & 7) * (BR >> 3) + (F.bx >> 3) / 8;
                if ((nblk > off ? (nblk - off + BR - 1) / BR : 0) < (nblk + BR - 1) / BR) conv_one(F, l + 1, true); }
            GRID_BAR(pb + 5); }
        }
        if (PHEN(8) && IN(pb + 6)) { asm volatile("; PHASE_MARK 8");
#pragma unroll 1
          for (int rep = 0; rep < NREP(8); ++rep) {
            REFRESH(); const int nblk = moe_table(F, l);
            pg8::MoeSched<false> S; S.A = (const char*)(F.ws + WS_ACT); S.Bt = (const char*)(F.ws + WS_WDN + (size_t)l * NE * D * FF); S.K = FF; S.nN = 4; S.G = F.G; S.c = F.bx; S.total = nblk * 4; S.lj_in = F.lane & 31;
            S.tab = (const LAS int*)(F.lds + MISC_OFF + 1536); S.slot = (const i32x2*)(F.ws + WS_SLOT);
            pg8::EpiDown E{(unsigned char*)(F.ws + WS_YBUF), GIN(I_BDN) + (size_t)l * NE * D, (const i32x2*)(F.ws + WS_SLOT)};
            pg8::gemm_phase<pg8::EpiDown, pg8::MoeSched<false>, false, true>(F.lds, FF, S, E, F.tid);
            if (l + 1 < DEPTH && rep == 0 && (F.G % 64) == 0) {
                const int BR = F.G / 4, off = (F.bx & 7) * (BR >> 3) + (F.bx >> 3) / 4;
                if ((nblk > off ? (nblk - off + BR - 1) / BR : 0) < (nblk + BR - 1) / BR) conv_one(F, l + 1, true); }
            GRID_BAR(pb + 6); }
        }
        if (PHEN(9) && IN(pb + 7)) { asm volatile("; PHASE_MARK 9");
#pragma unroll 1
          for (int rep = 0; rep < NREP(9); ++rep) { REFRESH(); p7_combine(F, l); if (l + 1 < DEPTH || rep + 1 < NREP(9)) GRID_BAR(pb + 7); } }
    }
#undef IN
#undef GRID_BAR
}

extern "C" void kernel_launch(void* const* d_in, const int* in_sizes, int n_in, void* d_out, int out_size, void* d_ws, size_t ws_size, hipStream_t stream) {
    static int grid = 0;
    if (grid == 0) {
        if (n_in != 23 || out_size != T * D || ws_size < WS_END) { fprintf(stderr, "kernel_launch: unexpected shapes (n_in %d, out %d, ws %zu)\n", n_in, out_size, ws_size); grid = -1; return; }
        int dev = 0, cus = 0, per_cu = 0;
        if (hipGetDevice(&dev) != hipSuccess || hipDeviceGetAttribute(&cus, hipDeviceAttributeMultiprocessorCount, dev) != hipSuccess) { grid = -1; return; }
        if (hipFuncSetAttribute((const void*)fwd_kernel, hipFuncAttributeMaxDynamicSharedMemorySize, LDS_BYTES) != hipSuccess) { fprintf(stderr, "kernel_launch: hipFuncSetAttribute failed\n"); grid = -1; return; }
        if (hipOccupancyMaxActiveBlocksPerMultiprocessor(&per_cu, (const void*)fwd_kernel, NWAVES * 64, LDS_BYTES) != hipSuccess || per_cu < 1) { fprintf(stderr, "kernel_launch: occupancy query says %d\n", per_cu); }
        (void)hipGetLastError();
        grid = cus;
    }
    if (grid < 0) return;
    (void)hipMemsetAsync((char*)d_ws + WS_CTL, 0, CTL_ZERO_BYTES, stream);
    Args a{};
    for (int i = 0; i < 23; ++i) a.in[i] = (const float*)d_in[i];
    a.out = (float*)d_out; a.ws = (unsigned char*)d_ws;
    if (MK_N_LAUNCHES == 1) { a.ph_lo = 0; a.ph_hi = N_PHASES; hipLaunchKernelGGL(fwd_kernel, dim3(grid), dim3(NWAVES * 64), LDS_BYTES, stream, a); }
    else for (int p = 0; p < N_PHASES; ++p) { a.ph_lo = p; a.ph_hi = p + 1; hipLaunchKernelGGL(fwd_kernel, dim3(grid), dim3(NWAVES * 64), LDS_BYTES, stream, a); }
}
```
